# Optimizing an MI355X kernel written in HIP

```python
import math
import jax, jax.numpy as jnp
from jax import lax
import numpy as np

D_MODEL = 1024
BATCH = 8
SEQ = 4096
DEPTH = 1

CHUNK = 64
Q_BLOCK = 128
SSM_WIDTH = 1024
SSM_GROUP = 16
SSM_GROUPS = SSM_WIDTH // SSM_GROUP
SSM_STATE = 64
DT_MIN = 1e-3
DT_MAX = 1e-1
MLA_HEADS = 16
QK_NOPE = 64
QK_ROPE = 32
V_HEAD = 64
Q_LORA = 256
KV_LORA = 256
MLA_WIDTH = MLA_HEADS * V_HEAD
ROPE_BASE = 10000.0
EPS = 1e-6
IN_SPLITS = (SSM_WIDTH, SSM_WIDTH, Q_LORA, KV_LORA, QK_ROPE, MLA_WIDTH, D_MODEL, D_MODEL)
IN_WIDTH = sum(IN_SPLITS)

kernel_name = "hybrid_s5_mla_gated_block"


def _rmsnorm(x, g):
    xf = x.astype(jnp.float32)
    y = xf * lax.rsqrt(jnp.mean(xf * xf, axis=-1, keepdims=True) + EPS)
    return (y * g.astype(jnp.float32)).astype(x.dtype)


def _cmul(ar, ai, br, bi):
    return ar * br - ai * bi, ar * bi + ai * br


def _ssm_branch(u, log_dt, a_re, a_im, b_re, b_im, c_re, c_im, d_skip):
    f32 = jnp.float32
    out_dtype = u.dtype
    bsz, seq, _ = u.shape
    n_chunks = seq // CHUNK
    u = u.astype(f32).reshape(bsz, n_chunks, CHUNK, SSM_GROUPS, SSM_GROUP)
    u = jnp.moveaxis(u, 1, 0)
    dt = jnp.exp(log_dt.astype(f32))[:, None]
    lr, li = a_re.astype(f32), a_im.astype(f32)
    mag = jnp.exp(lr * dt)
    abar_re, abar_im = mag * jnp.cos(li * dt), mag * jnp.sin(li * dt)
    den = lr * lr + li * li
    nr, ni = abar_re - 1.0, abar_im
    fr = (nr * lr + ni * li) / den
    fi = (ni * lr - nr * li) / den
    br, bi = b_re.astype(f32), b_im.astype(f32)
    bbar_re, bbar_im = _cmul(fr[..., None], fi[..., None], br, bi)
    cr_w, ci_w = c_re.astype(f32), c_im.astype(f32)
    d = d_skip.astype(f32).reshape(SSM_GROUPS, SSM_GROUP)

    def combine(e1, e2):
        a1r, a1i, b1r, b1i = e1
        a2r, a2i, b2r, b2i = e2
        ar, ai = _cmul(a2r, a2i, a1r, a1i)
        xr, xi = _cmul(a2r, a2i, b1r, b1i)
        return ar, ai, xr + b2r, xi + b2i

    def chunk_step(carry, u_c):
        sr, si = carry
        bur = jnp.einsum('btgp,gnp->btgn', u_c, bbar_re)
        bui = jnp.einsum('btgp,gnp->btgn', u_c, bbar_im)
        ar = jnp.broadcast_to(abar_re, bur.shape)
        ai = jnp.broadcast_to(abar_im, bur.shape)
        pr, pi_, xr, xi = lax.associative_scan(combine, (ar, ai, bur, bui), axis=1)
        cr, ci = _cmul(pr, pi_, sr[:, None], si[:, None])
        xr, xi = xr + cr, xi + ci
        y = (jnp.einsum('btgn,gpn->btgp', xr, cr_w)
             - jnp.einsum('btgn,gpn->btgp', xi, ci_w) + d * u_c)
        return (xr[:, -1], xi[:, -1]), y

    init = (jnp.zeros((bsz, SSM_GROUPS, SSM_STATE), f32),
            jnp.zeros((bsz, SSM_GROUPS, SSM_STATE), f32))
    _, ys = lax.scan(chunk_step, init, u)
    return jnp.moveaxis(ys, 0, 1).reshape(bsz, seq, SSM_WIDTH).astype(out_dtype)


def _rope(t, cos, sin):
    half = t.shape[-1] // 2
    t1, t2 = t[..., :half], t[..., half:]
    return jnp.concatenate([t1 * cos - t2 * sin, t2 * cos + t1 * sin], axis=-1).astype(t.dtype)


def _mla_branch(q_lat, kv_lat, k_rope, positions, g_q_norm, w_q_up, g_kv_norm, w_kv_up):
    bsz, seq, _ = q_lat.shape
    q = (_rmsnorm(q_lat, g_q_norm) @ w_q_up).reshape(bsz, seq, MLA_HEADS, QK_NOPE + QK_ROPE)
    q_nope, q_rope = q[..., :QK_NOPE], q[..., QK_NOPE:]
    kv = (_rmsnorm(kv_lat, g_kv_norm) @ w_kv_up).reshape(bsz, seq, MLA_HEADS, QK_NOPE + V_HEAD)
    k_nope, v = kv[..., :QK_NOPE], kv[..., QK_NOPE:]
    inv_freq = ROPE_BASE ** (-jnp.arange(0, QK_ROPE, 2, dtype=jnp.float32) / QK_ROPE)
    ang = positions.astype(jnp.float32)[..., None] * inv_freq
    cos, sin = jnp.cos(ang), jnp.sin(ang)
    q_rope = _rope(q_rope, cos[:, :, None], sin[:, :, None])
    k_rope = _rope(k_rope, cos, sin)
    n_blk = seq // Q_BLOCK
    key_chunk = jnp.arange(seq) // CHUNK
    scale = (QK_NOPE + QK_ROPE) ** -0.5

    def to_blocks(t):
        return jnp.moveaxis(t.reshape(bsz, n_blk, Q_BLOCK, *t.shape[2:]), 1, 0)

    def attend(args):
        qn, qr, blk = args
        s = (jnp.einsum('bqhd,bkhd->bhqk', qn, k_nope)
             + jnp.einsum('bqhr,bkr->bhqk', qr, k_rope)).astype(jnp.float32) * scale
        q_chunk = (blk * Q_BLOCK + jnp.arange(Q_BLOCK)) // CHUNK
        mask = key_chunk[None, :] <= q_chunk[:, None]
        p = jax.nn.softmax(jnp.where(mask, s, -jnp.inf), axis=-1).astype(v.dtype)
        return jnp.einsum('bhqk,bkhd->bqhd', p, v)

    o = lax.map(attend, (to_blocks(q_nope), to_blocks(q_rope), jnp.arange(n_blk)))
    return jnp.moveaxis(o, 0, 1).reshape(bsz, seq, MLA_WIDTH)


def setup_inputs(seed: int = 0) -> dict:
    key = jax.random.key(seed)
    ks = jax.random.split(key, 25)
    f32 = jnp.float32

    def nrm(k, shape, scale):
        return jax.random.normal(k, shape, f32) * scale

    positions = (jax.random.randint(ks[2], (BATCH, 1), 0, 2048, dtype=jnp.int32)
                 + jnp.arange(SEQ, dtype=jnp.int32)[None, :])
    return {
        "x": nrm(ks[0], (BATCH, SEQ, D_MODEL), 1.0),
        "c": nrm(ks[1], (BATCH, D_MODEL), 1.0),
        "positions": positions,
        "w_ada": nrm(ks[3], (DEPTH, D_MODEL, 3 * D_MODEL), 0.5 * D_MODEL ** -0.5),
        "b_ada": nrm(ks[4], (DEPTH, 3 * D_MODEL), 0.01),
        "g_pre": 1.0 + nrm(ks[5], (DEPTH, D_MODEL), 0.01),
        "w_in": nrm(ks[6], (DEPTH, D_MODEL, IN_WIDTH), D_MODEL ** -0.5),
        "ssm_log_dt": jax.random.uniform(ks[7], (DEPTH, SSM_GROUPS), f32,
                                         math.log(DT_MIN), math.log(DT_MAX)),
        "ssm_a_re": -0.5 + nrm(ks[8], (DEPTH, SSM_GROUPS, SSM_STATE), 0.01),
        "ssm_a_im": (jnp.pi * jnp.arange(SSM_STATE, dtype=f32)
                     + nrm(ks[9], (DEPTH, SSM_GROUPS, SSM_STATE), 0.01)),
        "ssm_b_re": nrm(ks[10], (DEPTH, SSM_GROUPS, SSM_STATE, SSM_GROUP), (2 * SSM_GROUP) ** -0.5),
        "ssm_b_im": nrm(ks[11], (DEPTH, SSM_GROUPS, SSM_STATE, SSM_GROUP), (2 * SSM_GROUP) ** -0.5),
        "ssm_c_re": nrm(ks[12], (DEPTH, SSM_GROUPS, SSM_GROUP, SSM_STATE), (2 * SSM_STATE) ** -0.5),
        "ssm_c_im": nrm(ks[13], (DEPTH, SSM_GROUPS, SSM_GROUP, SSM_STATE), (2 * SSM_STATE) ** -0.5),
        "ssm_d": nrm(ks[14], (DEPTH, SSM_WIDTH), 0.5),
        "w_glu": nrm(ks[15], (DEPTH, SSM_WIDTH, 2 * SSM_WIDTH), SSM_WIDTH ** -0.5),
        "b_glu": nrm(ks[16], (DEPTH, 2 * SSM_WIDTH), 0.01),
        "g_q_norm": 1.0 + nrm(ks[17], (DEPTH, Q_LORA), 0.01),
        "w_q_up": nrm(ks[18], (DEPTH, Q_LORA, MLA_HEADS * (QK_NOPE + QK_ROPE)), Q_LORA ** -0.5),
        "g_kv_norm": 1.0 + nrm(ks[19], (DEPTH, KV_LORA), 0.01),
        "w_kv_up": nrm(ks[20], (DEPTH, KV_LORA, MLA_HEADS * (QK_NOPE + V_HEAD)), KV_LORA ** -0.5),
        "w_br_ssm": nrm(ks[21], (DEPTH, SSM_WIDTH, D_MODEL), SSM_WIDTH ** -0.5),
        "w_br_mla": nrm(ks[22], (DEPTH, MLA_WIDTH, D_MODEL), MLA_WIDTH ** -0.5),
        "w_out": nrm(ks[23], (DEPTH, D_MODEL, D_MODEL), D_MODEL ** -0.5),
        "g_post": 1.0 + nrm(ks[24], (DEPTH, D_MODEL), 0.01),
    }


def reference(x, c, positions, w_ada, b_ada, g_pre, w_in, ssm_log_dt, ssm_a_re, ssm_a_im,
              ssm_b_re, ssm_b_im, ssm_c_re, ssm_c_im, ssm_d, w_glu, b_glu, g_q_norm, w_q_up,
              g_kv_norm, w_kv_up, w_br_ssm, w_br_mla, w_out, g_post):
    split_at = np.cumsum(IN_SPLITS)[:-1].tolist()
    for l in range(DEPTH):
        mod = c @ w_ada[l] + b_ada[l]
        shift, scale, gate = jnp.split(mod, 3, axis=-1)
        h = _rmsnorm(x, g_pre[l]) * (1.0 + scale[:, None]) + shift[:, None]
        proj = h @ w_in[l]
        u_s, z_s, q_lat, kv_lat, k_rope, z_m, gl_s, gl_m = jnp.split(proj, split_at, axis=-1)
        y_s = _ssm_branch(u_s, ssm_log_dt[l], ssm_a_re[l], ssm_a_im[l], ssm_b_re[l],
                          ssm_b_im[l], ssm_c_re[l], ssm_c_im[l], ssm_d[l])
        glu_a, glu_b = jnp.split(jax.nn.gelu(y_s) @ w_glu[l] + b_glu[l], 2, axis=-1)
        y_s = ((glu_a * jax.nn.sigmoid(glu_b)) * jax.nn.silu(z_s)) @ w_br_ssm[l]
        y_m = _mla_branch(q_lat, kv_lat, k_rope, positions, g_q_norm[l], w_q_up[l],
                          g_kv_norm[l], w_kv_up[l])
        y_m = (y_m * jax.nn.silu(z_m)) @ w_br_mla[l]
        merged = jax.nn.sigmoid(gl_s) * y_s + jax.nn.sigmoid(gl_m) * y_m
        out = merged @ w_out[l]
        x = x + gate[:, None] * _rmsnorm(out, g_post[l])
    return x
```

```cpp
#include <hip/hip_runtime.h>
#include <hip/hip_cooperative_groups.h>
#include <cstdint>
#include <cstdio>
namespace cg = cooperative_groups;

#ifndef MK_SINGLE
#define MK_SINGLE 0
#endif

typedef unsigned short bf16_t;
typedef float f32x4 __attribute__((ext_vector_type(4)));
typedef unsigned u32x4 __attribute__((ext_vector_type(4)));
typedef unsigned u32x2 __attribute__((ext_vector_type(2)));

constexpr int NB = 8, SEQ = 4096, DM = 1024, NT = NB * SEQ;
constexpr int INW = 5664;
constexpr int C_US = 0, C_ZS = 1024, C_QL = 2048, C_KL = 2304, C_KR = 2560, C_ZM = 2592, C_GS = 3616, C_GM = 4640;
constexpr int NG = 64, GP = 16, NS = 64;
constexpr int NH = 16;
constexpr float EPS = 1e-6f;
constexpr float QSCALE = 0.10206207261596577f * 1.4426950408889634f;
constexpr int NTHR = 512;
constexpr int LDS_BYTES = 147456;

constexpr size_t MiB = 1u << 20;
constexpr size_t WS_CTL = 0;
constexpr size_t WS_MOD = 1 * MiB;
constexpr size_t WS_ROPE = 2 * MiB;
constexpr size_t WS_SSMC = 6 * MiB;
constexpr size_t WS_HB = 32 * MiB;
constexpr size_t WS_US = 96 * MiB;
constexpr size_t WS_TM = 160 * MiB;
constexpr size_t WS_QL = 224 * MiB;
constexpr size_t WS_KL = 240 * MiB;
constexpr size_t WS_KR = 256 * MiB;
constexpr size_t WS_QN = 288 * MiB;
constexpr size_t WS_QR = 352 * MiB;
constexpr size_t WS_KN = 384 * MiB;
constexpr size_t WS_VV = 448 * MiB;
constexpr size_t WS_ZS = 288 * MiB;
constexpr size_t WS_YG = 352 * MiB;
constexpr size_t WS_TS = 416 * MiB;
constexpr size_t WS_GS = 96 * MiB;
constexpr size_t WS_GM = 224 * MiB;
constexpr size_t WS_P1 = 288 * MiB;
constexpr size_t WS_MG = 32 * MiB;
constexpr size_t WS_OUTF = 288 * MiB;
constexpr size_t WS_END = 512 * MiB;

__device__ __forceinline__ unsigned f2bf(float f) { unsigned u = __builtin_bit_cast(unsigned, f); return (u + 0x7fffu + ((u >> 16) & 1u)) >> 16; }
__device__ __forceinline__ float bf2f(unsigned h) { return __builtin_bit_cast(float, (h & 0xffffu) << 16); }
__device__ __forceinline__ unsigned pk2(float lo, float hi) { return f2bf(lo) | (f2bf(hi) << 16); }
__device__ __forceinline__ float sigmoidf_(float v) { return 1.f / (1.f + __expf(-v)); }
__device__ __forceinline__ float siluf_(float v) { return v / (1.f + __expf(-v)); }
__device__ __forceinline__ float gelu_tanh(float v) { const float u = 0.7978845608028654f * (v + 0.044715f * v * v * v); return 0.5f * v * (1.f + tanhf(u)); }
__device__ __forceinline__ float wave_sum(float v) {
#pragma unroll
    for (int o = 1; o < 64; o <<= 1) v += __shfl_xor(v, o);
    return v;
}

__device__ __forceinline__ int opq(int x) { asm volatile("" : "+v"(x)); return x; }
struct Args { const float* in[25]; float* out; unsigned char* ws; int ph_lo, ph_hi; };

template <class AL, class BL, class EP>
__device__ __forceinline__ void gemm_o(float* lds, int M, int N, int K, const AL& al, const BL& bl, const EP& ep) {
    float* As = lds;
    float* Bs = lds + 16 * 132;
    const int tid = opq(threadIdx.x), ty = tid >> 4, tx = tid & 15;
    const int ntn = (N + 127) / 128, ntm = M / 128, ntiles = ntm * ntn;
    for (int tile = blockIdx.x; tile < ntiles; tile += gridDim.x) {
        const int tm = tile / ntn, tn = tile % ntn;
        const int row0 = tm * 128, col0 = tn * 128;
        float acc[4][8];
#pragma unroll
        for (int i = 0; i < 4; ++i)
#pragma unroll
            for (int j = 0; j < 8; ++j) acc[i][j] = 0.f;
        for (int k0 = 0; k0 < K; k0 += 16) {
            {
                const int r = tid >> 2, kk = (tid & 3) * 4;
                const bf16_t* p = al.a4(row0 + r, k0 + kk);
                const u32x2 w = *(const u32x2*)p;
                As[(kk + 0) * 132 + r] = bf2f(w.x); As[(kk + 1) * 132 + r] = bf2f(w.x >> 16);
                As[(kk + 2) * 132 + r] = bf2f(w.y); As[(kk + 3) * 132 + r] = bf2f(w.y >> 16);
            }
            {
                const int kk = tid >> 5, c = (tid & 31) * 4;
#pragma unroll
                for (int j = 0; j < 4; ++j) { const int col = col0 + c + j; Bs[kk * 132 + c + j] = (col < N) ? bl.b(k0 + kk, col) : 0.f; }
            }
            __syncthreads();
#pragma unroll 2
            for (int kk = 0; kk < 16; ++kk) {
                const f32x4 a = *(const f32x4*)(As + kk * 132 + ty * 4);
                const f32x4 b0 = *(const f32x4*)(Bs + kk * 132 + tx * 8), b1 = *(const f32x4*)(Bs + kk * 132 + tx * 8 + 4);
#pragma unroll
                for (int i = 0; i < 4; ++i) {
                    acc[i][0] += a[i] * b0[0]; acc[i][1] += a[i] * b0[1]; acc[i][2] += a[i] * b0[2]; acc[i][3] += a[i] * b0[3];
                    acc[i][4] += a[i] * b1[0]; acc[i][5] += a[i] * b1[1]; acc[i][6] += a[i] * b1[2]; acc[i][7] += a[i] * b1[3];
                }
            }
            __syncthreads();
        }
#pragma unroll
        for (int i = 0; i < 4; ++i)
#pragma unroll
            for (int j = 0; j < 8; j += 2) { const int col = col0 + tx * 8 + j; if (col < N) ep.e(row0 + ty * 4 + i, col, acc[i][j], acc[i][j + 1]); }
    }
}

struct ARow { const bf16_t* A; int lda; __device__ __forceinline__ const bf16_t* a4(int row, int k) const { return A + (size_t)row * lda + k; } };
struct AGrp { const bf16_t* A; __device__ __forceinline__ const bf16_t* a4(int row, int k) const { return A + ((size_t)(k >> 4) * NT + row) * 16 + (k & 15); } };

__device__ __forceinline__ void ph0_prep(const Args& a) {
    const int gtid = blockIdx.x * NTHR + opq(threadIdx.x), gsz = gridDim.x * NTHR;
    const float* c = a.in[1]; const int* pos = (const int*)a.in[2]; const float* w_ada = a.in[3]; const float* b_ada = a.in[4];
    float* mod = (float*)(a.ws + WS_MOD);
    for (int idx = gtid; idx < NB * 3072; idx += gsz) {
        const int b = idx / 3072, j = idx % 3072; float s = b_ada[j];
        for (int k = 0; k < DM; ++k) s += c[b * DM + k] * w_ada[(size_t)k * 3072 + j];
        mod[idx] = s;
    }
    float* rope = (float*)(a.ws + WS_ROPE);
    for (int idx = gtid; idx < NT * 16; idx += gsz) {
        const int tok = idx >> 4, i = idx & 15;
        const float inv = powf(10000.f, -(float)i / 16.f);
        const float ang = (float)pos[tok] * inv; float sn, cs; sincosf(ang, &sn, &cs);
        rope[(size_t)tok * 32 + i] = cs; rope[(size_t)tok * 32 + 16 + i] = sn;
    }
    const float* log_dt = a.in[7]; const float* a_re = a.in[8]; const float* a_im = a.in[9]; const float* b_re = a.in[10]; const float* b_im = a.in[11];
    float* abar = (float*)(a.ws + WS_SSMC); float* bbar = (float*)(a.ws + WS_SSMC + 65536);
    for (int idx = gtid; idx < NG * NS; idx += gsz) {
        const int g = idx / NS;
        const float dt = expf(log_dt[g]), lr = a_re[idx], li = a_im[idx];
        const float mag = expf(lr * dt); float sn, cs; sincosf(li * dt, &sn, &cs);
        const float abr = mag * cs, abi = mag * sn, den = lr * lr + li * li, nr = abr - 1.f, ni = abi;
        const float fr = (nr * lr + ni * li) / den, fi = (ni * lr - nr * li) / den;
        abar[idx * 2] = abr; abar[idx * 2 + 1] = abi;
        for (int q = 0; q < GP; ++q) { const float br = b_re[(size_t)idx * GP + q], bi = b_im[(size_t)idx * GP + q];
            bbar[((size_t)idx * GP + q) * 2] = fr * br - fi * bi; bbar[((size_t)idx * GP + q) * 2 + 1] = fr * bi + fi * br; }
    }
}

__device__ __forceinline__ void ph1_hnorm(const Args& a) {
    const int tid_ = opq(threadIdx.x), lane = tid_ & 63, gw = blockIdx.x * (NTHR / 64) + (tid_ >> 6), ngw = gridDim.x * (NTHR / 64);
    const float* x = a.in[0]; const float* g_pre = a.in[5]; const float* mod = (const float*)(a.ws + WS_MOD); bf16_t* HB = (bf16_t*)(a.ws + WS_HB);
    for (int m = gw; m < NT; m += ngw) {
        const int b = m / SEQ; const f32x4* xr = (const f32x4*)(x + (size_t)m * DM) + lane;
        f32x4 v[4]; float s = 0.f;
#pragma unroll
        for (int j = 0; j < 4; ++j) { v[j] = xr[64 * j]; s += (v[j].x * v[j].x + v[j].y * v[j].y) + (v[j].z * v[j].z + v[j].w * v[j].w); }
        const float rstd = 1.f / sqrtf(wave_sum(s) * (1.f / DM) + EPS);
        unsigned long long* o8 = (unsigned long long*)(HB + (size_t)m * DM) + lane;
#pragma unroll
        for (int j = 0; j < 4; ++j) { const int k = 256 * j + 4 * lane;
            const f32x4 g = *(const f32x4*)(g_pre + k), sh = *(const f32x4*)(mod + b * 3072 + k), sc = *(const f32x4*)(mod + b * 3072 + 1024 + k);
            const f32x4 h = v[j] * rstd * g * (sc + 1.f) + sh;
            o8[64 * j] = (unsigned long long)pk2(h.x, h.y) | ((unsigned long long)pk2(h.z, h.w) << 32); }
    }
}

struct BL2 { const float* W; __device__ __forceinline__ float b(int k, int j) const {
    int src;
    if (j < 1024) src = C_US + j; else if (j < 1280) src = C_QL + (j - 1024); else if (j < 1536) src = C_KL + (j - 1280);
    else if (j < 1568) { const int p = j - 1536; src = C_KR + ((p & 1) ? 16 + (p >> 1) : (p >> 1)); } else src = C_ZM + (j - 1568);
    return W[(size_t)k * INW + src]; } };
struct EP2 { bf16_t *US, *QL, *KL, *KR, *TM; float *ssq_q, *ssq_kv; const float* rope;
    __device__ __forceinline__ void e(int row, int j, float v0, float v1) const {
        if (j < 1024) { *(unsigned*)(US + ((size_t)(j >> 4) * NT + row) * 16 + (j & 15)) = pk2(v0, v1); }
        else if (j < 1280) { *(unsigned*)(QL + (size_t)row * 256 + (j - 1024)) = pk2(v0, v1); atomicAdd(ssq_q + row, v0 * v0 + v1 * v1); }
        else if (j < 1536) { *(unsigned*)(KL + (size_t)row * 256 + (j - 1280)) = pk2(v0, v1); atomicAdd(ssq_kv + row, v0 * v0 + v1 * v1); }
        else if (j < 1568) { const int p = j - 1536, i = p >> 1; const float cs = rope[(size_t)row * 32 + i], sn = rope[(size_t)row * 32 + 16 + i];
            *(unsigned*)(KR + (size_t)row * 32 + p) = pk2(v0 * cs - v1 * sn, v1 * cs + v0 * sn); }
        else { *(unsigned*)(TM + (size_t)row * 1024 + (j - 1568)) = pk2(siluf_(v0), siluf_(v1)); }
    } };

struct BL3q { const float* W; const float* g; __device__ __forceinline__ float b(int k, int j) const {
    int src; if (j < 1024) src = (j >> 6) * 96 + (j & 63); else { const int jj = j - 1024, h = jj >> 5, p = jj & 31; src = h * 96 + 64 + ((p & 1) ? 16 + (p >> 1) : (p >> 1)); }
    return W[(size_t)k * 1536 + src] * g[k]; } };
struct EP3q { bf16_t *QN, *QR; const float* ssq; const float* rope;
    __device__ __forceinline__ void e(int row, int j, float v0, float v1) const {
        const float rs = QSCALE / sqrtf(ssq[row] * (1.f / 256.f) + EPS); v0 *= rs; v1 *= rs;
        if (j < 1024) *(unsigned*)(QN + (size_t)row * 1024 + j) = pk2(v0, v1);
        else { const int jj = j - 1024, i = (jj & 31) >> 1; const float cs = rope[(size_t)row * 32 + i], sn = rope[(size_t)row * 32 + 16 + i];
            *(unsigned*)(QR + (size_t)row * 512 + jj) = pk2(v0 * cs - v1 * sn, v1 * cs + v0 * sn); }
    } };
struct BL3kv { const float* W; const float* g; __device__ __forceinline__ float b(int k, int j) const {
    const int src = (j < 1024) ? (j >> 6) * 128 + (j & 63) : ((j - 1024) >> 6) * 128 + 64 + (j & 63);
    return W[(size_t)k * 2048 + src] * g[k]; } };
struct EP3kv { bf16_t *KN, *VV; const float* ssq;
    __device__ __forceinline__ void e(int row, int j, float v0, float v1) const {
        const float rs = 1.f / sqrtf(ssq[row] * (1.f / 256.f) + EPS); v0 *= rs; v1 *= rs;
        if (j < 1024) *(unsigned*)(KN + (size_t)row * 1024 + j) = pk2(v0, v1); else *(unsigned*)(VV + (size_t)row * 1024 + (j - 1024)) = pk2(v0, v1);
    } };

__device__ __forceinline__ void ph4_attn(const Args& a, float* lds) {
    const bf16_t* QN = (const bf16_t*)(a.ws + WS_QN); const bf16_t* QR = (const bf16_t*)(a.ws + WS_QR); const bf16_t* KN = (const bf16_t*)(a.ws + WS_KN);
    const bf16_t* KR = (const bf16_t*)(a.ws + WS_KR); const bf16_t* VV = (const bf16_t*)(a.ws + WS_VV); bf16_t* TM = (bf16_t*)(a.ws + WS_TM);
    float* Kt = lds;
    float* Vt = lds + 64 * 100;
    const int tid = opq(threadIdx.x), wv = tid >> 6, half = wv >> 2;
    for (int item = blockIdx.x; item < NB * NH * 16; item += gridDim.x) {
        const int qb = item & 15, h = (item >> 4) & 15, b = item >> 8;
        const size_t tok = (size_t)b * SEQ + qb * 256 + (tid & 255);
        float q[96], o[32];
#pragma unroll
        for (int d = 0; d < 64; d += 2) { const unsigned w = *(const unsigned*)(QN + tok * 1024 + h * 64 + d); q[d] = bf2f(w); q[d + 1] = bf2f(w >> 16); }
#pragma unroll
        for (int d = 0; d < 32; d += 2) { const unsigned w = *(const unsigned*)(QR + tok * 512 + h * 32 + d); q[64 + d] = bf2f(w); q[64 + d + 1] = bf2f(w >> 16); }
#pragma unroll
        for (int d = 0; d < 32; ++d) o[d] = 0.f;
        float m = -1e30f, l = 0.f;
        const int mychunk = qb * 4 + (wv & 3), nkt = qb * 4 + 4;
        for (int kt = 0; kt < nkt; ++kt) {
            __syncthreads();
            const size_t kt0 = (size_t)b * SEQ + kt * 64;
            for (int e = tid; e < 64 * 32; e += NTHR) { const int key = e >> 5, d2 = (e & 31) * 2; const unsigned w = *(const unsigned*)(KN + (kt0 + key) * 1024 + h * 64 + d2); Kt[key * 100 + d2] = bf2f(w); Kt[key * 100 + d2 + 1] = bf2f(w >> 16); }
            for (int e = tid; e < 64 * 16; e += NTHR) { const int key = e >> 4, d2 = (e & 15) * 2; const unsigned w = *(const unsigned*)(KR + (kt0 + key) * 32 + d2); Kt[key * 100 + 64 + d2] = bf2f(w); Kt[key * 100 + 64 + d2 + 1] = bf2f(w >> 16); }
            for (int e = tid; e < 64 * 32; e += NTHR) { const int key = e >> 5, d2 = (e & 31) * 2; const unsigned w = *(const unsigned*)(VV + (kt0 + key) * 1024 + h * 64 + d2); Vt[key * 68 + d2] = bf2f(w); Vt[key * 68 + d2 + 1] = bf2f(w >> 16); }
            __syncthreads();
            if (kt <= mychunk) {
                for (int key = 0; key < 64; ++key) {
                    float s = 0.f;
#pragma unroll
                    for (int d = 0; d < 96; d += 4) { const f32x4 kk = *(const f32x4*)(Kt + key * 100 + d); s += q[d] * kk[0] + q[d + 1] * kk[1] + q[d + 2] * kk[2] + q[d + 3] * kk[3]; }
                    if (s > m) { const float f = exp2f(m - s); l *= f;
#pragma unroll
                        for (int d = 0; d < 32; ++d) o[d] *= f;
                        m = s; }
                    const float p = exp2f(s - m); l += p;
#pragma unroll
                    for (int d = 0; d < 32; d += 4) { const f32x4 vv = *(const f32x4*)(Vt + key * 68 + half * 32 + d); o[d] += p * vv[0]; o[d + 1] += p * vv[1]; o[d + 2] += p * vv[2]; o[d + 3] += p * vv[3]; }
                }
            }
        }
        const float il = 1.f / l;
#pragma unroll
        for (int d = 0; d < 32; d += 2) { unsigned* p = (unsigned*)(TM + tok * 1024 + h * 64 + half * 32 + d); const unsigned w = *p; *p = pk2(o[d] * il * bf2f(w), o[d + 1] * il * bf2f(w >> 16)); }
    }
}

__device__ __forceinline__ void ph5_ssm(const Args& a, float* lds) {
    const int tid = opq(threadIdx.x), lane = tid & 63, wv = tid >> 6;
    const bf16_t* US = (const bf16_t*)(a.ws + WS_US); bf16_t* YG = (bf16_t*)(a.ws + WS_YG);
    const float* abar = (const float*)(a.ws + WS_SSMC); const float* bbar = (const float*)(a.ws + WS_SSMC + 65536);
    const float* c_re = a.in[12]; const float* c_im = a.in[13]; const float* dsk = a.in[14];
    float* Xs = lds + wv * 4096;
    float* Cs = Xs + 1024; float* Us = Cs + 2048;
    for (int item = blockIdx.x * 8 + wv; item < NB * NG; item += gridDim.x * 8) {
        const int b = item / NG, g = item % NG;
        const float abr = abar[(g * NS + lane) * 2], abi = abar[(g * NS + lane) * 2 + 1];
        float bbr[16], bbi[16];
#pragma unroll
        for (int q = 0; q < 16; ++q) { bbr[q] = bbar[((size_t)(g * NS + lane) * 16 + q) * 2]; bbi[q] = bbar[((size_t)(g * NS + lane) * 16 + q) * 2 + 1]; }
        for (int p = 0; p < 16; ++p) { Cs[(p * 64 + lane) * 2] = c_re[((size_t)g * 16 + p) * 64 + lane]; Cs[(p * 64 + lane) * 2 + 1] = c_im[((size_t)g * 16 + p) * 64 + lane]; }
        float xr = 0.f, xi = 0.f;
        const bf16_t* ug = US + ((size_t)g * NT + (size_t)b * SEQ) * 16; bf16_t* yg = YG + ((size_t)g * NT + (size_t)b * SEQ) * 16;
        const int tt = lane >> 3, p0 = (lane & 7) * 2;
        const float d0 = dsk[g * 16 + p0], d1 = dsk[g * 16 + p0 + 1];
        for (int t0 = 0; t0 < SEQ; t0 += 8) {
            { const unsigned w = *(const unsigned*)(ug + (size_t)t0 * 16 + lane * 2); Us[lane * 2] = bf2f(w); Us[lane * 2 + 1] = bf2f(w >> 16); }
            asm volatile("s_waitcnt vmcnt(0) lgkmcnt(0)" ::: "memory");
#pragma unroll
            for (int t = 0; t < 8; ++t) {
                float bur = 0.f, bui = 0.f;
#pragma unroll
                for (int q = 0; q < 16; ++q) { const float u = Us[t * 16 + q]; bur += bbr[q] * u; bui += bbi[q] * u; }
                const float nr = abr * xr - abi * xi + bur, ni = abr * xi + abi * xr + bui; xr = nr; xi = ni;
                Xs[(t * 64 + lane) * 2] = xr; Xs[(t * 64 + lane) * 2 + 1] = xi;
            }
            asm volatile("s_waitcnt vmcnt(0) lgkmcnt(0)" ::: "memory");
            float y0 = 0.f, y1 = 0.f;
            for (int n = 0; n < 64; ++n) { const float vr = Xs[(tt * 64 + n) * 2], vi = Xs[(tt * 64 + n) * 2 + 1];
                y0 += Cs[(p0 * 64 + n) * 2] * vr - Cs[(p0 * 64 + n) * 2 + 1] * vi; y1 += Cs[((p0 + 1) * 64 + n) * 2] * vr - Cs[((p0 + 1) * 64 + n) * 2 + 1] * vi; }
            y0 += d0 * Us[tt * 16 + p0]; y1 += d1 * Us[tt * 16 + p0 + 1];
            *(unsigned*)(yg + (size_t)(t0 + tt) * 16 + p0) = pk2(gelu_tanh(y0), gelu_tanh(y1));
            asm volatile("s_waitcnt vmcnt(0) lgkmcnt(0)" ::: "memory");
        }
    }
}

struct BLzs { const float* W; __device__ __forceinline__ float b(int k, int j) const { return W[(size_t)k * INW + C_ZS + j]; } };
struct EPzs { bf16_t* ZS; __device__ __forceinline__ void e(int row, int j, float v0, float v1) const { *(unsigned*)(ZS + (size_t)row * 1024 + j) = pk2(siluf_(v0), siluf_(v1)); } };
struct BLglu { const float* W; __device__ __forceinline__ float b(int k, int j) const { return W[(size_t)k * 2048 + ((j & 1) ? 1024 + (j >> 1) : (j >> 1))]; } };
struct EPglu { bf16_t* TS; const bf16_t* ZS; const float* bias; __device__ __forceinline__ void e(int row, int j, float v0, float v1) const {
    const int jj = j >> 1; const float ga = v0 + bias[jj], gb = v1 + bias[1024 + jj]; TS[(size_t)row * 1024 + jj] = (bf16_t)f2bf(ga * sigmoidf_(gb) * bf2f(ZS[(size_t)row * 1024 + jj])); } };
struct BLgate { const float* W; __device__ __forceinline__ float b(int k, int j) const { return W[(size_t)k * INW + ((j & 1) ? C_GM + (j >> 1) : C_GS + (j >> 1))]; } };
struct EPgate { bf16_t *GS, *GM; __device__ __forceinline__ void e(int row, int j, float v0, float v1) const { const int jj = j >> 1; GS[(size_t)row * 1024 + jj] = (bf16_t)f2bf(sigmoidf_(v0)); GM[(size_t)row * 1024 + jj] = (bf16_t)f2bf(sigmoidf_(v1)); } };
struct BLplain { const float* W; int ldw; __device__ __forceinline__ float b(int k, int j) const { return W[(size_t)k * ldw + j]; } };
struct EPbs { float* P1; const bf16_t* GS; __device__ __forceinline__ void e(int row, int j, float v0, float v1) const {
    const unsigned w = *(const unsigned*)(GS + (size_t)row * 1024 + j); P1[(size_t)row * 1024 + j] = bf2f(w) * v0; P1[(size_t)row * 1024 + j + 1] = bf2f(w >> 16) * v1; } };
struct EPbm { const float* P1; const bf16_t* GM; bf16_t* MG; __device__ __forceinline__ void e(int row, int j, float v0, float v1) const {
    const unsigned w = *(const unsigned*)(GM + (size_t)row * 1024 + j); *(unsigned*)(MG + (size_t)row * 1024 + j) = pk2(P1[(size_t)row * 1024 + j] + bf2f(w) * v0, P1[(size_t)row * 1024 + j + 1] + bf2f(w >> 16) * v1); } };
struct EPout { float* O; __device__ __forceinline__ void e(int row, int j, float v0, float v1) const { O[(size_t)row * 1024 + j] = v0; O[(size_t)row * 1024 + j + 1] = v1; } };

__device__ __forceinline__ void ph_final(const Args& a) {
    const int tid_ = opq(threadIdx.x), lane = tid_ & 63, gw = blockIdx.x * (NTHR / 64) + (tid_ >> 6), ngw = gridDim.x * (NTHR / 64);
    const float* x = a.in[0]; const float* g_post = a.in[24]; const float* mod = (const float*)(a.ws + WS_MOD); const float* OF = (const float*)(a.ws + WS_OUTF);
    for (int m = gw; m < NT; m += ngw) {
        const int b = m / SEQ; const f32x4* orow = (const f32x4*)(OF + (size_t)m * DM) + lane; const f32x4* xr = (const f32x4*)(x + (size_t)m * DM) + lane;
        f32x4 v[4]; float s = 0.f;
#pragma unroll
        for (int j = 0; j < 4; ++j) { v[j] = orow[64 * j]; s += (v[j].x * v[j].x + v[j].y * v[j].y) + (v[j].z * v[j].z + v[j].w * v[j].w); }
        const float rstd = 1.f / sqrtf(wave_sum(s) * (1.f / DM) + EPS);
        f32x4* o = (f32x4*)(a.out + (size_t)m * DM) + lane;
#pragma unroll
        for (int j = 0; j < 4; ++j) { const int k = 256 * j + 4 * lane; const f32x4 g = *(const f32x4*)(g_post + k), gt = *(const f32x4*)(mod + b * 3072 + 2048 + k);
            o[64 * j] = xr[64 * j] + gt * (v[j] * rstd * g); }
    }
}

constexpr int NPHASE = 11;
__global__ void __launch_bounds__(NTHR, 2) mk_fwd(Args a) {
    extern __shared__ __attribute__((aligned(16))) unsigned char lds_raw[];
    float* lds = (float*)lds_raw;
    unsigned char* ws = a.ws;
#define SEAM(k) do { if (a.ph_lo <= (k) && (k) + 1 < a.ph_hi) { cg::this_grid().sync(); } } while (0)
#define IN(k) (a.ph_lo <= (k) && (k) < a.ph_hi)
    if (IN(0)) { ph0_prep(a); } SEAM(0);
    if (IN(1)) { ph1_hnorm(a); } SEAM(1);
    if (IN(2)) {
        ARow al{(const bf16_t*)(ws + WS_HB), 1024}; BL2 bl{a.in[6]};
        EP2 ep{(bf16_t*)(ws + WS_US), (bf16_t*)(ws + WS_QL), (bf16_t*)(ws + WS_KL), (bf16_t*)(ws + WS_KR), (bf16_t*)(ws + WS_TM), (float*)(ws + WS_CTL), (float*)(ws + WS_CTL + 131072), (const float*)(ws + WS_ROPE)};
        gemm_o(lds, NT, 2592, 1024, al, bl, ep);
    } SEAM(2);
    if (IN(3)) {
        { ARow al{(const bf16_t*)(ws + WS_QL), 256}; BL3q bl{a.in[18], a.in[17]}; EP3q ep{(bf16_t*)(ws + WS_QN), (bf16_t*)(ws + WS_QR), (const float*)(ws + WS_CTL), (const float*)(ws + WS_ROPE)};
          gemm_o(lds, NT, 1536, 256, al, bl, ep); }
        { ARow al{(const bf16_t*)(ws + WS_KL), 256}; BL3kv bl{a.in[20], a.in[19]}; EP3kv ep{(bf16_t*)(ws + WS_KN), (bf16_t*)(ws + WS_VV), (const float*)(ws + WS_CTL + 131072)};
          gemm_o(lds, NT, 2048, 256, al, bl, ep); }
    } SEAM(3);
    if (IN(4)) { ph4_attn(a, lds); } SEAM(4);
    if (IN(5)) {
        { ARow al{(const bf16_t*)(ws + WS_HB), 1024}; BLzs bl{a.in[6]}; EPzs ep{(bf16_t*)(ws + WS_ZS)}; gemm_o(lds, NT, 1024, 1024, al, bl, ep); }
        __syncthreads();
        ph5_ssm(a, lds);
    } SEAM(5);
    if (IN(6)) {
        { AGrp al{(const bf16_t*)(ws + WS_YG)}; BLglu bl{a.in[15]}; EPglu ep{(bf16_t*)(ws + WS_TS), (const bf16_t*)(ws + WS_ZS), a.in[16]}; gemm_o(lds, NT, 2048, 1024, al, bl, ep); }
        { ARow al{(const bf16_t*)(ws + WS_HB), 1024}; BLgate bl{a.in[6]}; EPgate ep{(bf16_t*)(ws + WS_GS), (bf16_t*)(ws + WS_GM)}; gemm_o(lds, NT, 2048, 1024, al, bl, ep); }
    } SEAM(6);
    if (IN(7)) { ARow al{(const bf16_t*)(ws + WS_TS), 1024}; BLplain bl{a.in[21], 1024}; EPbs ep{(float*)(ws + WS_P1), (const bf16_t*)(ws + WS_GS)}; gemm_o(lds, NT, 1024, 1024, al, bl, ep); } SEAM(7);
    if (IN(8)) { ARow al{(const bf16_t*)(ws + WS_TM), 1024}; BLplain bl{a.in[22], 1024}; EPbm ep{(const float*)(ws + WS_P1), (const bf16_t*)(ws + WS_GM), (bf16_t*)(ws + WS_MG)}; gemm_o(lds, NT, 1024, 1024, al, bl, ep); } SEAM(8);
    if (IN(9)) { ARow al{(const bf16_t*)(ws + WS_MG), 1024}; BLplain bl{a.in[23], 1024}; EPout ep{(float*)(ws + WS_OUTF)}; gemm_o(lds, NT, 1024, 1024, al, bl, ep); } SEAM(9);
    if (IN(10)) { ph_final(a); }
#undef SEAM
#undef IN
}

extern "C" void kernel_launch(void* const* d_in, const int* in_sizes, int n_in, void* d_out, int out_size, void* d_ws, size_t ws_size, hipStream_t stream) {
    static int grid = 0;
    if (grid == 0) {
        if (n_in != 25 || out_size != NT * DM || ws_size < WS_END) { fprintf(stderr, "kernel_launch: unexpected shapes n_in %d out %d ws %zu\n", n_in, out_size, ws_size); grid = -1; return; }
        int dev = 0, cus = 0, per_cu = 0;
        hipGetDevice(&dev); hipDeviceGetAttribute(&cus, hipDeviceAttributeMultiprocessorCount, dev);
        hipFuncSetAttribute((const void*)mk_fwd, hipFuncAttributeMaxDynamicSharedMemorySize, LDS_BYTES);
        hipOccupancyMaxActiveBlocksPerMultiprocessor(&per_cu, (const void*)mk_fwd, NTHR, LDS_BYTES);
        (void)hipGetLastError();
        if (per_cu < 1) per_cu = 1;
        grid = cus * 1;
        fprintf(stderr, "kernel_launch: cus %d per_cu %d grid %d ws %zu\n", cus, per_cu, grid, ws_size);
    }
    if (grid < 0) return;
    hipMemsetAsync((char*)d_ws + WS_CTL, 0, 1 * MiB, stream);
    Args a{};
    for (int i = 0; i < 25; ++i) a.in[i] = (const float*)d_in[i];
    a.out = (float*)d_out; a.ws = (unsigned char*)d_ws;
#if MK_SINGLE
    a.ph_lo = 0; a.ph_hi = NPHASE;
    void* args[] = {&a};
    hipError_t e = hipLaunchCooperativeKernel((const void*)mk_fwd, dim3(grid), dim3(NTHR), args, LDS_BYTES, stream);
    if (e != hipSuccess) fprintf(stderr, "cooperative launch failed: %s (grid %d)\n", hipGetErrorString(e), grid);
#else
    for (int p = 0; p < NPHASE; ++p) { a.ph_lo = p; a.ph_hi = p + 1; hipLaunchKernelGGL(mk_fwd, dim3(grid), dim3(NTHR), LDS_BYTES, stream, a); }
#endif
}
```

```cpp
#include <hip/hip_runtime.h>
#include <hip/hip_cooperative_groups.h>
#include <cstdint>
#include <cstdio>
namespace cg = cooperative_groups;

#ifndef MK_SINGLE
#define MK_SINGLE 1
#endif

typedef unsigned short bf16_t;
typedef float f32x4 __attribute__((ext_vector_type(4)));
typedef unsigned u32x4 __attribute__((ext_vector_type(4)));
typedef unsigned u32x2 __attribute__((ext_vector_type(2)));

constexpr int NB = 8, SEQ = 4096, DM = 1024, NT = NB * SEQ;
constexpr int INW = 5664;
constexpr int C_US = 0, C_ZS = 1024, C_QL = 2048, C_KL = 2304, C_KR = 2560, C_ZM = 2592, C_GS = 3616, C_GM = 4640;
constexpr int NG = 64, GP = 16, NS = 64;
constexpr int NH = 16;
constexpr float EPS = 1e-6f;
constexpr float QSCALE = 0.10206207261596577f * 1.4426950408889634f;
constexpr int NTHR = 512;
constexpr int LDS_BYTES = 147456;

constexpr size_t MiB = 1u << 20;
constexpr size_t WS_CTL = 0;
constexpr size_t WS_MOD = 1 * MiB;
constexpr size_t WS_ROPE = 2 * MiB;
constexpr size_t WS_SSMC = 6 * MiB;
constexpr size_t WS_HB = 32 * MiB;
constexpr size_t WS_US = 96 * MiB;
constexpr size_t WS_TM = 160 * MiB;
constexpr size_t WS_QL = 224 * MiB;
constexpr size_t WS_KL = 240 * MiB;
constexpr size_t WS_KR = 256 * MiB;
constexpr size_t WS_QN = 288 * MiB;
constexpr size_t WS_QR = 352 * MiB;
constexpr size_t WS_KN = 384 * MiB;
constexpr size_t WS_VV = 448 * MiB;
constexpr size_t WS_ZS = 288 * MiB;
constexpr size_t WS_YG = 352 * MiB;
constexpr size_t WS_TS = 416 * MiB;
constexpr size_t WS_GS = 96 * MiB;
constexpr size_t WS_GM = 224 * MiB;
constexpr size_t WS_P1 = 288 * MiB;
constexpr size_t WS_MG = 32 * MiB;
constexpr size_t WS_OUTF = 288 * MiB;
constexpr size_t WS_END = 512 * MiB;

__device__ __forceinline__ unsigned f2bf(float f) { unsigned u = __builtin_bit_cast(unsigned, f); return (u + 0x7fffu + ((u >> 16) & 1u)) >> 16; }
__device__ __forceinline__ float bf2f(unsigned h) { return __builtin_bit_cast(float, (h & 0xffffu) << 16); }
__device__ __forceinline__ unsigned pk2(float lo, float hi) { return f2bf(lo) | (f2bf(hi) << 16); }
__device__ __forceinline__ float sigmoidf_(float v) { return 1.f / (1.f + __expf(-v)); }
__device__ __forceinline__ float siluf_(float v) { return v / (1.f + __expf(-v)); }
__device__ __forceinline__ float gelu_tanh(float v) { const float u = 0.7978845608028654f * (v + 0.044715f * v * v * v); return 0.5f * v * (1.f + tanhf(u)); }
__device__ __forceinline__ float wave_sum(float v) {
#pragma unroll
    for (int o = 1; o < 64; o <<= 1) v += __shfl_xor(v, o);
    return v;
}

__device__ __forceinline__ int opq(int x) { asm volatile("" : "+v"(x)); return x; }
struct Args { const float* in[25]; float* out; unsigned char* ws; int ph_lo, ph_hi; };

template <class AL, class BL, class EP>
__device__ __forceinline__ void gemm_o(float* lds, int M, int N, int K, const AL& al, const BL& bl, const EP& ep) {
    float* As = lds;
    float* Bs = lds + 16 * 132;
    const int tid = opq(threadIdx.x), ty = tid >> 4, tx = tid & 15;
    const int ntn = (N + 127) / 128, ntm = M / 128, ntiles = ntm * ntn;
    for (int tile = blockIdx.x; tile < ntiles; tile += gridDim.x) {
        const int tm = tile / ntn, tn = tile % ntn;
        const int row0 = tm * 128, col0 = tn * 128;
        float acc[4][8];
#pragma unroll
        for (int i = 0; i < 4; ++i)
#pragma unroll
            for (int j = 0; j < 8; ++j) acc[i][j] = 0.f;
        for (int k0 = 0; k0 < K; k0 += 16) {
            {
                const int r = tid >> 2, kk = (tid & 3) * 4;
                const bf16_t* p = al.a4(row0 + r, k0 + kk);
                const u32x2 w = *(const u32x2*)p;
                As[(kk + 0) * 132 + r] = bf2f(w.x); As[(kk + 1) * 132 + r] = bf2f(w.x >> 16);
                As[(kk + 2) * 132 + r] = bf2f(w.y); As[(kk + 3) * 132 + r] = bf2f(w.y >> 16);
            }
            {
                const int kk = tid >> 5, c = (tid & 31) * 4;
#pragma unroll
                for (int j = 0; j < 4; ++j) { const int col = col0 + c + j; Bs[kk * 132 + c + j] = (col < N) ? bl.b(k0 + kk, col) : 0.f; }
            }
            __syncthreads();
#pragma unroll 2
            for (int kk = 0; kk < 16; ++kk) {
                const f32x4 a = *(const f32x4*)(As + kk * 132 + ty * 4);
                const f32x4 b0 = *(const f32x4*)(Bs + kk * 132 + tx * 8), b1 = *(const f32x4*)(Bs + kk * 132 + tx * 8 + 4);
#pragma unroll
                for (int i = 0; i < 4; ++i) {
                    acc[i][0] += a[i] * b0[0]; acc[i][1] += a[i] * b0[1]; acc[i][2] += a[i] * b0[2]; acc[i][3] += a[i] * b0[3];
                    acc[i][4] += a[i] * b1[0]; acc[i][5] += a[i] * b1[1]; acc[i][6] += a[i] * b1[2]; acc[i][7] += a[i] * b1[3];
                }
            }
            __syncthreads();
        }
#pragma unroll
        for (int i = 0; i < 4; ++i)
#pragma unroll
            for (int j = 0; j < 8; j += 2) { const int col = col0 + tx * 8 + j; if (col < N) ep.e(row0 + ty * 4 + i, col, acc[i][j], acc[i][j + 1]); }
    }
}

struct ARow { const bf16_t* A; int lda; __device__ __forceinline__ const bf16_t* a4(int row, int k) const { return A + (size_t)row * lda + k; } };
struct AGrp { const bf16_t* A; __device__ __forceinline__ const bf16_t* a4(int row, int k) const { return A + ((size_t)(k >> 4) * NT + row) * 16 + (k & 15); } };

__device__ __forceinline__ void ph0_prep(const Args& a) {
    const int gtid = blockIdx.x * NTHR + opq(threadIdx.x), gsz = gridDim.x * NTHR;
    const float* c = a.in[1]; const int* pos = (const int*)a.in[2]; const float* w_ada = a.in[3]; const float* b_ada = a.in[4];
    float* mod = (float*)(a.ws + WS_MOD);
    for (int idx = gtid; idx < NB * 3072; idx += gsz) {
        const int b = idx / 3072, j = idx % 3072; float s = b_ada[j];
        for (int k = 0; k < DM; ++k) s += c[b * DM + k] * w_ada[(size_t)k * 3072 + j];
        mod[idx] = s;
    }
    float* rope = (float*)(a.ws + WS_ROPE);
    for (int idx = gtid; idx < NT * 16; idx += gsz) {
        const int tok = idx >> 4, i = idx & 15;
        const float inv = powf(10000.f, -(float)i / 16.f);
        const float ang = (float)pos[tok] * inv; float sn, cs; sincosf(ang, &sn, &cs);
        rope[(size_t)tok * 32 + i] = cs; rope[(size_t)tok * 32 + 16 + i] = sn;
    }
    const float* log_dt = a.in[7]; const float* a_re = a.in[8]; const float* a_im = a.in[9]; const float* b_re = a.in[10]; const float* b_im = a.in[11];
    float* abar = (float*)(a.ws + WS_SSMC); float* bbar = (float*)(a.ws + WS_SSMC + 65536);
    for (int idx = gtid; idx < NG * NS; idx += gsz) {
        const int g = idx / NS;
        const float dt = expf(log_dt[g]), lr = a_re[idx], li = a_im[idx];
        const float mag = expf(lr * dt); float sn, cs; sincosf(li * dt, &sn, &cs);
        const float abr = mag * cs, abi = mag * sn, den = lr * lr + li * li, nr = abr - 1.f, ni = abi;
        const float fr = (nr * lr + ni * li) / den, fi = (ni * lr - nr * li) / den;
        abar[idx * 2] = abr; abar[idx * 2 + 1] = abi;
        for (int q = 0; q < GP; ++q) { const float br = b_re[(size_t)idx * GP + q], bi = b_im[(size_t)idx * GP + q];
            bbar[((size_t)idx * GP + q) * 2] = fr * br - fi * bi; bbar[((size_t)idx * GP + q) * 2 + 1] = fr * bi + fi * br; }
    }
}

__device__ __forceinline__ void ph1_hnorm(const Args& a) {
    const int tid_ = opq(threadIdx.x), lane = tid_ & 63, gw = blockIdx.x * (NTHR / 64) + (tid_ >> 6), ngw = gridDim.x * (NTHR / 64);
    const float* x = a.in[0]; const float* g_pre = a.in[5]; const float* mod = (const float*)(a.ws + WS_MOD); bf16_t* HB = (bf16_t*)(a.ws + WS_HB);
    for (int m = gw; m < NT; m += ngw) {
        const int b = m / SEQ; const f32x4* xr = (const f32x4*)(x + (size_t)m * DM) + lane;
        f32x4 v[4]; float s = 0.f;
#pragma unroll
        for (int j = 0; j < 4; ++j) { v[j] = xr[64 * j]; s += (v[j].x * v[j].x + v[j].y * v[j].y) + (v[j].z * v[j].z + v[j].w * v[j].w); }
        const float rstd = 1.f / sqrtf(wave_sum(s) * (1.f / DM) + EPS);
        unsigned long long* o8 = (unsigned long long*)(HB + (size_t)m * DM) + lane;
#pragma unroll
        for (int j = 0; j < 4; ++j) { const int k = 256 * j + 4 * lane;
            const f32x4 g = *(const f32x4*)(g_pre + k), sh = *(const f32x4*)(mod + b * 3072 + k), sc = *(const f32x4*)(mod + b * 3072 + 1024 + k);
            const f32x4 h = v[j] * rstd * g * (sc + 1.f) + sh;
            o8[64 * j] = (unsigned long long)pk2(h.x, h.y) | ((unsigned long long)pk2(h.z, h.w) << 32); }
    }
}

struct BL2 { const float* W; __device__ __forceinline__ float b(int k, int j) const {
    int src;
    if (j < 1024) src = C_US + j; else if (j < 1280) src = C_QL + (j - 1024); else if (j < 1536) src = C_KL + (j - 1280);
    else if (j < 1568) { const int p = j - 1536; src = C_KR + ((p & 1) ? 16 + (p >> 1) : (p >> 1)); } else src = C_ZM + (j - 1568);
    return W[(size_t)k * INW + src]; } };
struct EP2 { bf16_t *US, *QL, *KL, *KR, *TM; float *ssq_q, *ssq_kv; const float* rope;
    __device__ __forceinline__ void e(int row, int j, float v0, float v1) const {
        if (j < 1024) { *(unsigned*)(US + ((size_t)(j >> 4) * NT + row) * 16 + (j & 15)) = pk2(v0, v1); }
        else if (j < 1280) { *(unsigned*)(QL + (size_t)row * 256 + (j - 1024)) = pk2(v0, v1); atomicAdd(ssq_q + row, v0 * v0 + v1 * v1); }
        else if (j < 1536) { *(unsigned*)(KL + (size_t)row * 256 + (j - 1280)) = pk2(v0, v1); atomicAdd(ssq_kv + row, v0 * v0 + v1 * v1); }
        else if (j < 1568) { const int p = j - 1536, i = p >> 1; const float cs = rope[(size_t)row * 32 + i], sn = rope[(size_t)row * 32 + 16 + i];
            *(unsigned*)(KR + (size_t)row * 32 + p) = pk2(v0 * cs - v1 * sn, v1 * cs + v0 * sn); }
        else { *(unsigned*)(TM + (size_t)row * 1024 + (j - 1568)) = pk2(siluf_(v0), siluf_(v1)); }
    } };

struct BL3q { const float* W; const float* g; __device__ __forceinline__ float b(int k, int j) const {
    int src; if (j < 1024) src = (j >> 6) * 96 + (j & 63); else { const int jj = j - 1024, h = jj >> 5, p = jj & 31; src = h * 96 + 64 + ((p & 1) ? 16 + (p >> 1) : (p >> 1)); }
    return W[(size_t)k * 1536 + src] * g[k]; } };
struct EP3q { bf16_t *QN, *QR; const float* ssq; const float* rope;
    __device__ __forceinline__ void e(int row, int j, float v0, float v1) const {
        const float rs = QSCALE / sqrtf(ssq[row] * (1.f / 256.f) + EPS); v0 *= rs; v1 *= rs;
        if (j < 1024) *(unsigned*)(QN + (size_t)row * 1024 + j) = pk2(v0, v1);
        else { const int jj = j - 1024, i = (jj & 31) >> 1; const float cs = rope[(size_t)row * 32 + i], sn = rope[(size_t)row * 32 + 16 + i];
            *(unsigned*)(QR + (size_t)row * 512 + jj) = pk2(v0 * cs - v1 * sn, v1 * cs + v0 * sn); }
    } };
struct BL3kv { const float* W; const float* g; __device__ __forceinline__ float b(int k, int j) const {
    const int src = (j < 1024) ? (j >> 6) * 128 + (j & 63) : ((j - 1024) >> 6) * 128 + 64 + (j & 63);
    return W[(size_t)k * 2048 + src] * g[k]; } };
struct EP3kv { bf16_t *KN, *VV; const float* ssq;
    __device__ __forceinline__ void e(int row, int j, float v0, float v1) const {
        const float rs = 1.f / sqrtf(ssq[row] * (1.f / 256.f) + EPS); v0 *= rs; v1 *= rs;
        if (j < 1024) *(unsigned*)(KN + (size_t)row * 1024 + j) = pk2(v0, v1); else *(unsigned*)(VV + (size_t)row * 1024 + (j - 1024)) = pk2(v0, v1);
    } };

__device__ __forceinline__ void ph4_attn(const Args& a, float* lds) {
    const bf16_t* QN = (const bf16_t*)(a.ws + WS_QN); const bf16_t* QR = (const bf16_t*)(a.ws + WS_QR); const bf16_t* KN = (const bf16_t*)(a.ws + WS_KN);
    const bf16_t* KR = (const bf16_t*)(a.ws + WS_KR); const bf16_t* VV = (const bf16_t*)(a.ws + WS_VV); bf16_t* TM = (bf16_t*)(a.ws + WS_TM);
    float* Kt = lds;
    float* Vt = lds + 64 * 100;
    const int tid = opq(threadIdx.x), wv = tid >> 6, half = wv >> 2;
    for (int item = blockIdx.x; item < NB * NH * 16; item += gridDim.x) {
        const int qb = item & 15, h = (item >> 4) & 15, b = item >> 8;
        const size_t tok = (size_t)b * SEQ + qb * 256 + (tid & 255);
        float q[96], o[32];
#pragma unroll
        for (int d = 0; d < 64; d += 2) { const unsigned w = *(const unsigned*)(QN + tok * 1024 + h * 64 + d); q[d] = bf2f(w); q[d + 1] = bf2f(w >> 16); }
#pragma unroll
        for (int d = 0; d < 32; d += 2) { const unsigned w = *(const unsigned*)(QR + tok * 512 + h * 32 + d); q[64 + d] = bf2f(w); q[64 + d + 1] = bf2f(w >> 16); }
#pragma unroll
        for (int d = 0; d < 32; ++d) o[d] = 0.f;
        float m = -1e30f, l = 0.f;
        const int mychunk = qb * 4 + (wv & 3), nkt = qb * 4 + 4;
        for (int kt = 0; kt < nkt; ++kt) {
            __syncthreads();
            const size_t kt0 = (size_t)b * SEQ + kt * 64;
            for (int e = tid; e < 64 * 32; e += NTHR) { const int key = e >> 5, d2 = (e & 31) * 2; const unsigned w = *(const unsigned*)(KN + (kt0 + key) * 1024 + h * 64 + d2); Kt[key * 100 + d2] = bf2f(w); Kt[key * 100 + d2 + 1] = bf2f(w >> 16); }
            for (int e = tid; e < 64 * 16; e += NTHR) { const int key = e >> 4, d2 = (e & 15) * 2; const unsigned w = *(const unsigned*)(KR + (kt0 + key) * 32 + d2); Kt[key * 100 + 64 + d2] = bf2f(w); Kt[key * 100 + 64 + d2 + 1] = bf2f(w >> 16); }
            for (int e = tid; e < 64 * 32; e += NTHR) { const int key = e >> 5, d2 = (e & 31) * 2; const unsigned w = *(const unsigned*)(VV + (kt0 + key) * 1024 + h * 64 + d2); Vt[key * 68 + d2] = bf2f(w); Vt[key * 68 + d2 + 1] = bf2f(w >> 16); }
            __syncthreads();
            if (kt <= mychunk) {
                for (int key = 0; key < 64; ++key) {
                    float s = 0.f;
#pragma unroll
                    for (int d = 0; d < 96; d += 4) { const f32x4 kk = *(const f32x4*)(Kt + key * 100 + d); s += q[d] * kk[0] + q[d + 1] * kk[1] + q[d + 2] * kk[2] + q[d + 3] * kk[3]; }
                    if (s > m) { const float f = exp2f(m - s); l *= f;
#pragma unroll
                        for (int d = 0; d < 32; ++d) o[d] *= f;
                        m = s; }
                    const float p = exp2f(s - m); l += p;
#pragma unroll
                    for (int d = 0; d < 32; d += 4) { const f32x4 vv = *(const f32x4*)(Vt + key * 68 + half * 32 + d); o[d] += p * vv[0]; o[d + 1] += p * vv[1]; o[d + 2] += p * vv[2]; o[d + 3] += p * vv[3]; }
                }
            }
        }
        const float il = 1.f / l;
#pragma unroll
        for (int d = 0; d < 32; d += 2) { unsigned* p = (unsigned*)(TM + tok * 1024 + h * 64 + half * 32 + d); const unsigned w = *p; *p = pk2(o[d] * il * bf2f(w), o[d + 1] * il * bf2f(w >> 16)); }
    }
}

__device__ __forceinline__ void ph5_ssm(const Args& a, float* lds) {
    const int tid = opq(threadIdx.x), lane = tid & 63, wv = tid >> 6;
    const bf16_t* US = (const bf16_t*)(a.ws + WS_US); bf16_t* YG = (bf16_t*)(a.ws + WS_YG);
    const float* abar = (const float*)(a.ws + WS_SSMC); const float* bbar = (const float*)(a.ws + WS_SSMC + 65536);
    const float* c_re = a.in[12]; const float* c_im = a.in[13]; const float* dsk = a.in[14];
    float* Xs = lds + wv * 4096;
    float* Cs = Xs + 1024; float* Us = Cs + 2048;
    for (int item = blockIdx.x * 8 + wv; item < NB * NG; item += gridDim.x * 8) {
        const int b = item / NG, g = item % NG;
        const float abr = abar[(g * NS + lane) * 2], abi = abar[(g * NS + lane) * 2 + 1];
        float bbr[16], bbi[16];
#pragma unroll
        for (int q = 0; q < 16; ++q) { bbr[q] = bbar[((size_t)(g * NS + lane) * 16 + q) * 2]; bbi[q] = bbar[((size_t)(g * NS + lane) * 16 + q) * 2 + 1]; }
        for (int p = 0; p < 16; ++p) { Cs[(p * 64 + lane) * 2] = c_re[((size_t)g * 16 + p) * 64 + lane]; Cs[(p * 64 + lane) * 2 + 1] = c_im[((size_t)g * 16 + p) * 64 + lane]; }
        float xr = 0.f, xi = 0.f;
        const bf16_t* ug = US + ((size_t)g * NT + (size_t)b * SEQ) * 16; bf16_t* yg = YG + ((size_t)g * NT + (size_t)b * SEQ) * 16;
        const int tt = lane >> 3, p0 = (lane & 7) * 2;
        const float d0 = dsk[g * 16 + p0], d1 = dsk[g * 16 + p0 + 1];
        for (int t0 = 0; t0 < SEQ; t0 += 8) {
            { const unsigned w = *(const unsigned*)(ug + (size_t)t0 * 16 + lane * 2); Us[lane * 2] = bf2f(w); Us[lane * 2 + 1] = bf2f(w >> 16); }
            asm volatile("s_waitcnt vmcnt(0) lgkmcnt(0)" ::: "memory");
#pragma unroll
            for (int t = 0; t < 8; ++t) {
                float bur = 0.f, bui = 0.f;
#pragma unroll
                for (int q = 0; q < 16; ++q) { const float u = Us[t * 16 + q]; bur += bbr[q] * u; bui += bbi[q] * u; }
                const float nr = abr * xr - abi * xi + bur, ni = abr * xi + abi * xr + bui; xr = nr; xi = ni;
                Xs[(t * 64 + lane) * 2] = xr; Xs[(t * 64 + lane) * 2 + 1] = xi;
            }
            asm volatile("s_waitcnt vmcnt(0) lgkmcnt(0)" ::: "memory");
            float y0 = 0.f, y1 = 0.f;
            for (int n = 0; n < 64; ++n) { const float vr = Xs[(tt * 64 + n) * 2], vi = Xs[(tt * 64 + n) * 2 + 1];
                y0 += Cs[(p0 * 64 + n) * 2] * vr - Cs[(p0 * 64 + n) * 2 + 1] * vi; y1 += Cs[((p0 + 1) * 64 + n) * 2] * vr - Cs[((p0 + 1) * 64 + n) * 2 + 1] * vi; }
            y0 += d0 * Us[tt * 16 + p0]; y1 += d1 * Us[tt * 16 + p0 + 1];
            *(unsigned*)(yg + (size_t)(t0 + tt) * 16 + p0) = pk2(gelu_tanh(y0), gelu_tanh(y1));
            asm volatile("s_waitcnt vmcnt(0) lgkmcnt(0)" ::: "memory");
        }
    }
}

struct BLzs { const float* W; __device__ __forceinline__ float b(int k, int j) const { return W[(size_t)k * INW + C_ZS + j]; } };
struct EPzs { bf16_t* ZS; __device__ __forceinline__ void e(int row, int j, float v0, float v1) const { *(unsigned*)(ZS + (size_t)row * 1024 + j) = pk2(siluf_(v0), siluf_(v1)); } };
struct BLglu { const float* W; __device__ __forceinline__ float b(int k, int j) const { return W[(size_t)k * 2048 + ((j & 1) ? 1024 + (j >> 1) : (j >> 1))]; } };
struct EPglu { bf16_t* TS; const bf16_t* ZS; const float* bias; __device__ __forceinline__ void e(int row, int j, float v0, float v1) const {
    const int jj = j >> 1; const float ga = v0 + bias[jj], gb = v1 + bias[1024 + jj]; TS[(size_t)row * 1024 + jj] = (bf16_t)f2bf(ga * sigmoidf_(gb) * bf2f(ZS[(size_t)row * 1024 + jj])); } };
struct BLgate { const float* W; __device__ __forceinline__ float b(int k, int j) const { return W[(size_t)k * INW + ((j & 1) ? C_GM + (j >> 1) : C_GS + (j >> 1))]; } };
struct EPgate { bf16_t *GS, *GM; __device__ __forceinline__ void e(int row, int j, float v0, float v1) const { const int jj = j >> 1; GS[(size_t)row * 1024 + jj] = (bf16_t)f2bf(sigmoidf_(v0)); GM[(size_t)row * 1024 + jj] = (bf16_t)f2bf(sigmoidf_(v1)); } };
struct BLplain { const float* W; int ldw; __device__ __forceinline__ float b(int k, int j) const { return W[(size_t)k * ldw + j]; } };
struct EPbs { float* P1; const bf16_t* GS; __device__ __forceinline__ void e(int row, int j, float v0, float v1) const {
    const unsigned w = *(const unsigned*)(GS + (size_t)row * 1024 + j); P1[(size_t)row * 1024 + j] = bf2f(w) * v0; P1[(size_t)row * 1024 + j + 1] = bf2f(w >> 16) * v1; } };
struct EPbm { const float* P1; const bf16_t* GM; bf16_t* MG; __device__ __forceinline__ void e(int row, int j, float v0, float v1) const {
    const unsigned w = *(const unsigned*)(GM + (size_t)row * 1024 + j); *(unsigned*)(MG + (size_t)row * 1024 + j) = pk2(P1[(size_t)row * 1024 + j] + bf2f(w) * v0, P1[(size_t)row * 1024 + j + 1] + bf2f(w >> 16) * v1); } };
struct EPout { float* O; __device__ __forceinline__ void e(int row, int j, float v0, float v1) const { O[(size_t)row * 1024 + j] = v0; O[(size_t)row * 1024 + j + 1] = v1; } };

__device__ __forceinline__ void ph_final(const Args& a) {
    const int tid_ = opq(threadIdx.x), lane = tid_ & 63, gw = blockIdx.x * (NTHR / 64) + (tid_ >> 6), ngw = gridDim.x * (NTHR / 64);
    const float* x = a.in[0]; const float* g_post = a.in[24]; const float* mod = (const float*)(a.ws + WS_MOD); const float* OF = (const float*)(a.ws + WS_OUTF);
    for (int m = gw; m < NT; m += ngw) {
        const int b = m / SEQ; const f32x4* orow = (const f32x4*)(OF + (size_t)m * DM) + lane; const f32x4* xr = (const f32x4*)(x + (size_t)m * DM) + lane;
        f32x4 v[4]; float s = 0.f;
#pragma unroll
        for (int j = 0; j < 4; ++j) { v[j] = orow[64 * j]; s += (v[j].x * v[j].x + v[j].y * v[j].y) + (v[j].z * v[j].z + v[j].w * v[j].w); }
        const float rstd = 1.f / sqrtf(wave_sum(s) * (1.f / DM) + EPS);
        f32x4* o = (f32x4*)(a.out + (size_t)m * DM) + lane;
#pragma unroll
        for (int j = 0; j < 4; ++j) { const int k = 256 * j + 4 * lane; const f32x4 g = *(const f32x4*)(g_post + k), gt = *(const f32x4*)(mod + b * 3072 + 2048 + k);
            o[64 * j] = xr[64 * j] + gt * (v[j] * rstd * g); }
    }
}

constexpr int NPHASE = 11;
__global__ void __launch_bounds__(NTHR, 2) mk_fwd(Args a) {
    extern __shared__ __attribute__((aligned(16))) unsigned char lds_raw[];
    float* lds = (float*)lds_raw;
    unsigned char* ws = a.ws;
#define SEAM(k) do { if (a.ph_lo <= (k) && (k) + 1 < a.ph_hi) { cg::this_grid().sync(); } } while (0)
#define IN(k) (a.ph_lo <= (k) && (k) < a.ph_hi)
    if (IN(0)) { ph0_prep(a); } SEAM(0);
    if (IN(1)) { ph1_hnorm(a); } SEAM(1);
    if (IN(2)) {
        ARow al{(const bf16_t*)(ws + WS_HB), 1024}; BL2 bl{a.in[6]};
        EP2 ep{(bf16_t*)(ws + WS_US), (bf16_t*)(ws + WS_QL), (bf16_t*)(ws + WS_KL), (bf16_t*)(ws + WS_KR), (bf16_t*)(ws + WS_TM), (float*)(ws + WS_CTL), (float*)(ws + WS_CTL + 131072), (const float*)(ws + WS_ROPE)};
        gemm_o(lds, NT, 2592, 1024, al, bl, ep);
    } SEAM(2);
    if (IN(3)) {
        { ARow al{(const bf16_t*)(ws + WS_QL), 256}; BL3q bl{a.in[18], a.in[17]}; EP3q ep{(bf16_t*)(ws + WS_QN), (bf16_t*)(ws + WS_QR), (const float*)(ws + WS_CTL), (const float*)(ws + WS_ROPE)};
          gemm_o(lds, NT, 1536, 256, al, bl, ep); }
        { ARow al{(const bf16_t*)(ws + WS_KL), 256}; BL3kv bl{a.in[20], a.in[19]}; EP3kv ep{(bf16_t*)(ws + WS_KN), (bf16_t*)(ws + WS_VV), (const float*)(ws + WS_CTL + 131072)};
          gemm_o(lds, NT, 2048, 256, al, bl, ep); }
    } SEAM(3);
    if (IN(4)) { ph4_attn(a, lds); } SEAM(4);
    if (IN(5)) {
        { ARow al{(const bf16_t*)(ws + WS_HB), 1024}; BLzs bl{a.in[6]}; EPzs ep{(bf16_t*)(ws + WS_ZS)}; gemm_o(lds, NT, 1024, 1024, al, bl, ep); }
        __syncthreads();
        ph5_ssm(a, lds);
    } SEAM(5);
    if (IN(6)) {
        { AGrp al{(const bf16_t*)(ws + WS_YG)}; BLglu bl{a.in[15]}; EPglu ep{(bf16_t*)(ws + WS_TS), (const bf16_t*)(ws + WS_ZS), a.in[16]}; gemm_o(lds, NT, 2048, 1024, al, bl, ep); }
        { ARow al{(const bf16_t*)(ws + WS_HB), 1024}; BLgate bl{a.in[6]}; EPgate ep{(bf16_t*)(ws + WS_GS), (bf16_t*)(ws + WS_GM)}; gemm_o(lds, NT, 2048, 1024, al, bl, ep); }
    } SEAM(6);
    if (IN(7)) { ARow al{(const bf16_t*)(ws + WS_TS), 1024}; BLplain bl{a.in[21], 1024}; EPbs ep{(float*)(ws + WS_P1), (const bf16_t*)(ws + WS_GS)}; gemm_o(lds, NT, 1024, 1024, al, bl, ep); } SEAM(7);
    if (IN(8)) { ARow al{(const bf16_t*)(ws + WS_TM), 1024}; BLplain bl{a.in[22], 1024}; EPbm ep{(const float*)(ws + WS_P1), (const bf16_t*)(ws + WS_GM), (bf16_t*)(ws + WS_MG)}; gemm_o(lds, NT, 1024, 1024, al, bl, ep); } SEAM(8);
    if (IN(9)) { ARow al{(const bf16_t*)(ws + WS_MG), 1024}; BLplain bl{a.in[23], 1024}; EPout ep{(float*)(ws + WS_OUTF)}; gemm_o(lds, NT, 1024, 1024, al, bl, ep); } SEAM(9);
    if (IN(10)) { ph_final(a); }
#undef SEAM
#undef IN
}

extern "C" void kernel_launch(void* const* d_in, const int* in_sizes, int n_in, void* d_out, int out_size, void* d_ws, size_t ws_size, hipStream_t stream) {
    static int grid = 0;
    if (grid == 0) {
        if (n_in != 25 || out_size != NT * DM || ws_size < WS_END) { fprintf(stderr, "kernel_launch: unexpected shapes n_in %d out %d ws %zu\n", n_in, out_size, ws_size); grid = -1; return; }
        int dev = 0, cus = 0, per_cu = 0;
        hipGetDevice(&dev); hipDeviceGetAttribute(&cus, hipDeviceAttributeMultiprocessorCount, dev);
        hipFuncSetAttribute((const void*)mk_fwd, hipFuncAttributeMaxDynamicSharedMemorySize, LDS_BYTES);
        hipOccupancyMaxActiveBlocksPerMultiprocessor(&per_cu, (const void*)mk_fwd, NTHR, LDS_BYTES);
        (void)hipGetLastError();
        if (per_cu < 1) per_cu = 1;
        grid = cus * 1;
        fprintf(stderr, "kernel_launch: cus %d per_cu %d grid %d ws %zu\n", cus, per_cu, grid, ws_size);
    }
    if (grid < 0) return;
    hipMemsetAsync((char*)d_ws + WS_CTL, 0, 1 * MiB, stream);
    Args a{};
    for (int i = 0; i < 25; ++i) a.in[i] = (const float*)d_in[i];
    a.out = (float*)d_out; a.ws = (unsigned char*)d_ws;
#if MK_SINGLE
    a.ph_lo = 0; a.ph_hi = NPHASE;
    void* args[] = {&a};
    hipError_t e = hipLaunchCooperativeKernel((const void*)mk_fwd, dim3(grid), dim3(NTHR), args, LDS_BYTES, stream);
    if (e != hipSuccess) fprintf(stderr, "cooperative launch failed: %s (grid %d)\n", hipGetErrorString(e), grid);
#else
    for (int p = 0; p < NPHASE; ++p) { a.ph_lo = p; a.ph_hi = p + 1; hipLaunchKernelGGL(mk_fwd, dim3(grid), dim3(NTHR), LDS_BYTES, stream, a); }
#endif
}
```

```cpp
#include <hip/hip_runtime.h>
#include <hip/hip_cooperative_groups.h>
#include <cstdint>
#include <cstdio>
namespace cg = cooperative_groups;

#ifndef MK_SINGLE
#define MK_SINGLE 1
#endif
#ifndef FAST_ALL
#define FAST_ALL 1
#endif
#ifndef FAST_G1A
#define FAST_G1A FAST_ALL
#endif
#ifndef FAST_G2
#define FAST_G2 FAST_ALL
#endif
#ifndef FAST_ZS
#define FAST_ZS FAST_ALL
#endif
#ifndef FAST_GLU
#define FAST_GLU FAST_ALL
#endif
#ifndef FAST_MERGE
#define FAST_MERGE FAST_ALL
#endif
#ifndef FAST_OUT
#define FAST_OUT FAST_ALL
#endif

typedef unsigned short bf16_t;
typedef float f32x4 __attribute__((ext_vector_type(4)));
typedef unsigned u32x4 __attribute__((ext_vector_type(4)));
typedef unsigned u32x2 __attribute__((ext_vector_type(2)));

constexpr int NB = 8, SEQ = 4096, DM = 1024, NT = NB * SEQ;
constexpr int INW = 5664;
constexpr int C_US = 0, C_ZS = 1024, C_QL = 2048, C_KL = 2304, C_KR = 2560, C_ZM = 2592, C_GS = 3616, C_GM = 4640;
constexpr int NG = 64, GP = 16, NS = 64;
constexpr int NH = 16;
constexpr float EPS = 1e-6f;
constexpr float QSCALE = 0.10206207261596577f * 1.4426950408889634f;
constexpr int NTHR = 512;
constexpr int LDS_BYTES = 147456;

constexpr size_t MiB = 1u << 20;
constexpr size_t WS_CTL = 0;
constexpr size_t WS_MOD = 1 * MiB;
constexpr size_t WS_ROPE = 2 * MiB;
constexpr size_t WS_SSMC = 6 * MiB;
constexpr size_t WS_SSQ = 0;
constexpr size_t WS_WINA = 8 * MiB;
constexpr size_t WS_WZS = 14 * MiB;
constexpr size_t WS_WGATE = 16 * MiB;
constexpr size_t WS_WGLU = 20 * MiB;
constexpr size_t WS_WQ = 24 * MiB;
constexpr size_t WS_WKV = 25 * MiB;
constexpr size_t WS_WBR = 26 * MiB;
constexpr size_t WS_WOUT = 30 * MiB;
constexpr size_t WS_SQ = 274 * MiB;
constexpr size_t WS_SKV = 275 * MiB;
constexpr size_t WS_SO = 276 * MiB;
constexpr size_t WS_HB = 32 * MiB;
constexpr size_t WS_US = 96 * MiB;
constexpr size_t WS_TM = 160 * MiB;
constexpr size_t WS_QL = 224 * MiB;
constexpr size_t WS_KL = 240 * MiB;
constexpr size_t WS_KR = 256 * MiB;
constexpr size_t WS_QN = 288 * MiB;
constexpr size_t WS_QR = 352 * MiB;
constexpr size_t WS_KN = 384 * MiB;
constexpr size_t WS_VV = 448 * MiB;
constexpr size_t WS_ZS = 288 * MiB;
constexpr size_t WS_YG = 352 * MiB;
constexpr size_t WS_TS = 416 * MiB;
constexpr size_t WS_GS = 96 * MiB;
constexpr size_t WS_GM = 224 * MiB;
constexpr size_t WS_P1 = 288 * MiB;
constexpr size_t WS_MG = 32 * MiB;
constexpr size_t WS_OUTF = 288 * MiB;
constexpr size_t WS_RAT = 96 * MiB;
constexpr size_t WS_SGM = 224 * MiB;
constexpr size_t WS_OUTB = 288 * MiB;
constexpr size_t WS_END = 512 * MiB;

__device__ __forceinline__ unsigned f2bf(float f) { unsigned u = __builtin_bit_cast(unsigned, f); return (u + 0x7fffu + ((u >> 16) & 1u)) >> 16; }
__device__ __forceinline__ float bf2f(unsigned h) { return __builtin_bit_cast(float, (h & 0xffffu) << 16); }
__device__ __forceinline__ unsigned pk2(float lo, float hi) { return f2bf(lo) | (f2bf(hi) << 16); }
__device__ __forceinline__ float sigmoidf_(float v) { return 1.f / (1.f + __expf(-v)); }
__device__ __forceinline__ float siluf_(float v) { return v / (1.f + __expf(-v)); }
__device__ __forceinline__ float gelu_tanh(float v) { const float u = 0.7978845608028654f * (v + 0.044715f * v * v * v); return 0.5f * v * (1.f + tanhf(u)); }
__device__ __forceinline__ float wave_sum(float v) {
#pragma unroll
    for (int o = 1; o < 64; o <<= 1) v += __shfl_xor(v, o);
    return v;
}

__device__ __forceinline__ int opq(int x) { asm volatile("" : "+v"(x)); return x; }
struct Args { const float* in[25]; float* out; unsigned char* ws; int ph_lo, ph_hi; };

template <class AL, class BL, class EP>
__device__ __forceinline__ void gemm_o(float* lds, int M, int N, int K, const AL& al, const BL& bl, const EP& ep) {
    float* As = lds;
    float* Bs = lds + 16 * 132;
    const int tid = opq(threadIdx.x), ty = tid >> 4, tx = tid & 15;
    const int ntn = (N + 127) / 128, ntm = M / 128, ntiles = ntm * ntn;
    for (int tile = blockIdx.x; tile < ntiles; tile += gridDim.x) {
        const int tm = tile / ntn, tn = tile % ntn;
        const int row0 = tm * 128, col0 = tn * 128;
        float acc[4][8];
#pragma unroll
        for (int i = 0; i < 4; ++i)
#pragma unroll
            for (int j = 0; j < 8; ++j) acc[i][j] = 0.f;
        for (int k0 = 0; k0 < K; k0 += 16) {
            {
                const int r = tid >> 2, kk = (tid & 3) * 4;
                const bf16_t* p = al.a4(row0 + r, k0 + kk);
                const u32x2 w = *(const u32x2*)p;
                As[(kk + 0) * 132 + r] = bf2f(w.x); As[(kk + 1) * 132 + r] = bf2f(w.x >> 16);
                As[(kk + 2) * 132 + r] = bf2f(w.y); As[(kk + 3) * 132 + r] = bf2f(w.y >> 16);
            }
            {
                const int kk = tid >> 5, c = (tid & 31) * 4;
#pragma unroll
                for (int j = 0; j < 4; ++j) { const int col = col0 + c + j; Bs[kk * 132 + c + j] = (col < N) ? bl.b(k0 + kk, col) : 0.f; }
            }
            __syncthreads();
#pragma unroll 2
            for (int kk = 0; kk < 16; ++kk) {
                const f32x4 a = *(const f32x4*)(As + kk * 132 + ty * 4);
                const f32x4 b0 = *(const f32x4*)(Bs + kk * 132 + tx * 8), b1 = *(const f32x4*)(Bs + kk * 132 + tx * 8 + 4);
#pragma unroll
                for (int i = 0; i < 4; ++i) {
                    acc[i][0] += a[i] * b0[0]; acc[i][1] += a[i] * b0[1]; acc[i][2] += a[i] * b0[2]; acc[i][3] += a[i] * b0[3];
                    acc[i][4] += a[i] * b1[0]; acc[i][5] += a[i] * b1[1]; acc[i][6] += a[i] * b1[2]; acc[i][7] += a[i] * b1[3];
                }
            }
            __syncthreads();
        }
#pragma unroll
        for (int i = 0; i < 4; ++i)
#pragma unroll
            for (int j = 0; j < 8; j += 2) { const int col = col0 + tx * 8 + j; if (col < N) ep.e(row0 + ty * 4 + i, col, acc[i][j], acc[i][j + 1]); }
    }
}

struct ARow { const bf16_t* A; int lda; __device__ __forceinline__ const bf16_t* a4(int row, int k) const { return A + (size_t)row * lda + k; } };
struct AGrp { const bf16_t* A; __device__ __forceinline__ const bf16_t* a4(int row, int k) const { return A + ((size_t)(k >> 4) * NT + row) * 16 + (k & 15); } };

namespace pg8 {
#define PG8_LAS __attribute__((address_space(3)))
typedef PG8_LAS unsigned char PG8_LAS_T;
typedef short bf16x8 __attribute__((ext_vector_type(8)));
constexpr int BM = 256, BK = 64, HALF = 128, HTB = HALF * BK * 2, STAGE_BYTES = 8 * HTB, NXCD = 8, WGM = 8;
constexpr unsigned PLANE = (unsigned)NT * 32u;

__host__ __device__ __forceinline__ int lds_byte(int r, int c) { const int st = (r >> 4) * 2 + (c >> 5), rr = r & 15, cc = c & 31, ob = rr * 64 + cc * 2; return st * 1024 + (ob ^ (((ob >> 9) & 1) << 5)); }
__host__ __device__ __forceinline__ void stage_rc(int b, int& R, int& C) { const int st = b / 1024, sb = b % 1024, swz = sb ^ (((sb >> 9) & 1) << 5); R = (st >> 1) * 16 + swz / 64; C = (st & 1) * 32 + (swz % 64) / 2; }
__host__ __device__ __forceinline__ int perm32(int rho) { const int n = rho >> 4, i = rho & 15; return 8 * (i >> 2) + 4 * n + (i & 3); }

struct Unit { int pm, pn; };
struct Gemm { const char* A; const char* A2; const char* Bt; int N, K, lda, amode, tmid; };

struct StaticOrder {
    int nM, nN, nwg, G, c;
    __device__ void init(int M, int N, int G_, int c_) { nM = M / BM; nN = N / BM; nwg = nM * nN; G = G_; c = c_; }
    __device__ bool next(int i, Unit& u) const {
        const long L = (long)i * G + c; if (L >= nwg) return false;
        int wgid = (int)L; { const int q = nwg / NXCD, r = nwg % NXCD, xcd = wgid % NXCD, off = wgid / NXCD; wgid = (xcd < r ? xcd * (q + 1) : r * (q + 1) + (xcd - r) * q) + off; }
        const int nig = WGM * nN, gid = wgid / nig, fm = gid * WGM, gsz = (nM - fm) < WGM ? (nM - fm) : WGM;
        u.pm = fm + ((wgid % nig) % gsz); u.pn = (wgid % nig) / gsz; return true;
    }
};

typedef f32x4 Acc[2][2][4][2];

template <class Epi, class Sched>
__device__ __forceinline__ void gemm_phase(PG8_LAS unsigned char* lds, const Gemm g, const Sched& S, const Epi& E) {
    const int tid = opq(threadIdx.x), wid = __builtin_amdgcn_readfirstlane(tid >> 6), lane = tid & 63, wr = wid >> 2, wc = wid & 3, fr = lane & 15, fq = lane >> 4;
    const int K = g.K, nt = K / BK;
    unsigned voffA[2], voffB[2];
#pragma unroll
    for (int i = 0; i < 2; ++i) { int R, C; stage_rc(tid * 16 + i * 8192, R, C); const int Rb = (R & ~31) + perm32(R & 31);
        voffA[i] = g.amode == 0 ? (unsigned)(R * g.lda + C) * 2u : (unsigned)(C >> 4) * PLANE + (unsigned)R * 32u + (unsigned)(C & 15) * 2u;
        voffB[i] = (unsigned)(Rb * K + C) * 2u; }
    const size_t akstep = g.amode == 0 ? (size_t)(BK * 2) : (size_t)4 * PLANE;
    const size_t ahstep = g.amode == 0 ? (size_t)HALF * g.lda * 2 : (size_t)HALF * 32;
    const size_t atstep = 2 * ahstep;
    const size_t bkstep = (size_t)(BK * 2), bhstep = (size_t)HALF * K * 2, btstep = 2 * bhstep;
    const unsigned ldsw = (unsigned)wid * 1024u;
    const int aoff = lds_byte(wr * 64 + fr, fq * 8), boff = lds_byte(wc * 32 + fr, fq * 8);
    const int tmid = g.tmid;
    const char* const Alo = g.A; const char* const Ahi = g.A2 - (size_t)tmid * akstep;
#define PG8_AP(pm_, t_) ((((t_) < tmid) ? Alo : Ahi) + (size_t)(pm_) * atstep + (size_t)(t_) * akstep)
#define PG8_SA(b, h) (((b) * 2 + (h)) * HTB)
#define PG8_SB(b, h) ((4 + (b) * 2 + (h)) * HTB)
#define PG8_STAGE(bufoff, gbase, voff) do { _Pragma("unroll") for (int _i = 0; _i < 2; ++_i) \
        __builtin_amdgcn_global_load_lds((const unsigned*)((const char*)(gbase) + (voff)[_i]), (PG8_LAS unsigned*)(lds + (bufoff) + ldsw + _i * 8192), 16, 0, 0); } while (0)
#define PG8_LDA(dst, b, h) do { _Pragma("unroll") for (int m = 0; m < 4; ++m) _Pragma("unroll") for (int k = 0; k < 2; ++k) dst[m][k] = *(const PG8_LAS bf16x8*)(lds + PG8_SA(b, h) + aoff + m * 2048 + k * 1024); } while (0)
#define PG8_LDB(dst, b, h) do { _Pragma("unroll") for (int n = 0; n < 2; ++n) _Pragma("unroll") for (int k = 0; k < 2; ++k) dst[n][k] = *(const PG8_LAS bf16x8*)(lds + PG8_SB(b, h) + boff + n * 2048 + k * 1024); } while (0)
#define PG8_MMA(ai, bj, At, Bt) do { __builtin_amdgcn_s_setprio(1); _Pragma("unroll") for (int m = 0; m < 4; ++m) _Pragma("unroll") for (int n = 0; n < 2; ++n) _Pragma("unroll") for (int k = 0; k < 2; ++k) \
        acc[ai][bj][m][n] = __builtin_amdgcn_mfma_f32_16x16x32_bf16(Bt[n][k], At[m][k], acc[ai][bj][m][n], 0, 0, 0); __builtin_amdgcn_s_setprio(0); } while (0)
#define PG8_WAIT_V(n) asm volatile("s_waitcnt vmcnt(" #n ")" ::: "memory")
#define PG8_WAIT_L(n) asm volatile("s_waitcnt lgkmcnt(" #n ")" ::: "memory")
#define PG8_BAR __builtin_amdgcn_s_barrier()
#define PG8_SCHED __builtin_amdgcn_sched_barrier(0)
    Unit cur, nxt; int ui = 0;
    if (!S.next(0, cur)) return;
    Acc acc;
#pragma unroll
    for (int a = 0; a < 2; ++a)
#pragma unroll
        for (int b = 0; b < 2; ++b)
#pragma unroll
            for (int m = 0; m < 4; ++m)
#pragma unroll
                for (int n = 0; n < 2; ++n) acc[a][b][m][n] = (f32x4){0.f, 0.f, 0.f, 0.f};
    bf16x8 At[4][2], B0[2][2], B1[2][2];
    const char* cB = g.Bt + (size_t)cur.pn * btstep;
    {
        const char* cA0 = PG8_AP(cur.pm, 0); const char* cA1 = PG8_AP(cur.pm, 1);
        PG8_STAGE(PG8_SB(0, 0), cB, voffB); PG8_STAGE(PG8_SB(0, 1), cB + bhstep, voffB); PG8_STAGE(PG8_SA(0, 0), cA0, voffA); PG8_STAGE(PG8_SA(0, 1), cA0 + ahstep, voffA);
        if (wr == 1) PG8_BAR;
        PG8_WAIT_V(2); PG8_BAR;
        PG8_STAGE(PG8_SB(1, 0), cB + bkstep, voffB); PG8_STAGE(PG8_SA(1, 0), cA1, voffA); PG8_STAGE(PG8_SB(1, 1), cB + bhstep + bkstep, voffB);
        PG8_WAIT_V(6); PG8_BAR;
    }
    for (;;) {
        const bool has_next = S.next(ui + 1, nxt);
        const int npm = has_next ? nxt.pm : cur.pm;
        const char* nB = has_next ? g.Bt + (size_t)nxt.pn * btstep : cB;
#pragma unroll 1
        for (int t = 0; t < nt; t += 2) {
            const bool last = (t == nt - 2);
            if constexpr (Epi::HAS_MID) { if (t == tmid) E.mid(acc, cur, wr, wc, fr, fq); }
            const char* a1 = PG8_AP(cur.pm, t + 1);
            const char* a2 = last ? PG8_AP(npm, 0) : PG8_AP(cur.pm, t + 2);
            const char* a3 = last ? PG8_AP(npm, 1) : PG8_AP(cur.pm, t + 3);
            const char* b2 = last ? nB : cB + (size_t)(t + 2) * bkstep; const char* b3 = b2 + bkstep;
            PG8_LDB(B0, 0, 0); PG8_LDB(B1, 0, 1); PG8_SCHED; PG8_LDA(At, 0, 0); PG8_STAGE(PG8_SA(1, 1), a1 + ahstep, voffA);
            PG8_WAIT_V(8); PG8_WAIT_L(0); PG8_BAR; PG8_MMA(0, 0, At, B0); PG8_MMA(0, 1, At, B1); PG8_BAR; PG8_SCHED;
            PG8_LDA(At, 0, 1); PG8_STAGE(PG8_SB(0, 0), b2, voffB); PG8_STAGE(PG8_SB(0, 1), b2 + bhstep, voffB); PG8_STAGE(PG8_SA(0, 0), a2, voffA);
            PG8_WAIT_V(8); PG8_WAIT_L(0); PG8_BAR; PG8_MMA(1, 0, At, B0); PG8_MMA(1, 1, At, B1); PG8_BAR; PG8_SCHED;
            PG8_LDB(B0, 1, 0); PG8_LDB(B1, 1, 1); PG8_SCHED; PG8_LDA(At, 1, 0); PG8_STAGE(PG8_SA(0, 1), a2 + ahstep, voffA);
            PG8_WAIT_V(8); PG8_WAIT_L(0); PG8_BAR; PG8_MMA(0, 0, At, B0); PG8_MMA(0, 1, At, B1); PG8_BAR; PG8_SCHED;
            PG8_LDA(At, 1, 1); PG8_STAGE(PG8_SB(1, 0), b3, voffB); PG8_STAGE(PG8_SB(1, 1), b3 + bhstep, voffB); PG8_STAGE(PG8_SA(1, 0), a3, voffA);
            PG8_WAIT_V(8); PG8_WAIT_L(0); PG8_BAR; PG8_MMA(1, 0, At, B0); PG8_MMA(1, 1, At, B1); PG8_BAR; PG8_SCHED;
        }
        if (wr == 0) PG8_BAR;
        E(acc, cur, wr, wc, fr, fq);
        if (!has_next) break;
#pragma unroll
        for (int a = 0; a < 2; ++a)
#pragma unroll
            for (int b = 0; b < 2; ++b)
#pragma unroll
                for (int m = 0; m < 4; ++m)
#pragma unroll
                    for (int n = 0; n < 2; ++n) acc[a][b][m][n] = (f32x4){0.f, 0.f, 0.f, 0.f};
        cur = nxt; cB = nB; ++ui;
        if (wr == 1) PG8_BAR;
    }
    PG8_WAIT_V(0);
    PG8_BAR;
#undef PG8_AP
#undef PG8_SA
#undef PG8_SB
#undef PG8_STAGE
#undef PG8_LDA
#undef PG8_LDB
#undef PG8_MMA
#undef PG8_WAIT_V
#undef PG8_WAIT_L
#undef PG8_BAR
#undef PG8_SCHED
}

__device__ __forceinline__ unsigned cvt_pk_bf16(float lo, float hi) { unsigned r; asm volatile("v_cvt_pk_bf16_f32 %0, %1, %2" : "=v"(r) : "v"(lo), "v"(hi)); return r; }
__device__ __forceinline__ u32x4 pack8(const f32x4 a, const f32x4 b) { u32x4 w; w.x = cvt_pk_bf16(a[0], a[1]); w.y = cvt_pk_bf16(a[2], a[3]); w.z = cvt_pk_bf16(b[0], b[1]); w.w = cvt_pk_bf16(b[2], b[3]); return w; }
__device__ __forceinline__ void unpack8(const u32x4 w, f32x4& a, f32x4& b) { a = (f32x4){bf2f(w.x), bf2f(w.x >> 16), bf2f(w.y), bf2f(w.y >> 16)}; b = (f32x4){bf2f(w.z), bf2f(w.z >> 16), bf2f(w.w), bf2f(w.w >> 16)}; }
__device__ __forceinline__ f32x4 silu4(const f32x4 v) { return (f32x4){siluf_(v[0]), siluf_(v[1]), siluf_(v[2]), siluf_(v[3])}; }
__device__ __forceinline__ f32x4 sig4(const f32x4 v) { return (f32x4){sigmoidf_(v[0]), sigmoidf_(v[1]), sigmoidf_(v[2]), sigmoidf_(v[3])}; }
__device__ __forceinline__ float ssq4(const f32x4 v) { return (v[0] * v[0] + v[1] * v[1]) + (v[2] * v[2] + v[3] * v[3]); }
__device__ __forceinline__ void rope8(f32x4& a, f32x4& b, const f32x4 cs, const f32x4 sn) {
    const f32x4 a0 = a, b0 = b;
    a[0] = a0[0] * cs[0] - a0[1] * sn[0]; a[1] = a0[1] * cs[0] + a0[0] * sn[0]; a[2] = a0[2] * cs[1] - a0[3] * sn[1]; a[3] = a0[3] * cs[1] + a0[2] * sn[1];
    b[0] = b0[0] * cs[2] - b0[1] * sn[2]; b[1] = b0[1] * cs[2] + b0[0] * sn[2]; b[2] = b0[2] * cs[3] - b0[3] * sn[3]; b[3] = b0[3] * cs[3] + b0[2] * sn[3];
}
#define EPI_ROWS(...) _Pragma("unroll") for (int ai = 0; ai < 2; ++ai) _Pragma("unroll") for (int m = 0; m < 4; ++m) { const int row = u.pm * BM + ai * HALF + wr * 64 + m * 16 + fr; __VA_ARGS__ if (m & 1) asm volatile("" ::: "memory"); }

struct EpiG1a {
    static constexpr bool HAS_MID = false;
    bf16_t *US, *TM, *QL, *KL, *KR; float *SQ, *SKV; const float* rope;
    __device__ __forceinline__ void operator()(const Acc& acc, const Unit& u, int wr, int wc, int fr, int fq) const {
        const int pn = u.pn, cw = wc * 32 + 8 * fq;
        if (pn < 4) { EPI_ROWS(
            _Pragma("unroll") for (int bj = 0; bj < 2; ++bj) { const int c = pn * 256 + bj * 128 + cw;
                *(u32x4*)(US + ((size_t)(c >> 4) * NT + row) * 16 + (c & 15)) = pack8(acc[ai][bj][m][0], acc[ai][bj][m][1]); } ) }
        else if (pn < 8) { EPI_ROWS(
            _Pragma("unroll") for (int bj = 0; bj < 2; ++bj) { const int c = (pn - 4) * 256 + bj * 128 + cw;
                *(u32x4*)(TM + (size_t)row * 1024 + c) = pack8(silu4(acc[ai][bj][m][0]), silu4(acc[ai][bj][m][1])); } ) }
        else if (pn < 10) { bf16_t* dst = pn == 8 ? QL : KL; float* sp = pn == 8 ? SQ : SKV;
            EPI_ROWS( float s = 0.f;
            _Pragma("unroll") for (int bj = 0; bj < 2; ++bj) { const int c = bj * 128 + cw; s += ssq4(acc[ai][bj][m][0]) + ssq4(acc[ai][bj][m][1]);
                *(u32x4*)(dst + (size_t)row * 256 + c) = pack8(acc[ai][bj][m][0], acc[ai][bj][m][1]); }
            s += __shfl_xor(s, 16); s += __shfl_xor(s, 32); if (fq == 0) sp[(size_t)row * 4 + wc] = s; ) }
        else if (wc == 0) { EPI_ROWS(
            const f32x4 cs = *(const f32x4*)(rope + (size_t)row * 32 + 4 * fq), sn = *(const f32x4*)(rope + (size_t)row * 32 + 16 + 4 * fq);
            f32x4 a = acc[ai][0][m][0], b = acc[ai][0][m][1]; rope8(a, b, cs, sn);
            *(u32x4*)(KR + (size_t)row * 32 + 8 * fq) = pack8(a, b); ) }
    }
};
struct EpiG2q {
    static constexpr bool HAS_MID = false;
    bf16_t *QN, *QR; const float* SQ; const float* rope;
    __device__ __forceinline__ void operator()(const Acc& acc, const Unit& u, int wr, int wc, int fr, int fq) const {
        const int pn = u.pn, cw = wc * 32 + 8 * fq;
        float rsv[2][4];
        EPI_ROWS( const f32x4 sp = *(const f32x4*)(SQ + (size_t)row * 4); rsv[ai][m] = QSCALE / sqrtf(((sp[0] + sp[1]) + (sp[2] + sp[3])) * (1.f / 256.f) + EPS); )
        if (pn < 4) { EPI_ROWS( const float rs = rsv[ai][m];
                _Pragma("unroll") for (int bj = 0; bj < 2; ++bj) { const int c = pn * 256 + bj * 128 + cw; *(u32x4*)(QN + (size_t)row * 1024 + c) = pack8(acc[ai][bj][m][0] * rs, acc[ai][bj][m][1] * rs); } )
        } else { EPI_ROWS( const float rs = rsv[ai][m];
                const f32x4 cs = *(const f32x4*)(rope + (size_t)row * 32 + 4 * fq), sn = *(const f32x4*)(rope + (size_t)row * 32 + 16 + 4 * fq);
                _Pragma("unroll") for (int bj = 0; bj < 2; ++bj) { const int c = (pn - 4) * 256 + bj * 128 + cw; f32x4 a = acc[ai][bj][m][0] * rs, b = acc[ai][bj][m][1] * rs; rope8(a, b, cs, sn);
                    *(u32x4*)(QR + (size_t)row * 512 + c) = pack8(a, b); } ) }
    }
};
struct EpiG2kv {
    static constexpr bool HAS_MID = false;
    bf16_t *KN, *VV; const float* SKV;
    __device__ __forceinline__ void operator()(const Acc& acc, const Unit& u, int wr, int wc, int fr, int fq) const {
        const int pn = u.pn, cw = wc * 32 + 8 * fq; bf16_t* dst = pn < 4 ? KN : VV;
        float rsv[2][4];
        EPI_ROWS( const f32x4 sp = *(const f32x4*)(SKV + (size_t)row * 4); rsv[ai][m] = 1.f / sqrtf(((sp[0] + sp[1]) + (sp[2] + sp[3])) * (1.f / 256.f) + EPS); )
        EPI_ROWS( const float rs = rsv[ai][m];
            _Pragma("unroll") for (int bj = 0; bj < 2; ++bj) { const int c = (pn & 3) * 256 + bj * 128 + cw; *(u32x4*)(dst + (size_t)row * 1024 + c) = pack8(acc[ai][bj][m][0] * rs, acc[ai][bj][m][1] * rs); } )
    }
};
struct EpiZs {
    static constexpr bool HAS_MID = false;
    bf16_t* ZS;
    __device__ __forceinline__ void operator()(const Acc& acc, const Unit& u, int wr, int wc, int fr, int fq) const {
        const int cw = wc * 32 + 8 * fq;
        EPI_ROWS( _Pragma("unroll") for (int bj = 0; bj < 2; ++bj) { const int c = u.pn * 256 + bj * 128 + cw; *(u32x4*)(ZS + (size_t)row * 1024 + c) = pack8(silu4(acc[ai][bj][m][0]), silu4(acc[ai][bj][m][1])); } )
    }
};
struct EpiGlu {
    static constexpr bool HAS_MID = false;
    bf16_t* TS; const bf16_t* ZS; const float* bias;
    __device__ __forceinline__ void operator()(const Acc& acc, const Unit& u, int wr, int wc, int fr, int fq) const {
        const int jj = u.pn * 128 + wc * 32 + 8 * fq;
        const f32x4 ba0 = *(const f32x4*)(bias + jj), ba1 = *(const f32x4*)(bias + jj + 4), bb0 = *(const f32x4*)(bias + 1024 + jj), bb1 = *(const f32x4*)(bias + 1024 + jj + 4);
        EPI_ROWS( f32x4 z0, z1; unpack8(*(const u32x4*)(ZS + (size_t)row * 1024 + jj), z0, z1);
            const f32x4 o0 = (acc[ai][0][m][0] + ba0) * sig4(acc[ai][1][m][0] + bb0) * z0, o1 = (acc[ai][0][m][1] + ba1) * sig4(acc[ai][1][m][1] + bb1) * z1;
            *(u32x4*)(TS + (size_t)row * 1024 + jj) = pack8(o0, o1); )
    }
};
struct EpiGate {
    static constexpr bool HAS_MID = false;
    bf16_t *RAT, *SGM;
    __device__ __forceinline__ void operator()(const Acc& acc, const Unit& u, int wr, int wc, int fr, int fq) const {
        const int jj = u.pn * 128 + wc * 32 + 8 * fq;
        EPI_ROWS( const f32x4 s0 = sig4(acc[ai][0][m][0]), s1 = sig4(acc[ai][0][m][1]), m0 = sig4(acc[ai][1][m][0]), m1 = sig4(acc[ai][1][m][1]);
            *(u32x4*)(RAT + (size_t)row * 1024 + jj) = pack8(s0 / m0, s1 / m1); *(u32x4*)(SGM + (size_t)row * 1024 + jj) = pack8(m0, m1); )
    }
};
struct EpiMerge {
    static constexpr bool HAS_MID = true;
    const bf16_t *RAT, *SGM; bf16_t* MG;
    __device__ __forceinline__ void mid(Acc& acc, const Unit& u, int wr, int wc, int fr, int fq) const {
        const int cw = wc * 32 + 8 * fq;
#pragma unroll
        for (int ai = 0; ai < 2; ++ai) {
            u32x4 r[4][2];
#pragma unroll
            for (int m = 0; m < 4; ++m) { const int row = u.pm * BM + ai * HALF + wr * 64 + m * 16 + fr;
#pragma unroll
                for (int bj = 0; bj < 2; ++bj) r[m][bj] = *(const u32x4*)(RAT + (size_t)row * 1024 + u.pn * 256 + bj * 128 + cw); }
#pragma unroll
            for (int m = 0; m < 4; ++m)
#pragma unroll
                for (int bj = 0; bj < 2; ++bj) { f32x4 a, b; unpack8(r[m][bj], a, b); acc[ai][bj][m][0] *= a; acc[ai][bj][m][1] *= b; }
        }
        asm volatile("s_waitcnt vmcnt(0)" ::: "memory");
    }
    __device__ __forceinline__ void operator()(const Acc& acc, const Unit& u, int wr, int wc, int fr, int fq) const {
        const int cw = wc * 32 + 8 * fq;
        EPI_ROWS( _Pragma("unroll") for (int bj = 0; bj < 2; ++bj) { const int c = u.pn * 256 + bj * 128 + cw; f32x4 a, b; unpack8(*(const u32x4*)(SGM + (size_t)row * 1024 + c), a, b);
            *(u32x4*)(MG + (size_t)row * 1024 + c) = pack8(acc[ai][bj][m][0] * a, acc[ai][bj][m][1] * b); } )
    }
};
struct EpiOut {
    static constexpr bool HAS_MID = false;
    bf16_t* OUTB; float* SO;
    __device__ __forceinline__ void operator()(const Acc& acc, const Unit& u, int wr, int wc, int fr, int fq) const {
        const int cw = wc * 32 + 8 * fq;
        EPI_ROWS( float s = 0.f;
            _Pragma("unroll") for (int bj = 0; bj < 2; ++bj) { const int c = u.pn * 256 + bj * 128 + cw; s += ssq4(acc[ai][bj][m][0]) + ssq4(acc[ai][bj][m][1]);
                *(u32x4*)(OUTB + (size_t)row * 1024 + c) = pack8(acc[ai][bj][m][0], acc[ai][bj][m][1]); }
            s += __shfl_xor(s, 16); s += __shfl_xor(s, 32); if (fq == 0) SO[(size_t)row * 16 + u.pn * 4 + wc] = s; )
    }
};
}

template <class MAP>
__device__ __forceinline__ void tr_item(const float* W, int ldw, const MAP& map, const float* kscale, bf16_t* dst, int dpitch, int koff, int nblk, float* scr, int item, int lane) {
    const int kb = item / nblk, nb = item % nblk, k0 = 64 * kb, n0 = 32 * nb;
    const int src = map(n0 + (lane & 31));
#pragma unroll 8
    for (int i = 0; i < 32; ++i) { const int kk = 2 * i + (lane >> 5); float v = (src >= 0) ? W[(size_t)(k0 + kk) * ldw + src] : 0.f; if (kscale) v *= kscale[k0 + kk]; scr[kk * 33 + (lane & 31)] = v; }
    asm volatile("s_waitcnt lgkmcnt(0)" ::: "memory");
    const int c = lane & 7;
#pragma unroll
    for (int j = 0; j < 4; ++j) { const int n = (lane >> 3) + 8 * j; const float* sc = scr + (8 * c) * 33 + n;
        u32x4 o; o.x = pk2(sc[0 * 33], sc[1 * 33]); o.y = pk2(sc[2 * 33], sc[3 * 33]); o.z = pk2(sc[4 * 33], sc[5 * 33]); o.w = pk2(sc[6 * 33], sc[7 * 33]);
        *(u32x4*)(dst + (size_t)(n0 + n) * dpitch + koff + k0 + 8 * c) = o; }
    asm volatile("s_waitcnt lgkmcnt(0)" ::: "memory");
}
struct MapG1a { __device__ __forceinline__ int operator()(int j) const { if (j < 1024) return C_US + j; if (j < 2048) return C_ZM + (j - 1024); if (j < 2304) return C_QL + (j - 2048); if (j < 2560) return C_KL + (j - 2304);
    if (j < 2592) { const int p = j - 2560; return C_KR + ((p & 1) ? 16 + (p >> 1) : (p >> 1)); } return -1; } };
struct MapOff { int off; __device__ __forceinline__ int operator()(int j) const { return off + j; } };
struct MapPair { int offa, offb; __device__ __forceinline__ int operator()(int j) const { const int pn = j >> 8, w = j & 255, jj = pn * 128 + (w & 127); return offa + (w >> 7) * (offb - offa) + jj; } };
struct MapQ { __device__ __forceinline__ int operator()(int j) const { if (j < 1024) return (j >> 6) * 96 + (j & 63); const int jj = j - 1024, h = jj >> 5, p = jj & 31; return h * 96 + 64 + ((p & 1) ? 16 + (p >> 1) : (p >> 1)); } };
struct MapKV { __device__ __forceinline__ int operator()(int j) const { return (j < 1024) ? (j >> 6) * 128 + (j & 63) : ((j - 1024) >> 6) * 128 + 64 + (j & 63); } };

__device__ __forceinline__ void prep_weights(const Args& a, float* lds) {
    const int tid = opq(threadIdx.x), lane = tid & 63, wv = tid >> 6;
    float* scr = lds + wv * (64 * 33);
    const int gw = blockIdx.x * 8 + wv, ngw = gridDim.x * 8;
    unsigned char* ws = a.ws;
    constexpr int I0 = 16 * 88, I1 = 16 * 32, I2 = 16 * 64, I3 = 16 * 64, I4 = 4 * 48, I5 = 4 * 64, I6 = 16 * 32, I7 = 16 * 32, I8 = 16 * 32;
    constexpr int NITEMS = I0 + I1 + I2 + I3 + I4 + I5 + I6 + I7 + I8;
    for (int it = gw; it < NITEMS; it += ngw) {
        int r = it;
        if (r < I0) { tr_item(a.in[6], INW, MapG1a{}, nullptr, (bf16_t*)(ws + WS_WINA), 1024, 0, 88, scr, r, lane); continue; } r -= I0;
        if (r < I1) { tr_item(a.in[6], INW, MapOff{C_ZS}, nullptr, (bf16_t*)(ws + WS_WZS), 1024, 0, 32, scr, r, lane); continue; } r -= I1;
        if (r < I2) { tr_item(a.in[6], INW, MapPair{C_GS, C_GM}, nullptr, (bf16_t*)(ws + WS_WGATE), 1024, 0, 64, scr, r, lane); continue; } r -= I2;
        if (r < I3) { tr_item(a.in[15], 2048, MapPair{0, 1024}, nullptr, (bf16_t*)(ws + WS_WGLU), 1024, 0, 64, scr, r, lane); continue; } r -= I3;
        if (r < I4) { tr_item(a.in[18], 1536, MapQ{}, a.in[17], (bf16_t*)(ws + WS_WQ), 256, 0, 48, scr, r, lane); continue; } r -= I4;
        if (r < I5) { tr_item(a.in[20], 2048, MapKV{}, a.in[19], (bf16_t*)(ws + WS_WKV), 256, 0, 64, scr, r, lane); continue; } r -= I5;
        if (r < I6) { tr_item(a.in[21], 1024, MapOff{0}, nullptr, (bf16_t*)(ws + WS_WBR), 2048, 0, 32, scr, r, lane); continue; } r -= I6;
        if (r < I7) { tr_item(a.in[22], 1024, MapOff{0}, nullptr, (bf16_t*)(ws + WS_WBR), 2048, 1024, 32, scr, r, lane); continue; } r -= I7;
        tr_item(a.in[23], 1024, MapOff{0}, nullptr, (bf16_t*)(ws + WS_WOUT), 1024, 0, 32, scr, r, lane);
    }
}

__device__ __forceinline__ void ph0_prep(const Args& a) {
    const int gtid = blockIdx.x * NTHR + opq(threadIdx.x), gsz = gridDim.x * NTHR;
    const float* c = a.in[1]; const int* pos = (const int*)a.in[2]; const float* w_ada = a.in[3]; const float* b_ada = a.in[4];
    float* mod = (float*)(a.ws + WS_MOD);
    for (int idx = gtid; idx < NB * 3072; idx += gsz) {
        const int b = idx / 3072, j = idx % 3072; float s = b_ada[j];
        for (int k = 0; k < DM; ++k) s += c[b * DM + k] * w_ada[(size_t)k * 3072 + j];
        mod[idx] = s;
    }
    float* rope = (float*)(a.ws + WS_ROPE);
    for (int idx = gtid; idx < NT * 16; idx += gsz) {
        const int tok = idx >> 4, i = idx & 15;
        const float inv = powf(10000.f, -(float)i / 16.f);
        const float ang = (float)pos[tok] * inv; float sn, cs; sincosf(ang, &sn, &cs);
        rope[(size_t)tok * 32 + i] = cs; rope[(size_t)tok * 32 + 16 + i] = sn;
    }
    const float* log_dt = a.in[7]; const float* a_re = a.in[8]; const float* a_im = a.in[9]; const float* b_re = a.in[10]; const float* b_im = a.in[11];
    float* abar = (float*)(a.ws + WS_SSMC); float* bbar = (float*)(a.ws + WS_SSMC + 65536);
    for (int idx = gtid; idx < NG * NS; idx += gsz) {
        const int g = idx / NS;
        const float dt = expf(log_dt[g]), lr = a_re[idx], li = a_im[idx];
        const float mag = expf(lr * dt); float sn, cs; sincosf(li * dt, &sn, &cs);
        const float abr = mag * cs, abi = mag * sn, den = lr * lr + li * li, nr = abr - 1.f, ni = abi;
        const float fr = (nr * lr + ni * li) / den, fi = (ni * lr - nr * li) / den;
        abar[idx * 2] = abr; abar[idx * 2 + 1] = abi;
        for (int q = 0; q < GP; ++q) { const float br = b_re[(size_t)idx * GP + q], bi = b_im[(size_t)idx * GP + q];
            bbar[((size_t)idx * GP + q) * 2] = fr * br - fi * bi; bbar[((size_t)idx * GP + q) * 2 + 1] = fr * bi + fi * br; }
    }
}

__device__ __forceinline__ void ph1_hnorm(const Args& a) {
    const int tid_ = opq(threadIdx.x), lane = tid_ & 63, gw = blockIdx.x * (NTHR / 64) + (tid_ >> 6), ngw = gridDim.x * (NTHR / 64);
    const float* x = a.in[0]; const float* g_pre = a.in[5]; const float* mod = (const float*)(a.ws + WS_MOD); bf16_t* HB = (bf16_t*)(a.ws + WS_HB);
    for (int m = gw; m < NT; m += ngw) {
        const int b = m / SEQ; const f32x4* xr = (const f32x4*)(x + (size_t)m * DM) + lane;
        f32x4 v[4]; float s = 0.f;
#pragma unroll
        for (int j = 0; j < 4; ++j) { v[j] = xr[64 * j]; s += (v[j].x * v[j].x + v[j].y * v[j].y) + (v[j].z * v[j].z + v[j].w * v[j].w); }
        const float rstd = 1.f / sqrtf(wave_sum(s) * (1.f / DM) + EPS);
        unsigned long long* o8 = (unsigned long long*)(HB + (size_t)m * DM) + lane;
#pragma unroll
        for (int j = 0; j < 4; ++j) { const int k = 256 * j + 4 * lane;
            const f32x4 g = *(const f32x4*)(g_pre + k), sh = *(const f32x4*)(mod + b * 3072 + k), sc = *(const f32x4*)(mod + b * 3072 + 1024 + k);
            const f32x4 h = v[j] * rstd * g * (sc + 1.f) + sh;
            o8[64 * j] = (unsigned long long)pk2(h.x, h.y) | ((unsigned long long)pk2(h.z, h.w) << 32); }
    }
}

struct BL2 { const float* W; __device__ __forceinline__ float b(int k, int j) const {
    int src;
    if (j < 1024) src = C_US + j; else if (j < 1280) src = C_QL + (j - 1024); else if (j < 1536) src = C_KL + (j - 1280);
    else if (j < 1568) { const int p = j - 1536; src = C_KR + ((p & 1) ? 16 + (p >> 1) : (p >> 1)); } else src = C_ZM + (j - 1568);
    return W[(size_t)k * INW + src]; } };
struct EP2 { bf16_t *US, *QL, *KL, *KR, *TM; float *ssq_q, *ssq_kv; const float* rope;
    __device__ __forceinline__ void e(int row, int j, float v0, float v1) const {
        if (j < 1024) { *(unsigned*)(US + ((size_t)(j >> 4) * NT + row) * 16 + (j & 15)) = pk2(v0, v1); }
        else if (j < 1280) { *(unsigned*)(QL + (size_t)row * 256 + (j - 1024)) = pk2(v0, v1); atomicAdd(ssq_q + row, v0 * v0 + v1 * v1); }
        else if (j < 1536) { *(unsigned*)(KL + (size_t)row * 256 + (j - 1280)) = pk2(v0, v1); atomicAdd(ssq_kv + row, v0 * v0 + v1 * v1); }
        else if (j < 1568) { const int p = j - 1536, i = p >> 1; const float cs = rope[(size_t)row * 32 + i], sn = rope[(size_t)row * 32 + 16 + i];
            *(unsigned*)(KR + (size_t)row * 32 + p) = pk2(v0 * cs - v1 * sn, v1 * cs + v0 * sn); }
        else { *(unsigned*)(TM + (size_t)row * 1024 + (j - 1568)) = pk2(siluf_(v0), siluf_(v1)); }
    } };

struct BL3q { const float* W; const float* g; __device__ __forceinline__ float b(int k, int j) const {
    int src; if (j < 1024) src = (j >> 6) * 96 + (j & 63); else { const int jj = j - 1024, h = jj >> 5, p = jj & 31; src = h * 96 + 64 + ((p & 1) ? 16 + (p >> 1) : (p >> 1)); }
    return W[(size_t)k * 1536 + src] * g[k]; } };
struct EP3q { bf16_t *QN, *QR; const float* ssq; const float* rope;
    __device__ __forceinline__ void e(int row, int j, float v0, float v1) const {
        const float rs = QSCALE / sqrtf(ssq[row] * (1.f / 256.f) + EPS); v0 *= rs; v1 *= rs;
        if (j < 1024) *(unsigned*)(QN + (size_t)row * 1024 + j) = pk2(v0, v1);
        else { const int jj = j - 1024, i = (jj & 31) >> 1; const float cs = rope[(size_t)row * 32 + i], sn = rope[(size_t)row * 32 + 16 + i];
            *(unsigned*)(QR + (size_t)row * 512 + jj) = pk2(v0 * cs - v1 * sn, v1 * cs + v0 * sn); }
    } };
struct BL3kv { const float* W; const float* g; __device__ __forceinline__ float b(int k, int j) const {
    const int src = (j < 1024) ? (j >> 6) * 128 + (j & 63) : ((j - 1024) >> 6) * 128 + 64 + (j & 63);
    return W[(size_t)k * 2048 + src] * g[k]; } };
struct EP3kv { bf16_t *KN, *VV; const float* ssq;
    __device__ __forceinline__ void e(int row, int j, float v0, float v1) const {
        const float rs = 1.f / sqrtf(ssq[row] * (1.f / 256.f) + EPS); v0 *= rs; v1 *= rs;
        if (j < 1024) *(unsigned*)(KN + (size_t)row * 1024 + j) = pk2(v0, v1); else *(unsigned*)(VV + (size_t)row * 1024 + (j - 1024)) = pk2(v0, v1);
    } };

__device__ __forceinline__ void ph4_attn(const Args& a, float* lds) {
    const bf16_t* QN = (const bf16_t*)(a.ws + WS_QN); const bf16_t* QR = (const bf16_t*)(a.ws + WS_QR); const bf16_t* KN = (const bf16_t*)(a.ws + WS_KN);
    const bf16_t* KR = (const bf16_t*)(a.ws + WS_KR); const bf16_t* VV = (const bf16_t*)(a.ws + WS_VV); bf16_t* TM = (bf16_t*)(a.ws + WS_TM);
    float* Kt = lds;
    float* Vt = lds + 64 * 100;
    const int tid = opq(threadIdx.x), wv = tid >> 6, half = wv >> 2;
    for (int item = blockIdx.x; item < NB * NH * 16; item += gridDim.x) {
        const int qb = item & 15, h = (item >> 4) & 15, b = item >> 8;
        const size_t tok = (size_t)b * SEQ + qb * 256 + (tid & 255);
        float q[96], o[32];
#pragma unroll
        for (int d = 0; d < 64; d += 2) { const unsigned w = *(const unsigned*)(QN + tok * 1024 + h * 64 + d); q[d] = bf2f(w); q[d + 1] = bf2f(w >> 16); }
#pragma unroll
        for (int d = 0; d < 32; d += 2) { const unsigned w = *(const unsigned*)(QR + tok * 512 + h * 32 + d); q[64 + d] = bf2f(w); q[64 + d + 1] = bf2f(w >> 16); }
#pragma unroll
        for (int d = 0; d < 32; ++d) o[d] = 0.f;
        float m = -1e30f, l = 0.f;
        const int mychunk = qb * 4 + (wv & 3), nkt = qb * 4 + 4;
        for (int kt = 0; kt < nkt; ++kt) {
            __syncthreads();
            const size_t kt0 = (size_t)b * SEQ + kt * 64;
            for (int e = tid; e < 64 * 32; e += NTHR) { const int key = e >> 5, d2 = (e & 31) * 2; const unsigned w = *(const unsigned*)(KN + (kt0 + key) * 1024 + h * 64 + d2); Kt[key * 100 + d2] = bf2f(w); Kt[key * 100 + d2 + 1] = bf2f(w >> 16); }
            for (int e = tid; e < 64 * 16; e += NTHR) { const int key = e >> 4, d2 = (e & 15) * 2; const unsigned w = *(const unsigned*)(KR + (kt0 + key) * 32 + d2); Kt[key * 100 + 64 + d2] = bf2f(w); Kt[key * 100 + 64 + d2 + 1] = bf2f(w >> 16); }
            for (int e = tid; e < 64 * 32; e += NTHR) { const int key = e >> 5, d2 = (e & 31) * 2; const unsigned w = *(const unsigned*)(VV + (kt0 + key) * 1024 + h * 64 + d2); Vt[key * 68 + d2] = bf2f(w); Vt[key * 68 + d2 + 1] = bf2f(w >> 16); }
            __syncthreads();
            if (kt <= mychunk) {
                for (int key = 0; key < 64; ++key) {
                    float s = 0.f;
#pragma unroll
                    for (int d = 0; d < 96; d += 4) { const f32x4 kk = *(const f32x4*)(Kt + key * 100 + d); s += q[d] * kk[0] + q[d + 1] * kk[1] + q[d + 2] * kk[2] + q[d + 3] * kk[3]; }
                    if (s > m) { const float f = exp2f(m - s); l *= f;
#pragma unroll
                        for (int d = 0; d < 32; ++d) o[d] *= f;
                        m = s; }
                    const float p = exp2f(s - m); l += p;
#pragma unroll
                    for (int d = 0; d < 32; d += 4) { const f32x4 vv = *(const f32x4*)(Vt + key * 68 + half * 32 + d); o[d] += p * vv[0]; o[d + 1] += p * vv[1]; o[d + 2] += p * vv[2]; o[d + 3] += p * vv[3]; }
                }
            }
        }
        const float il = 1.f / l;
#pragma unroll
        for (int d = 0; d < 32; d += 2) { unsigned* p = (unsigned*)(TM + tok * 1024 + h * 64 + half * 32 + d); const unsigned w = *p; *p = pk2(o[d] * il * bf2f(w), o[d + 1] * il * bf2f(w >> 16)); }
    }
}

__device__ __forceinline__ void ph5_ssm(const Args& a, float* lds) {
    const int tid = opq(threadIdx.x), lane = tid & 63, wv = tid >> 6;
    const bf16_t* US = (const bf16_t*)(a.ws + WS_US); bf16_t* YG = (bf16_t*)(a.ws + WS_YG);
    const float* abar = (const float*)(a.ws + WS_SSMC); const float* bbar = (const float*)(a.ws + WS_SSMC + 65536);
    const float* c_re = a.in[12]; const float* c_im = a.in[13]; const float* dsk = a.in[14];
    float* Xs = lds + wv * 4096;
    float* Cs = Xs + 1024; float* Us = Cs + 2048;
    for (int item = blockIdx.x * 8 + wv; item < NB * NG; item += gridDim.x * 8) {
        const int b = item / NG, g = item % NG;
        const float abr = abar[(g * NS + lane) * 2], abi = abar[(g * NS + lane) * 2 + 1];
        float bbr[16], bbi[16];
#pragma unroll
        for (int q = 0; q < 16; ++q) { bbr[q] = bbar[((size_t)(g * NS + lane) * 16 + q) * 2]; bbi[q] = bbar[((size_t)(g * NS + lane) * 16 + q) * 2 + 1]; }
        for (int p = 0; p < 16; ++p) { Cs[(p * 64 + lane) * 2] = c_re[((size_t)g * 16 + p) * 64 + lane]; Cs[(p * 64 + lane) * 2 + 1] = c_im[((size_t)g * 16 + p) * 64 + lane]; }
        float xr = 0.f, xi = 0.f;
        const bf16_t* ug = US + ((size_t)g * NT + (size_t)b * SEQ) * 16; bf16_t* yg = YG + ((size_t)g * NT + (size_t)b * SEQ) * 16;
        const int tt = lane >> 3, p0 = (lane & 7) * 2;
        const float d0 = dsk[g * 16 + p0], d1 = dsk[g * 16 + p0 + 1];
        for (int t0 = 0; t0 < SEQ; t0 += 8) {
            { const unsigned w = *(const unsigned*)(ug + (size_t)t0 * 16 + lane * 2); Us[lane * 2] = bf2f(w); Us[lane * 2 + 1] = bf2f(w >> 16); }
            asm volatile("s_waitcnt vmcnt(0) lgkmcnt(0)" ::: "memory");
#pragma unroll
            for (int t = 0; t < 8; ++t) {
                float bur = 0.f, bui = 0.f;
#pragma unroll
                for (int q = 0; q < 16; ++q) { const float u = Us[t * 16 + q]; bur += bbr[q] * u; bui += bbi[q] * u; }
                const float nr = abr * xr - abi * xi + bur, ni = abr * xi + abi * xr + bui; xr = nr; xi = ni;
                Xs[(t * 64 + lane) * 2] = xr; Xs[(t * 64 + lane) * 2 + 1] = xi;
            }
            asm volatile("s_waitcnt vmcnt(0) lgkmcnt(0)" ::: "memory");
            float y0 = 0.f, y1 = 0.f;
            for (int n = 0; n < 64; ++n) { const float vr = Xs[(tt * 64 + n) * 2], vi = Xs[(tt * 64 + n) * 2 + 1];
                y0 += Cs[(p0 * 64 + n) * 2] * vr - Cs[(p0 * 64 + n) * 2 + 1] * vi; y1 += Cs[((p0 + 1) * 64 + n) * 2] * vr - Cs[((p0 + 1) * 64 + n) * 2 + 1] * vi; }
            y0 += d0 * Us[tt * 16 + p0]; y1 += d1 * Us[tt * 16 + p0 + 1];
            *(unsigned*)(yg + (size_t)(t0 + tt) * 16 + p0) = pk2(gelu_tanh(y0), gelu_tanh(y1));
            asm volatile("s_waitcnt vmcnt(0) lgkmcnt(0)" ::: "memory");
        }
    }
}

struct BLzs { const float* W; __device__ __forceinline__ float b(int k, int j) const { return W[(size_t)k * INW + C_ZS + j]; } };
struct EPzs { bf16_t* ZS; __device__ __forceinline__ void e(int row, int j, float v0, float v1) const { *(unsigned*)(ZS + (size_t)row * 1024 + j) = pk2(siluf_(v0), siluf_(v1)); } };
struct BLglu { const float* W; __device__ __forceinline__ float b(int k, int j) const { return W[(size_t)k * 2048 + ((j & 1) ? 1024 + (j >> 1) : (j >> 1))]; } };
struct EPglu { bf16_t* TS; const bf16_t* ZS; const float* bias; __device__ __forceinline__ void e(int row, int j, float v0, float v1) const {
    const int jj = j >> 1; const float ga = v0 + bias[jj], gb = v1 + bias[1024 + jj]; TS[(size_t)row * 1024 + jj] = (bf16_t)f2bf(ga * sigmoidf_(gb) * bf2f(ZS[(size_t)row * 1024 + jj])); } };
struct BLgate { const float* W; __device__ __forceinline__ float b(int k, int j) const { return W[(size_t)k * INW + ((j & 1) ? C_GM + (j >> 1) : C_GS + (j >> 1))]; } };
struct EPgate { bf16_t *GS, *GM; __device__ __forceinline__ void e(int row, int j, float v0, float v1) const { const int jj = j >> 1; GS[(size_t)row * 1024 + jj] = (bf16_t)f2bf(sigmoidf_(v0)); GM[(size_t)row * 1024 + jj] = (bf16_t)f2bf(sigmoidf_(v1)); } };
struct BLplain { const float* W; int ldw; __device__ __forceinline__ float b(int k, int j) const { return W[(size_t)k * ldw + j]; } };
struct EPbs { float* P1; const bf16_t* GS; __device__ __forceinline__ void e(int row, int j, float v0, float v1) const {
    const unsigned w = *(const unsigned*)(GS + (size_t)row * 1024 + j); P1[(size_t)row * 1024 + j] = bf2f(w) * v0; P1[(size_t)row * 1024 + j + 1] = bf2f(w >> 16) * v1; } };
struct EPbm { const float* P1; const bf16_t* GM; bf16_t* MG; __device__ __forceinline__ void e(int row, int j, float v0, float v1) const {
    const unsigned w = *(const unsigned*)(GM + (size_t)row * 1024 + j); *(unsigned*)(MG + (size_t)row * 1024 + j) = pk2(P1[(size_t)row * 1024 + j] + bf2f(w) * v0, P1[(size_t)row * 1024 + j + 1] + bf2f(w >> 16) * v1); } };
struct EPout { float* O; __device__ __forceinline__ void e(int row, int j, float v0, float v1) const { O[(size_t)row * 1024 + j] = v0; O[(size_t)row * 1024 + j + 1] = v1; } };

__device__ __forceinline__ void ph_final(const Args& a) {
    const int tid_ = opq(threadIdx.x), lane = tid_ & 63, gw = blockIdx.x * (NTHR / 64) + (tid_ >> 6), ngw = gridDim.x * (NTHR / 64);
    const float* x = a.in[0]; const float* g_post = a.in[24]; const float* mod = (const float*)(a.ws + WS_MOD);
#if FAST_OUT
    const bf16_t* OB = (const bf16_t*)(a.ws + WS_OUTB); const float* SO = (const float*)(a.ws + WS_SO);
    for (int m = gw; m < NT; m += ngw) {
        const int b = m / SEQ; const f32x4* xr = (const f32x4*)(x + (size_t)m * DM) + lane;
        const f32x4 p0 = *(const f32x4*)(SO + (size_t)m * 16), p1 = *(const f32x4*)(SO + (size_t)m * 16 + 4), p2 = *(const f32x4*)(SO + (size_t)m * 16 + 8), p3 = *(const f32x4*)(SO + (size_t)m * 16 + 12);
        const f32x4 ps = (p0 + p1) + (p2 + p3);
        const float rstd = 1.f / sqrtf(((ps[0] + ps[1]) + (ps[2] + ps[3])) * (1.f / DM) + EPS);
        const u32x2* orow = (const u32x2*)(OB + (size_t)m * DM) + lane;
        f32x4* o = (f32x4*)(a.out + (size_t)m * DM) + lane;
#pragma unroll
        for (int j = 0; j < 4; ++j) { const int k = 256 * j + 4 * lane; const u32x2 w = orow[64 * j]; const f32x4 v = (f32x4){bf2f(w.x), bf2f(w.x >> 16), bf2f(w.y), bf2f(w.y >> 16)};
            const f32x4 g = *(const f32x4*)(g_post + k), gt = *(const f32x4*)(mod + b * 3072 + 2048 + k);
            o[64 * j] = xr[64 * j] + gt * (v * rstd * g); }
    }
#else
    const float* OF = (const float*)(a.ws + WS_OUTF);
    for (int m = gw; m < NT; m += ngw) {
        const int b = m / SEQ; const f32x4* orow = (const f32x4*)(OF + (size_t)m * DM) + lane; const f32x4* xr = (const f32x4*)(x + (size_t)m * DM) + lane;
        f32x4 v[4]; float s = 0.f;
#pragma unroll
        for (int j = 0; j < 4; ++j) { v[j] = orow[64 * j]; s += (v[j].x * v[j].x + v[j].y * v[j].y) + (v[j].z * v[j].z + v[j].w * v[j].w); }
        const float rstd = 1.f / sqrtf(wave_sum(s) * (1.f / DM) + EPS);
        f32x4* o = (f32x4*)(a.out + (size_t)m * DM) + lane;
#pragma unroll
        for (int j = 0; j < 4; ++j) { const int k = 256 * j + 4 * lane; const f32x4 g = *(const f32x4*)(g_post + k), gt = *(const f32x4*)(mod + b * 3072 + 2048 + k);
            o[64 * j] = xr[64 * j] + gt * (v[j] * rstd * g); }
    }
#endif
}

constexpr int NPHASE = 11;
__global__ void __launch_bounds__(NTHR, 2) mk_fwd(Args a) {
    extern __shared__ __attribute__((aligned(16))) unsigned char lds_raw[];
    float* lds = (float*)lds_raw;
    unsigned char* ws = a.ws;
#define SEAM(k) do { if (a.ph_lo <= (k) && (k) + 1 < a.ph_hi) { cg::this_grid().sync(); } } while (0)
#define IN(k) (a.ph_lo <= (k) && (k) < a.ph_hi)
    pg8::PG8_LAS_T* l3 = (pg8::PG8_LAS_T*)lds_raw;
    const int G = gridDim.x, bid = blockIdx.x;
    if (IN(0)) { ph0_prep(a); prep_weights(a, lds); } SEAM(0);
    if (IN(1)) { ph1_hnorm(a); } SEAM(1);
    if (IN(2)) {
#if FAST_G1A
        pg8::Gemm g{(const char*)(ws + WS_HB), (const char*)(ws + WS_HB), (const char*)(ws + WS_WINA), 2816, 1024, 1024, 0, 16}; pg8::StaticOrder S; S.init(NT, 2816, G, bid);
        pg8::EpiG1a E{(bf16_t*)(ws + WS_US), (bf16_t*)(ws + WS_TM), (bf16_t*)(ws + WS_QL), (bf16_t*)(ws + WS_KL), (bf16_t*)(ws + WS_KR), (float*)(ws + WS_SQ), (float*)(ws + WS_SKV), (const float*)(ws + WS_ROPE)};
        pg8::gemm_phase(l3, g, S, E);
#else
        ARow al{(const bf16_t*)(ws + WS_HB), 1024}; BL2 bl{a.in[6]};
        EP2 ep{(bf16_t*)(ws + WS_US), (bf16_t*)(ws + WS_QL), (bf16_t*)(ws + WS_KL), (bf16_t*)(ws + WS_KR), (bf16_t*)(ws + WS_TM), (float*)(ws + WS_CTL), (float*)(ws + WS_CTL + 131072), (const float*)(ws + WS_ROPE)};
        gemm_o(lds, NT, 2592, 1024, al, bl, ep);
#endif
    } SEAM(2);
    if (IN(3)) {
#if FAST_G2
        { pg8::Gemm g{(const char*)(ws + WS_QL), (const char*)(ws + WS_QL), (const char*)(ws + WS_WQ), 1536, 256, 256, 0, 4}; pg8::StaticOrder S; S.init(NT, 1536, G, bid);
          pg8::EpiG2q E{(bf16_t*)(ws + WS_QN), (bf16_t*)(ws + WS_QR), (const float*)(ws + WS_SQ), (const float*)(ws + WS_ROPE)}; pg8::gemm_phase(l3, g, S, E); }
        { pg8::Gemm g{(const char*)(ws + WS_KL), (const char*)(ws + WS_KL), (const char*)(ws + WS_WKV), 2048, 256, 256, 0, 4}; pg8::StaticOrder S; S.init(NT, 2048, G, bid);
          pg8::EpiG2kv E{(bf16_t*)(ws + WS_KN), (bf16_t*)(ws + WS_VV), (const float*)(ws + WS_SKV)}; pg8::gemm_phase(l3, g, S, E); }
#else
        { ARow al{(const bf16_t*)(ws + WS_QL), 256}; BL3q bl{a.in[18], a.in[17]}; EP3q ep{(bf16_t*)(ws + WS_QN), (bf16_t*)(ws + WS_QR), (const float*)(ws + WS_CTL), (const float*)(ws + WS_ROPE)};
          gemm_o(lds, NT, 1536, 256, al, bl, ep); }
        { ARow al{(const bf16_t*)(ws + WS_KL), 256}; BL3kv bl{a.in[20], a.in[19]}; EP3kv ep{(bf16_t*)(ws + WS_KN), (bf16_t*)(ws + WS_VV), (const float*)(ws + WS_CTL + 131072)};
          gemm_o(lds, NT, 2048, 256, al, bl, ep); }
#endif
    } SEAM(3);
    if (IN(4)) { ph4_attn(a, lds); } SEAM(4);
    if (IN(5)) {
#if FAST_ZS
        { pg8::Gemm g{(const char*)(ws + WS_HB), (const char*)(ws + WS_HB), (const char*)(ws + WS_WZS), 1024, 1024, 1024, 0, 16}; pg8::StaticOrder S; S.init(NT, 1024, G, bid);
          pg8::EpiZs E{(bf16_t*)(ws + WS_ZS)}; pg8::gemm_phase(l3, g, S, E); }
#else
        { ARow al{(const bf16_t*)(ws + WS_HB), 1024}; BLzs bl{a.in[6]}; EPzs ep{(bf16_t*)(ws + WS_ZS)}; gemm_o(lds, NT, 1024, 1024, al, bl, ep); }
#endif
        __syncthreads();
        ph5_ssm(a, lds);
    } SEAM(5);
    if (IN(6)) {
#if FAST_GLU
        { pg8::Gemm g{(const char*)(ws + WS_YG), (const char*)(ws + WS_YG), (const char*)(ws + WS_WGLU), 2048, 1024, 1024, 1, 16}; pg8::StaticOrder S; S.init(NT, 2048, G, bid);
          pg8::EpiGlu E{(bf16_t*)(ws + WS_TS), (const bf16_t*)(ws + WS_ZS), a.in[16]}; pg8::gemm_phase(l3, g, S, E); }
#else
        { AGrp al{(const bf16_t*)(ws + WS_YG)}; BLglu bl{a.in[15]}; EPglu ep{(bf16_t*)(ws + WS_TS), (const bf16_t*)(ws + WS_ZS), a.in[16]}; gemm_o(lds, NT, 2048, 1024, al, bl, ep); }
#endif
#if FAST_MERGE
        { pg8::Gemm g{(const char*)(ws + WS_HB), (const char*)(ws + WS_HB), (const char*)(ws + WS_WGATE), 2048, 1024, 1024, 0, 16}; pg8::StaticOrder S; S.init(NT, 2048, G, bid);
          pg8::EpiGate E{(bf16_t*)(ws + WS_RAT), (bf16_t*)(ws + WS_SGM)}; pg8::gemm_phase(l3, g, S, E); }
#else
        { ARow al{(const bf16_t*)(ws + WS_HB), 1024}; BLgate bl{a.in[6]}; EPgate ep{(bf16_t*)(ws + WS_GS), (bf16_t*)(ws + WS_GM)}; gemm_o(lds, NT, 2048, 1024, al, bl, ep); }
#endif
    } SEAM(6);
#if FAST_MERGE
    if (IN(7)) { pg8::Gemm g{(const char*)(ws + WS_TS), (const char*)(ws + WS_TM), (const char*)(ws + WS_WBR), 1024, 2048, 1024, 0, 16}; pg8::StaticOrder S; S.init(NT, 1024, G, bid);
        pg8::EpiMerge E{(const bf16_t*)(ws + WS_RAT), (const bf16_t*)(ws + WS_SGM), (bf16_t*)(ws + WS_MG)}; pg8::gemm_phase(l3, g, S, E); } SEAM(7);
    SEAM(8);
#else
    if (IN(7)) { ARow al{(const bf16_t*)(ws + WS_TS), 1024}; BLplain bl{a.in[21], 1024}; EPbs ep{(float*)(ws + WS_P1), (const bf16_t*)(ws + WS_GS)}; gemm_o(lds, NT, 1024, 1024, al, bl, ep); } SEAM(7);
    if (IN(8)) { ARow al{(const bf16_t*)(ws + WS_TM), 1024}; BLplain bl{a.in[22], 1024}; EPbm ep{(const float*)(ws + WS_P1), (const bf16_t*)(ws + WS_GM), (bf16_t*)(ws + WS_MG)}; gemm_o(lds, NT, 1024, 1024, al, bl, ep); } SEAM(8);
#endif
    if (IN(9)) {
#if FAST_OUT
        pg8::Gemm g{(const char*)(ws + WS_MG), (const char*)(ws + WS_MG), (const char*)(ws + WS_WOUT), 1024, 1024, 1024, 0, 16}; pg8::StaticOrder S; S.init(NT, 1024, G, bid);
        pg8::EpiOut E{(bf16_t*)(ws + WS_OUTB), (float*)(ws + WS_SO)}; pg8::gemm_phase(l3, g, S, E);
#else
        ARow al{(const bf16_t*)(ws + WS_MG), 1024}; BLplain bl{a.in[23], 1024}; EPout ep{(float*)(ws + WS_OUTF)}; gemm_o(lds, NT, 1024, 1024, al, bl, ep);
#endif
    } SEAM(9);
    if (IN(10)) { ph_final(a); }
#undef SEAM
#undef IN
}

extern "C" void kernel_launch(void* const* d_in, const int* in_sizes, int n_in, void* d_out, int out_size, void* d_ws, size_t ws_size, hipStream_t stream) {
    static int grid = 0;
    if (grid == 0) {
        if (n_in != 25 || out_size != NT * DM || ws_size < WS_END) { fprintf(stderr, "kernel_launch: unexpected shapes n_in %d out %d ws %zu\n", n_in, out_size, ws_size); grid = -1; return; }
        int dev = 0, cus = 0, per_cu = 0;
        hipGetDevice(&dev); hipDeviceGetAttribute(&cus, hipDeviceAttributeMultiprocessorCount, dev);
        hipFuncSetAttribute((const void*)mk_fwd, hipFuncAttributeMaxDynamicSharedMemorySize, LDS_BYTES);
        hipOccupancyMaxActiveBlocksPerMultiprocessor(&per_cu, (const void*)mk_fwd, NTHR, LDS_BYTES);
        (void)hipGetLastError();
        if (per_cu < 1) per_cu = 1;
        grid = cus * 1;
        fprintf(stderr, "kernel_launch: cus %d per_cu %d grid %d ws %zu\n", cus, per_cu, grid, ws_size);
    }
    if (grid < 0) return;
    hipMemsetAsync((char*)d_ws + WS_CTL, 0, 1 * MiB, stream);
    Args a{};
    for (int i = 0; i < 25; ++i) a.in[i] = (const float*)d_in[i];
    a.out = (float*)d_out; a.ws = (unsigned char*)d_ws;
#if MK_SINGLE
    a.ph_lo = 0; a.ph_hi = NPHASE;
    void* args[] = {&a};
    hipError_t e = hipLaunchCooperativeKernel((const void*)mk_fwd, dim3(grid), dim3(NTHR), args, LDS_BYTES, stream);
    if (e != hipSuccess) fprintf(stderr, "cooperative launch failed: %s (grid %d)\n", hipGetErrorString(e), grid);
#else
    for (int p = 0; p < NPHASE; ++p) { a.ph_lo = p; a.ph_hi = p + 1; hipLaunchKernelGGL(mk_fwd, dim3(grid), dim3(NTHR), LDS_BYTES, stream, a); }
#endif
}
```

```cpp
#include <hip/hip_runtime.h>
#include <hip/hip_cooperative_groups.h>
#include <cstdint>
#include <cstdio>
namespace cg = cooperative_groups;

#ifndef MK_SINGLE
#define MK_SINGLE 1
#endif
#ifndef FAST_ALL
#define FAST_ALL 1
#endif
#ifndef FAST_G1A
#define FAST_G1A FAST_ALL
#endif
#ifndef FAST_G2
#define FAST_G2 FAST_ALL
#endif
#ifndef FAST_ZS
#define FAST_ZS FAST_ALL
#endif
#ifndef FAST_GLU
#define FAST_GLU FAST_ALL
#endif
#ifndef FAST_MERGE
#define FAST_MERGE FAST_ALL
#endif
#ifndef FAST_OUT
#define FAST_OUT FAST_ALL
#endif
#ifndef FAST_ATT
#define FAST_ATT FAST_ALL
#endif

typedef unsigned short bf16_t;
typedef float f32x4 __attribute__((ext_vector_type(4)));
typedef unsigned u32x4 __attribute__((ext_vector_type(4)));
typedef unsigned u32x2 __attribute__((ext_vector_type(2)));

constexpr int NB = 8, SEQ = 4096, DM = 1024, NT = NB * SEQ;
constexpr int INW = 5664;
constexpr int C_US = 0, C_ZS = 1024, C_QL = 2048, C_KL = 2304, C_KR = 2560, C_ZM = 2592, C_GS = 3616, C_GM = 4640;
constexpr int NG = 64, GP = 16, NS = 64;
constexpr int NH = 16;
constexpr float EPS = 1e-6f;
constexpr float QSCALE = 0.10206207261596577f * 1.4426950408889634f;
constexpr int NTHR = 512;
constexpr int LDS_BYTES = 147456;

constexpr size_t MiB = 1u << 20;
constexpr size_t WS_CTL = 0;
constexpr size_t WS_MOD = 1 * MiB;
constexpr size_t WS_ROPE = 2 * MiB;
constexpr size_t WS_SSMC = 6 * MiB;
constexpr size_t WS_SSQ = 0;
constexpr size_t WS_WINA = 8 * MiB;
constexpr size_t WS_WZS = 14 * MiB;
constexpr size_t WS_WGATE = 16 * MiB;
constexpr size_t WS_WGLU = 20 * MiB;
constexpr size_t WS_WQ = 24 * MiB;
constexpr size_t WS_WKV = 25 * MiB;
constexpr size_t WS_WBR = 26 * MiB;
constexpr size_t WS_WOUT = 30 * MiB;
constexpr size_t WS_SQ = 274 * MiB;
constexpr size_t WS_SKV = 275 * MiB;
constexpr size_t WS_SO = 276 * MiB;
constexpr size_t WS_HB = 32 * MiB;
constexpr size_t WS_US = 96 * MiB;
constexpr size_t WS_TM = 160 * MiB;
constexpr size_t WS_QL = 224 * MiB;
constexpr size_t WS_KL = 240 * MiB;
constexpr size_t WS_KR = 256 * MiB;
constexpr size_t WS_QN = 288 * MiB;
constexpr size_t WS_QR = 352 * MiB;
constexpr size_t WS_KN = 384 * MiB;
constexpr size_t WS_VV = 448 * MiB;
constexpr size_t WS_ZS = 288 * MiB;
constexpr size_t WS_YG = 352 * MiB;
constexpr size_t WS_TS = 416 * MiB;
constexpr size_t WS_GS = 96 * MiB;
constexpr size_t WS_GM = 224 * MiB;
constexpr size_t WS_P1 = 288 * MiB;
constexpr size_t WS_MG = 32 * MiB;
constexpr size_t WS_OUTF = 288 * MiB;
constexpr size_t WS_RAT = 96 * MiB;
constexpr size_t WS_SGM = 224 * MiB;
constexpr size_t WS_OUTB = 288 * MiB;
constexpr size_t WS_END = 512 * MiB;

__device__ __forceinline__ unsigned f2bf(float f) { unsigned u = __builtin_bit_cast(unsigned, f); return (u + 0x7fffu + ((u >> 16) & 1u)) >> 16; }
__device__ __forceinline__ float bf2f(unsigned h) { return __builtin_bit_cast(float, (h & 0xffffu) << 16); }
__device__ __forceinline__ unsigned pk2(float lo, float hi) { return f2bf(lo) | (f2bf(hi) << 16); }
__device__ __forceinline__ float sigmoidf_(float v) { return 1.f / (1.f + __expf(-v)); }
__device__ __forceinline__ float siluf_(float v) { return v / (1.f + __expf(-v)); }
__device__ __forceinline__ float gelu_tanh(float v) { const float u = 0.7978845608028654f * (v + 0.044715f * v * v * v); return 0.5f * v * (1.f + tanhf(u)); }
__device__ __forceinline__ float wave_sum(float v) {
#pragma unroll
    for (int o = 1; o < 64; o <<= 1) v += __shfl_xor(v, o);
    return v;
}

__device__ __forceinline__ int opq(int x) { asm volatile("" : "+v"(x)); return x; }
struct Args { const float* in[25]; float* out; unsigned char* ws; int ph_lo, ph_hi; };

template <class AL, class BL, class EP>
__device__ __forceinline__ void gemm_o(float* lds, int M, int N, int K, const AL& al, const BL& bl, const EP& ep) {
    float* As = lds;
    float* Bs = lds + 16 * 132;
    const int tid = opq(threadIdx.x), ty = tid >> 4, tx = tid & 15;
    const int ntn = (N + 127) / 128, ntm = M / 128, ntiles = ntm * ntn;
    for (int tile = blockIdx.x; tile < ntiles; tile += gridDim.x) {
        const int tm = tile / ntn, tn = tile % ntn;
        const int row0 = tm * 128, col0 = tn * 128;
        float acc[4][8];
#pragma unroll
        for (int i = 0; i < 4; ++i)
#pragma unroll
            for (int j = 0; j < 8; ++j) acc[i][j] = 0.f;
        for (int k0 = 0; k0 < K; k0 += 16) {
            {
                const int r = tid >> 2, kk = (tid & 3) * 4;
                const bf16_t* p = al.a4(row0 + r, k0 + kk);
                const u32x2 w = *(const u32x2*)p;
                As[(kk + 0) * 132 + r] = bf2f(w.x); As[(kk + 1) * 132 + r] = bf2f(w.x >> 16);
                As[(kk + 2) * 132 + r] = bf2f(w.y); As[(kk + 3) * 132 + r] = bf2f(w.y >> 16);
            }
            {
                const int kk = tid >> 5, c = (tid & 31) * 4;
#pragma unroll
                for (int j = 0; j < 4; ++j) { const int col = col0 + c + j; Bs[kk * 132 + c + j] = (col < N) ? bl.b(k0 + kk, col) : 0.f; }
            }
            __syncthreads();
#pragma unroll 2
            for (int kk = 0; kk < 16; ++kk) {
                const f32x4 a = *(const f32x4*)(As + kk * 132 + ty * 4);
                const f32x4 b0 = *(const f32x4*)(Bs + kk * 132 + tx * 8), b1 = *(const f32x4*)(Bs + kk * 132 + tx * 8 + 4);
#pragma unroll
                for (int i = 0; i < 4; ++i) {
                    acc[i][0] += a[i] * b0[0]; acc[i][1] += a[i] * b0[1]; acc[i][2] += a[i] * b0[2]; acc[i][3] += a[i] * b0[3];
                    acc[i][4] += a[i] * b1[0]; acc[i][5] += a[i] * b1[1]; acc[i][6] += a[i] * b1[2]; acc[i][7] += a[i] * b1[3];
                }
            }
            __syncthreads();
        }
#pragma unroll
        for (int i = 0; i < 4; ++i)
#pragma unroll
            for (int j = 0; j < 8; j += 2) { const int col = col0 + tx * 8 + j; if (col < N) ep.e(row0 + ty * 4 + i, col, acc[i][j], acc[i][j + 1]); }
    }
}

struct ARow { const bf16_t* A; int lda; __device__ __forceinline__ const bf16_t* a4(int row, int k) const { return A + (size_t)row * lda + k; } };
struct AGrp { const bf16_t* A; __device__ __forceinline__ const bf16_t* a4(int row, int k) const { return A + ((size_t)(k >> 4) * NT + row) * 16 + (k & 15); } };

namespace pg8 {
#define PG8_LAS __attribute__((address_space(3)))
typedef PG8_LAS unsigned char PG8_LAS_T;
typedef short bf16x8 __attribute__((ext_vector_type(8)));
constexpr int BM = 256, BK = 64, HALF = 128, HTB = HALF * BK * 2, STAGE_BYTES = 8 * HTB, NXCD = 8, WGM = 8;
constexpr unsigned PLANE = (unsigned)NT * 32u;

__host__ __device__ __forceinline__ int lds_byte(int r, int c) { const int st = (r >> 4) * 2 + (c >> 5), rr = r & 15, cc = c & 31, ob = rr * 64 + cc * 2; return st * 1024 + (ob ^ (((ob >> 9) & 1) << 5)); }
__host__ __device__ __forceinline__ void stage_rc(int b, int& R, int& C) { const int st = b / 1024, sb = b % 1024, swz = sb ^ (((sb >> 9) & 1) << 5); R = (st >> 1) * 16 + swz / 64; C = (st & 1) * 32 + (swz % 64) / 2; }
__host__ __device__ __forceinline__ int perm32(int rho) { const int n = rho >> 4, i = rho & 15; return 8 * (i >> 2) + 4 * n + (i & 3); }

struct Unit { int pm, pn; };
struct Gemm { const char* A; const char* A2; const char* Bt; int N, K, lda, amode, tmid; };

struct StaticOrder {
    int nM, nN, nwg, G, c;
    __device__ void init(int M, int N, int G_, int c_) { nM = M / BM; nN = N / BM; nwg = nM * nN; G = G_; c = c_; }
    __device__ bool next(int i, Unit& u) const {
        const long L = (long)i * G + c; if (L >= nwg) return false;
        int wgid = (int)L; { const int q = nwg / NXCD, r = nwg % NXCD, xcd = wgid % NXCD, off = wgid / NXCD; wgid = (xcd < r ? xcd * (q + 1) : r * (q + 1) + (xcd - r) * q) + off; }
        const int nig = WGM * nN, gid = wgid / nig, fm = gid * WGM, gsz = (nM - fm) < WGM ? (nM - fm) : WGM;
        u.pm = fm + ((wgid % nig) % gsz); u.pn = (wgid % nig) / gsz; return true;
    }
};

typedef f32x4 Acc[2][2][4][2];

template <class Epi, class Sched>
__device__ __forceinline__ void gemm_phase(PG8_LAS unsigned char* lds, const Gemm g, const Sched& S, const Epi& E) {
    const int tid = opq(threadIdx.x), wid = __builtin_amdgcn_readfirstlane(tid >> 6), lane = tid & 63, wr = wid >> 2, wc = wid & 3, fr = lane & 15, fq = lane >> 4;
    const int K = g.K, nt = K / BK;
    unsigned voffA[2], voffB[2];
#pragma unroll
    for (int i = 0; i < 2; ++i) { int R, C; stage_rc(tid * 16 + i * 8192, R, C); const int Rb = (R & ~31) + perm32(R & 31);
        voffA[i] = g.amode == 0 ? (unsigned)(R * g.lda + C) * 2u : (unsigned)(C >> 4) * PLANE + (unsigned)R * 32u + (unsigned)(C & 15) * 2u;
        voffB[i] = (unsigned)(Rb * K + C) * 2u; }
    const size_t akstep = g.amode == 0 ? (size_t)(BK * 2) : (size_t)4 * PLANE;
    const size_t ahstep = g.amode == 0 ? (size_t)HALF * g.lda * 2 : (size_t)HALF * 32;
    const size_t atstep = 2 * ahstep;
    const size_t bkstep = (size_t)(BK * 2), bhstep = (size_t)HALF * K * 2, btstep = 2 * bhstep;
    const unsigned ldsw = (unsigned)wid * 1024u;
    const int aoff = lds_byte(wr * 64 + fr, fq * 8), boff = lds_byte(wc * 32 + fr, fq * 8);
    const int tmid = g.tmid;
    const char* const Alo = g.A; const char* const Ahi = g.A2 - (size_t)tmid * akstep;
#define PG8_AP(pm_, t_) ((((t_) < tmid) ? Alo : Ahi) + (size_t)(pm_) * atstep + (size_t)(t_) * akstep)
#define PG8_SA(b, h) (((b) * 2 + (h)) * HTB)
#define PG8_SB(b, h) ((4 + (b) * 2 + (h)) * HTB)
#define PG8_STAGE(bufoff, gbase, voff) do { _Pragma("unroll") for (int _i = 0; _i < 2; ++_i) \
        __builtin_amdgcn_global_load_lds((const unsigned*)((const char*)(gbase) + (voff)[_i]), (PG8_LAS unsigned*)(lds + (bufoff) + ldsw + _i * 8192), 16, 0, 0); } while (0)
#define PG8_LDA(dst, b, h) do { _Pragma("unroll") for (int m = 0; m < 4; ++m) _Pragma("unroll") for (int k = 0; k < 2; ++k) dst[m][k] = *(const PG8_LAS bf16x8*)(lds + PG8_SA(b, h) + aoff + m * 2048 + k * 1024); } while (0)
#define PG8_LDB(dst, b, h) do { _Pragma("unroll") for (int n = 0; n < 2; ++n) _Pragma("unroll") for (int k = 0; k < 2; ++k) dst[n][k] = *(const PG8_LAS bf16x8*)(lds + PG8_SB(b, h) + boff + n * 2048 + k * 1024); } while (0)
#define PG8_MMA(ai, bj, At, Bt) do { __builtin_amdgcn_s_setprio(1); _Pragma("unroll") for (int m = 0; m < 4; ++m) _Pragma("unroll") for (int n = 0; n < 2; ++n) _Pragma("unroll") for (int k = 0; k < 2; ++k) \
        acc[ai][bj][m][n] = __builtin_amdgcn_mfma_f32_16x16x32_bf16(Bt[n][k], At[m][k], acc[ai][bj][m][n], 0, 0, 0); __builtin_amdgcn_s_setprio(0); } while (0)
#define PG8_WAIT_V(n) asm volatile("s_waitcnt vmcnt(" #n ")" ::: "memory")
#define PG8_WAIT_L(n) asm volatile("s_waitcnt lgkmcnt(" #n ")" ::: "memory")
#define PG8_BAR __builtin_amdgcn_s_barrier()
#define PG8_SCHED __builtin_amdgcn_sched_barrier(0)
    Unit cur, nxt; int ui = 0;
    if (!S.next(0, cur)) return;
    Acc acc;
#pragma unroll
    for (int a = 0; a < 2; ++a)
#pragma unroll
        for (int b = 0; b < 2; ++b)
#pragma unroll
            for (int m = 0; m < 4; ++m)
#pragma unroll
                for (int n = 0; n < 2; ++n) acc[a][b][m][n] = (f32x4){0.f, 0.f, 0.f, 0.f};
    bf16x8 At[4][2], B0[2][2], B1[2][2];
    const char* cB = g.Bt + (size_t)cur.pn * btstep;
    {
        const char* cA0 = PG8_AP(cur.pm, 0); const char* cA1 = PG8_AP(cur.pm, 1);
        PG8_STAGE(PG8_SB(0, 0), cB, voffB); PG8_STAGE(PG8_SB(0, 1), cB + bhstep, voffB); PG8_STAGE(PG8_SA(0, 0), cA0, voffA); PG8_STAGE(PG8_SA(0, 1), cA0 + ahstep, voffA);
        if (wr == 1) PG8_BAR;
        PG8_WAIT_V(2); PG8_BAR;
        PG8_STAGE(PG8_SB(1, 0), cB + bkstep, voffB); PG8_STAGE(PG8_SA(1, 0), cA1, voffA); PG8_STAGE(PG8_SB(1, 1), cB + bhstep + bkstep, voffB);
        PG8_WAIT_V(6); PG8_BAR;
    }
    for (;;) {
        const bool has_next = S.next(ui + 1, nxt);
        const int npm = has_next ? nxt.pm : cur.pm;
        const char* nB = has_next ? g.Bt + (size_t)nxt.pn * btstep : cB;
#pragma unroll 1
        for (int t = 0; t < nt; t += 2) {
            const bool last = (t == nt - 2);
            if constexpr (Epi::HAS_MID) { if (t == tmid) E.mid(acc, cur, wr, wc, fr, fq); }
            const char* a1 = PG8_AP(cur.pm, t + 1);
            const char* a2 = last ? PG8_AP(npm, 0) : PG8_AP(cur.pm, t + 2);
            const char* a3 = last ? PG8_AP(npm, 1) : PG8_AP(cur.pm, t + 3);
            const char* b2 = last ? nB : cB + (size_t)(t + 2) * bkstep; const char* b3 = b2 + bkstep;
            PG8_LDB(B0, 0, 0); PG8_LDB(B1, 0, 1); PG8_SCHED; PG8_LDA(At, 0, 0); PG8_STAGE(PG8_SA(1, 1), a1 + ahstep, voffA);
            PG8_WAIT_V(8); PG8_WAIT_L(0); PG8_BAR; PG8_MMA(0, 0, At, B0); PG8_MMA(0, 1, At, B1); PG8_BAR; PG8_SCHED;
            PG8_LDA(At, 0, 1); PG8_STAGE(PG8_SB(0, 0), b2, voffB); PG8_STAGE(PG8_SB(0, 1), b2 + bhstep, voffB); PG8_STAGE(PG8_SA(0, 0), a2, voffA);
            PG8_WAIT_V(8); PG8_WAIT_L(0); PG8_BAR; PG8_MMA(1, 0, At, B0); PG8_MMA(1, 1, At, B1); PG8_BAR; PG8_SCHED;
            PG8_LDB(B0, 1, 0); PG8_LDB(B1, 1, 1); PG8_SCHED; PG8_LDA(At, 1, 0); PG8_STAGE(PG8_SA(0, 1), a2 + ahstep, voffA);
            PG8_WAIT_V(8); PG8_WAIT_L(0); PG8_BAR; PG8_MMA(0, 0, At, B0); PG8_MMA(0, 1, At, B1); PG8_BAR; PG8_SCHED;
            PG8_LDA(At, 1, 1); PG8_STAGE(PG8_SB(1, 0), b3, voffB); PG8_STAGE(PG8_SB(1, 1), b3 + bhstep, voffB); PG8_STAGE(PG8_SA(1, 0), a3, voffA);
            PG8_WAIT_V(8); PG8_WAIT_L(0); PG8_BAR; PG8_MMA(1, 0, At, B0); PG8_MMA(1, 1, At, B1); PG8_BAR; PG8_SCHED;
        }
        if (wr == 0) PG8_BAR;
        E(acc, cur, wr, wc, fr, fq);
        if (!has_next) break;
#pragma unroll
        for (int a = 0; a < 2; ++a)
#pragma unroll
            for (int b = 0; b < 2; ++b)
#pragma unroll
                for (int m = 0; m < 4; ++m)
#pragma unroll
                    for (int n = 0; n < 2; ++n) acc[a][b][m][n] = (f32x4){0.f, 0.f, 0.f, 0.f};
        cur = nxt; cB = nB; ++ui;
        if (wr == 1) PG8_BAR;
    }
    PG8_WAIT_V(0);
    PG8_BAR;
#undef PG8_AP
#undef PG8_SA
#undef PG8_SB
#undef PG8_STAGE
#undef PG8_LDA
#undef PG8_LDB
#undef PG8_MMA
#undef PG8_WAIT_V
#undef PG8_WAIT_L
#undef PG8_BAR
#undef PG8_SCHED
}

__device__ __forceinline__ unsigned cvt_pk_bf16(float lo, float hi) { unsigned r; asm volatile("v_cvt_pk_bf16_f32 %0, %1, %2" : "=v"(r) : "v"(lo), "v"(hi)); return r; }
__device__ __forceinline__ u32x4 pack8(const f32x4 a, const f32x4 b) { u32x4 w; w.x = cvt_pk_bf16(a[0], a[1]); w.y = cvt_pk_bf16(a[2], a[3]); w.z = cvt_pk_bf16(b[0], b[1]); w.w = cvt_pk_bf16(b[2], b[3]); return w; }
__device__ __forceinline__ void unpack8(const u32x4 w, f32x4& a, f32x4& b) { a = (f32x4){bf2f(w.x), bf2f(w.x >> 16), bf2f(w.y), bf2f(w.y >> 16)}; b = (f32x4){bf2f(w.z), bf2f(w.z >> 16), bf2f(w.w), bf2f(w.w >> 16)}; }
__device__ __forceinline__ f32x4 silu4(const f32x4 v) { return (f32x4){siluf_(v[0]), siluf_(v[1]), siluf_(v[2]), siluf_(v[3])}; }
__device__ __forceinline__ f32x4 sig4(const f32x4 v) { return (f32x4){sigmoidf_(v[0]), sigmoidf_(v[1]), sigmoidf_(v[2]), sigmoidf_(v[3])}; }
__device__ __forceinline__ float ssq4(const f32x4 v) { return (v[0] * v[0] + v[1] * v[1]) + (v[2] * v[2] + v[3] * v[3]); }
__device__ __forceinline__ void rope8(f32x4& a, f32x4& b, const f32x4 cs, const f32x4 sn) {
    const f32x4 a0 = a, b0 = b;
    a[0] = a0[0] * cs[0] - a0[1] * sn[0]; a[1] = a0[1] * cs[0] + a0[0] * sn[0]; a[2] = a0[2] * cs[1] - a0[3] * sn[1]; a[3] = a0[3] * cs[1] + a0[2] * sn[1];
    b[0] = b0[0] * cs[2] - b0[1] * sn[2]; b[1] = b0[1] * cs[2] + b0[0] * sn[2]; b[2] = b0[2] * cs[3] - b0[3] * sn[3]; b[3] = b0[3] * cs[3] + b0[2] * sn[3];
}
#define EPI_ROWS(...) _Pragma("unroll") for (int ai = 0; ai < 2; ++ai) _Pragma("unroll") for (int m = 0; m < 4; ++m) { const int row = u.pm * BM + ai * HALF + wr * 64 + m * 16 + fr; __VA_ARGS__ if (m & 1) asm volatile("" ::: "memory"); }

struct EpiG1a {
    static constexpr bool HAS_MID = false;
    bf16_t *US, *TM, *QL, *KL, *KR; float *SQ, *SKV; const float* rope;
    __device__ __forceinline__ void operator()(const Acc& acc, const Unit& u, int wr, int wc, int fr, int fq) const {
        const int pn = u.pn, cw = wc * 32 + 8 * fq;
        if (pn < 4) { EPI_ROWS(
            _Pragma("unroll") for (int bj = 0; bj < 2; ++bj) { const int c = pn * 256 + bj * 128 + cw;
                *(u32x4*)(US + ((size_t)(c >> 4) * NT + row) * 16 + (c & 15)) = pack8(acc[ai][bj][m][0], acc[ai][bj][m][1]); } ) }
        else if (pn < 8) { EPI_ROWS(
            _Pragma("unroll") for (int bj = 0; bj < 2; ++bj) { const int c = (pn - 4) * 256 + bj * 128 + cw;
                *(u32x4*)(TM + (size_t)row * 1024 + c) = pack8(silu4(acc[ai][bj][m][0]), silu4(acc[ai][bj][m][1])); } ) }
        else if (pn < 10) { bf16_t* dst = pn == 8 ? QL : KL; float* sp = pn == 8 ? SQ : SKV;
            EPI_ROWS( float s = 0.f;
            _Pragma("unroll") for (int bj = 0; bj < 2; ++bj) { const int c = bj * 128 + cw; s += ssq4(acc[ai][bj][m][0]) + ssq4(acc[ai][bj][m][1]);
                *(u32x4*)(dst + (size_t)row * 256 + c) = pack8(acc[ai][bj][m][0], acc[ai][bj][m][1]); }
            s += __shfl_xor(s, 16); s += __shfl_xor(s, 32); if (fq == 0) sp[(size_t)row * 4 + wc] = s; ) }
        else if (wc == 0) { EPI_ROWS(
            const f32x4 cs = *(const f32x4*)(rope + (size_t)row * 32 + 4 * fq), sn = *(const f32x4*)(rope + (size_t)row * 32 + 16 + 4 * fq);
            f32x4 a = acc[ai][0][m][0], b = acc[ai][0][m][1]; rope8(a, b, cs, sn);
            *(u32x4*)(KR + (size_t)row * 32 + 8 * fq) = pack8(a, b); ) }
    }
};
struct EpiG2q {
    static constexpr bool HAS_MID = false;
    bf16_t *QN, *QR; const float* SQ; const float* rope;
    __device__ __forceinline__ void operator()(const Acc& acc, const Unit& u, int wr, int wc, int fr, int fq) const {
        const int pn = u.pn, cw = wc * 32 + 8 * fq;
        float rsv[2][4];
        EPI_ROWS( const f32x4 sp = *(const f32x4*)(SQ + (size_t)row * 4); rsv[ai][m] = QSCALE / sqrtf(((sp[0] + sp[1]) + (sp[2] + sp[3])) * (1.f / 256.f) + EPS); )
        if (pn < 4) { EPI_ROWS( const float rs = rsv[ai][m];
                _Pragma("unroll") for (int bj = 0; bj < 2; ++bj) { const int c = pn * 256 + bj * 128 + cw; *(u32x4*)(QN + (size_t)row * 1024 + c) = pack8(acc[ai][bj][m][0] * rs, acc[ai][bj][m][1] * rs); } )
        } else { EPI_ROWS( const float rs = rsv[ai][m];
                const f32x4 cs = *(const f32x4*)(rope + (size_t)row * 32 + 4 * fq), sn = *(const f32x4*)(rope + (size_t)row * 32 + 16 + 4 * fq);
                _Pragma("unroll") for (int bj = 0; bj < 2; ++bj) { const int c = (pn - 4) * 256 + bj * 128 + cw; f32x4 a = acc[ai][bj][m][0] * rs, b = acc[ai][bj][m][1] * rs; rope8(a, b, cs, sn);
                    *(u32x4*)(QR + (size_t)row * 512 + c) = pack8(a, b); } ) }
    }
};
struct EpiG2kv {
    static constexpr bool HAS_MID = false;
    bf16_t *KN, *VV; const float* SKV;
    __device__ __forceinline__ void operator()(const Acc& acc, const Unit& u, int wr, int wc, int fr, int fq) const {
        const int pn = u.pn, cw = wc * 32 + 8 * fq; bf16_t* dst = pn < 4 ? KN : VV;
        float rsv[2][4];
        EPI_ROWS( const f32x4 sp = *(const f32x4*)(SKV + (size_t)row * 4); rsv[ai][m] = 1.f / sqrtf(((sp[0] + sp[1]) + (sp[2] + sp[3])) * (1.f / 256.f) + EPS); )
        EPI_ROWS( const float rs = rsv[ai][m];
            _Pragma("unroll") for (int bj = 0; bj < 2; ++bj) { const int c = (pn & 3) * 256 + bj * 128 + cw; *(u32x4*)(dst + (size_t)row * 1024 + c) = pack8(acc[ai][bj][m][0] * rs, acc[ai][bj][m][1] * rs); } )
    }
};
struct EpiZs {
    static constexpr bool HAS_MID = false;
    bf16_t* ZS;
    __device__ __forceinline__ void operator()(const Acc& acc, const Unit& u, int wr, int wc, int fr, int fq) const {
        const int cw = wc * 32 + 8 * fq;
        EPI_ROWS( _Pragma("unroll") for (int bj = 0; bj < 2; ++bj) { const int c = u.pn * 256 + bj * 128 + cw; *(u32x4*)(ZS + (size_t)row * 1024 + c) = pack8(silu4(acc[ai][bj][m][0]), silu4(acc[ai][bj][m][1])); } )
    }
};
struct EpiGlu {
    static constexpr bool HAS_MID = false;
    bf16_t* TS; const bf16_t* ZS; const float* bias;
    __device__ __forceinline__ void operator()(const Acc& acc, const Unit& u, int wr, int wc, int fr, int fq) const {
        const int jj = u.pn * 128 + wc * 32 + 8 * fq;
        const f32x4 ba0 = *(const f32x4*)(bias + jj), ba1 = *(const f32x4*)(bias + jj + 4), bb0 = *(const f32x4*)(bias + 1024 + jj), bb1 = *(const f32x4*)(bias + 1024 + jj + 4);
        EPI_ROWS( f32x4 z0, z1; unpack8(*(const u32x4*)(ZS + (size_t)row * 1024 + jj), z0, z1);
            const f32x4 o0 = (acc[ai][0][m][0] + ba0) * sig4(acc[ai][1][m][0] + bb0) * z0, o1 = (acc[ai][0][m][1] + ba1) * sig4(acc[ai][1][m][1] + bb1) * z1;
            *(u32x4*)(TS + (size_t)row * 1024 + jj) = pack8(o0, o1); )
    }
};
struct EpiGate {
    static constexpr bool HAS_MID = false;
    bf16_t *RAT, *SGM;
    __device__ __forceinline__ void operator()(const Acc& acc, const Unit& u, int wr, int wc, int fr, int fq) const {
        const int jj = u.pn * 128 + wc * 32 + 8 * fq;
        EPI_ROWS( const f32x4 s0 = sig4(acc[ai][0][m][0]), s1 = sig4(acc[ai][0][m][1]), m0 = sig4(acc[ai][1][m][0]), m1 = sig4(acc[ai][1][m][1]);
            *(u32x4*)(RAT + (size_t)row * 1024 + jj) = pack8(s0 / m0, s1 / m1); *(u32x4*)(SGM + (size_t)row * 1024 + jj) = pack8(m0, m1); )
    }
};
struct EpiMerge {
    static constexpr bool HAS_MID = true;
    const bf16_t *RAT, *SGM; bf16_t* MG;
    __device__ __forceinline__ void mid(Acc& acc, const Unit& u, int wr, int wc, int fr, int fq) const {
        const int cw = wc * 32 + 8 * fq;
#pragma unroll
        for (int ai = 0; ai < 2; ++ai) {
            u32x4 r[4][2];
#pragma unroll
            for (int m = 0; m < 4; ++m) { const int row = u.pm * BM + ai * HALF + wr * 64 + m * 16 + fr;
#pragma unroll
                for (int bj = 0; bj < 2; ++bj) r[m][bj] = *(const u32x4*)(RAT + (size_t)row * 1024 + u.pn * 256 + bj * 128 + cw); }
#pragma unroll
            for (int m = 0; m < 4; ++m)
#pragma unroll
                for (int bj = 0; bj < 2; ++bj) { f32x4 a, b; unpack8(r[m][bj], a, b); acc[ai][bj][m][0] *= a; acc[ai][bj][m][1] *= b; }
        }
        asm volatile("s_waitcnt vmcnt(0)" ::: "memory");
    }
    __device__ __forceinline__ void operator()(const Acc& acc, const Unit& u, int wr, int wc, int fr, int fq) const {
        const int cw = wc * 32 + 8 * fq;
        EPI_ROWS( _Pragma("unroll") for (int bj = 0; bj < 2; ++bj) { const int c = u.pn * 256 + bj * 128 + cw; f32x4 a, b; unpack8(*(const u32x4*)(SGM + (size_t)row * 1024 + c), a, b);
            *(u32x4*)(MG + (size_t)row * 1024 + c) = pack8(acc[ai][bj][m][0] * a, acc[ai][bj][m][1] * b); } )
    }
};
struct EpiOut {
    static constexpr bool HAS_MID = false;
    bf16_t* OUTB; float* SO;
    __device__ __forceinline__ void operator()(const Acc& acc, const Unit& u, int wr, int wc, int fr, int fq) const {
        const int cw = wc * 32 + 8 * fq;
        EPI_ROWS( float s = 0.f;
            _Pragma("unroll") for (int bj = 0; bj < 2; ++bj) { const int c = u.pn * 256 + bj * 128 + cw; s += ssq4(acc[ai][bj][m][0]) + ssq4(acc[ai][bj][m][1]);
                *(u32x4*)(OUTB + (size_t)row * 1024 + c) = pack8(acc[ai][bj][m][0], acc[ai][bj][m][1]); }
            s += __shfl_xor(s, 16); s += __shfl_xor(s, 32); if (fq == 0) SO[(size_t)row * 16 + u.pn * 4 + wc] = s; )
    }
};
}

template <class MAP>
__device__ __forceinline__ void tr_item(const float* W, int ldw, const MAP& map, const float* kscale, bf16_t* dst, int dpitch, int koff, int nblk, float* scr, int item, int lane) {
    const int kb = item / nblk, nb = item % nblk, k0 = 64 * kb, n0 = 32 * nb;
    const int src = map(n0 + (lane & 31));
#pragma unroll 8
    for (int i = 0; i < 32; ++i) { const int kk = 2 * i + (lane >> 5); float v = (src >= 0) ? W[(size_t)(k0 + kk) * ldw + src] : 0.f; if (kscale) v *= kscale[k0 + kk]; scr[kk * 33 + (lane & 31)] = v; }
    asm volatile("s_waitcnt lgkmcnt(0)" ::: "memory");
    const int c = lane & 7;
#pragma unroll
    for (int j = 0; j < 4; ++j) { const int n = (lane >> 3) + 8 * j; const float* sc = scr + (8 * c) * 33 + n;
        u32x4 o; o.x = pk2(sc[0 * 33], sc[1 * 33]); o.y = pk2(sc[2 * 33], sc[3 * 33]); o.z = pk2(sc[4 * 33], sc[5 * 33]); o.w = pk2(sc[6 * 33], sc[7 * 33]);
        *(u32x4*)(dst + (size_t)(n0 + n) * dpitch + koff + k0 + 8 * c) = o; }
    asm volatile("s_waitcnt lgkmcnt(0)" ::: "memory");
}
struct MapG1a { __device__ __forceinline__ int operator()(int j) const { if (j < 1024) return C_US + j; if (j < 2048) return C_ZM + (j - 1024); if (j < 2304) return C_QL + (j - 2048); if (j < 2560) return C_KL + (j - 2304);
    if (j < 2592) { const int p = j - 2560; return C_KR + ((p & 1) ? 16 + (p >> 1) : (p >> 1)); } return -1; } };
struct MapOff { int off; __device__ __forceinline__ int operator()(int j) const { return off + j; } };
struct MapPair { int offa, offb; __device__ __forceinline__ int operator()(int j) const { const int pn = j >> 8, w = j & 255, jj = pn * 128 + (w & 127); return offa + (w >> 7) * (offb - offa) + jj; } };
struct MapQ { __device__ __forceinline__ int operator()(int j) const { if (j < 1024) return (j >> 6) * 96 + (j & 63); const int jj = j - 1024, h = jj >> 5, p = jj & 31; return h * 96 + 64 + ((p & 1) ? 16 + (p >> 1) : (p >> 1)); } };
struct MapKV { __device__ __forceinline__ int operator()(int j) const { return (j < 1024) ? (j >> 6) * 128 + (j & 63) : ((j - 1024) >> 6) * 128 + 64 + (j & 63); } };

__device__ __forceinline__ void prep_weights(const Args& a, float* lds) {
    const int tid = opq(threadIdx.x), lane = tid & 63, wv = tid >> 6;
    float* scr = lds + wv * (64 * 33);
    const int gw = blockIdx.x * 8 + wv, ngw = gridDim.x * 8;
    unsigned char* ws = a.ws;
    constexpr int I0 = 16 * 88, I1 = 16 * 32, I2 = 16 * 64, I3 = 16 * 64, I4 = 4 * 48, I5 = 4 * 64, I6 = 16 * 32, I7 = 16 * 32, I8 = 16 * 32;
    constexpr int NITEMS = I0 + I1 + I2 + I3 + I4 + I5 + I6 + I7 + I8;
    for (int it = gw; it < NITEMS; it += ngw) {
        int r = it;
        if (r < I0) { tr_item(a.in[6], INW, MapG1a{}, nullptr, (bf16_t*)(ws + WS_WINA), 1024, 0, 88, scr, r, lane); continue; } r -= I0;
        if (r < I1) { tr_item(a.in[6], INW, MapOff{C_ZS}, nullptr, (bf16_t*)(ws + WS_WZS), 1024, 0, 32, scr, r, lane); continue; } r -= I1;
        if (r < I2) { tr_item(a.in[6], INW, MapPair{C_GS, C_GM}, nullptr, (bf16_t*)(ws + WS_WGATE), 1024, 0, 64, scr, r, lane); continue; } r -= I2;
        if (r < I3) { tr_item(a.in[15], 2048, MapPair{0, 1024}, nullptr, (bf16_t*)(ws + WS_WGLU), 1024, 0, 64, scr, r, lane); continue; } r -= I3;
        if (r < I4) { tr_item(a.in[18], 1536, MapQ{}, a.in[17], (bf16_t*)(ws + WS_WQ), 256, 0, 48, scr, r, lane); continue; } r -= I4;
        if (r < I5) { tr_item(a.in[20], 2048, MapKV{}, a.in[19], (bf16_t*)(ws + WS_WKV), 256, 0, 64, scr, r, lane); continue; } r -= I5;
        if (r < I6) { tr_item(a.in[21], 1024, MapOff{0}, nullptr, (bf16_t*)(ws + WS_WBR), 2048, 0, 32, scr, r, lane); continue; } r -= I6;
        if (r < I7) { tr_item(a.in[22], 1024, MapOff{0}, nullptr, (bf16_t*)(ws + WS_WBR), 2048, 1024, 32, scr, r, lane); continue; } r -= I7;
        tr_item(a.in[23], 1024, MapOff{0}, nullptr, (bf16_t*)(ws + WS_WOUT), 1024, 0, 32, scr, r, lane);
    }
}

namespace att {
#define ATT_LAS __attribute__((address_space(3)))
typedef ATT_LAS unsigned char ATT_LAS_T;
typedef short bf16x8 __attribute__((ext_vector_type(8)));
typedef short s16x4 __attribute__((ext_vector_type(4)));
typedef float f32x16 __attribute__((ext_vector_type(16)));
constexpr int KT = 12288, VT = 8192, BUFB = KT + VT, WSF_OFF = 2 * BUFB;
constexpr float THR = 8.f;
__device__ __forceinline__ int crow(int r, int hi) { return (r & 3) + 8 * (r >> 2) + 4 * hi; }
__device__ __forceinline__ unsigned cvtpk(float lo, float hi) { unsigned r; asm volatile("v_cvt_pk_bf16_f32 %0, %1, %2" : "=v"(r) : "v"(lo), "v"(hi)); return r; }
__device__ __forceinline__ s16x4 vtr(ATT_LAS const unsigned char* p) { return __builtin_bit_cast(s16x4, __builtin_amdgcn_ds_read_tr16_b64_v4i16((ATT_LAS s16x4*)p)); }

__device__ __forceinline__ void attn_unit(int b, int h, int qb, const bf16_t* QN, const bf16_t* QR, const bf16_t* KN, const bf16_t* KR, const bf16_t* VV, bf16_t* TM, ATT_LAS unsigned char* lds) {
    const int tid = opq(threadIdx.x), lane = tid & 63, r32 = lane & 31, hi = lane >> 5, wid = __builtin_amdgcn_readfirstlane(tid >> 6);
    const size_t rowbase = (size_t)b * SEQ; const int q0 = qb * 256;
    const size_t tokq = rowbase + q0 + wid * 32 + r32;
    bf16x8 qf[6];
#pragma unroll
    for (int d0 = 0; d0 < 4; ++d0) qf[d0] = *(const bf16x8*)(QN + tokq * 1024 + h * 64 + d0 * 16 + hi * 8);
#pragma unroll
    for (int d0 = 0; d0 < 2; ++d0) qf[4 + d0] = *(const bf16x8*)(QR + tokq * 512 + h * 32 + d0 * 16 + hi * 8);
    const bf16_t* ksrc = KN + (rowbase + lane) * 1024 + h * 64 + wid * 8;
    const bf16_t* rsrc = KR + (rowbase + lane) * 32 + (wid & 3) * 8;
    const bf16_t* vsrc = VV + (rowbase + 16 * (wid & 3) + (lane >> 2)) * 1024 + h * 64 + (wid >> 2) * 32 + (lane & 3) * 8;
    ATT_LAS float* wsf = (ATT_LAS float*)(lds + WSF_OFF) + wid * 64;
#define ATT_DMA(t, bufo) do { \
        __builtin_amdgcn_global_load_lds((const unsigned*)(ksrc + (size_t)(t) * 64 * 1024), (ATT_LAS unsigned*)(lds + (bufo) + wid * 1024), 16, 0, 0); \
        __builtin_amdgcn_global_load_lds((const unsigned*)(vsrc + (size_t)(t) * 64 * 1024), (ATT_LAS unsigned*)(lds + (bufo) + KT + wid * 1024), 16, 0, 0); \
        if (wid < 4) __builtin_amdgcn_global_load_lds((const unsigned*)(rsrc + (size_t)(t) * 64 * 32), (ATT_LAS unsigned*)(lds + (bufo) + (8 + wid) * 1024), 16, 0, 0); } while (0)
    const int nT = 4 * qb + 4, mychunk = 4 * qb + (wid >> 1);
    float mref = 0.f, lsum = 0.f;
    f32x16 o0, o1;
#pragma unroll
    for (int r = 0; r < 16; ++r) { o0[r] = 0.f; o1[r] = 0.f; }
    ATT_DMA(0, 0);
    asm volatile("s_waitcnt vmcnt(0)" ::: "memory"); __builtin_amdgcn_s_barrier();
    const int kfo = hi * 1024 + r32 * 16;
    const int vfo = ((lane >> 4) & 1) * 32 + (lane & 3) * 8 + (4 * hi + ((lane & 15) >> 2)) * 64;
#pragma unroll 1
    for (int t = 0; t < nT; ++t) {
        const int bufo = (t & 1) * BUFB;
        if (t + 1 < nT) ATT_DMA(t + 1, BUFB - bufo);
        if (t <= mychunk) {
            ATT_LAS const unsigned char* Kb = lds + bufo + kfo; ATT_LAS const unsigned char* Vb = lds + bufo + KT + vfo;
            f32x16 p0, p1;
#pragma unroll
            for (int r = 0; r < 16; ++r) { p0[r] = -mref; p1[r] = -mref; }
#pragma unroll
            for (int d0 = 0; d0 < 6; ++d0) {
                const bf16x8 a0 = *(ATT_LAS const bf16x8*)(Kb + d0 * 2048), a1 = *(ATT_LAS const bf16x8*)(Kb + d0 * 2048 + 512);
                p0 = __builtin_amdgcn_mfma_f32_32x32x16_bf16(a0, qf[d0], p0, 0, 0, 0);
                p1 = __builtin_amdgcn_mfma_f32_32x32x16_bf16(a1, qf[d0], p1, 0, 0, 0);
            }
            float rm = fmaxf(p0[0], p1[0]);
#pragma unroll
            for (int r = 1; r < 16; ++r) rm = fmaxf(rm, fmaxf(p0[r], p1[r]));
            rm = fmaxf(rm, __shfl_xor(rm, 32));
            if (t == 0 || __any(rm > THR)) {
                const float dl = (t == 0) ? rm : fmaxf(rm, 0.f);
                mref += dl;
#pragma unroll
                for (int r = 0; r < 16; ++r) { p0[r] -= dl; p1[r] -= dl; }
                const float f = __builtin_amdgcn_exp2f(-dl); lsum *= f;
                if (t != 0) {
                    if (hi == 0) wsf[r32] = f;
                    asm volatile("s_waitcnt lgkmcnt(0)" ::: "memory");
#pragma unroll
                    for (int r = 0; r < 16; ++r) { const float fr_ = wsf[crow(r, hi)]; o0[r] *= fr_; o1[r] *= fr_; }
                    asm volatile("s_waitcnt lgkmcnt(0)" ::: "memory");
                }
            }
            float ps = 0.f;
#pragma unroll
            for (int r = 0; r < 16; ++r) { p0[r] = __builtin_amdgcn_exp2f(p0[r]); p1[r] = __builtin_amdgcn_exp2f(p1[r]); ps += p0[r] + p1[r]; }
            lsum += ps;
            bf16x8 pa[4];
#pragma unroll
            for (int s = 0; s < 2; ++s) {
                u32x4 w0, w1;
                w0.x = cvtpk(p0[8 * s + 0], p0[8 * s + 1]); w0.y = cvtpk(p0[8 * s + 2], p0[8 * s + 3]); w0.z = cvtpk(p0[8 * s + 4], p0[8 * s + 5]); w0.w = cvtpk(p0[8 * s + 6], p0[8 * s + 7]);
                w1.x = cvtpk(p1[8 * s + 0], p1[8 * s + 1]); w1.y = cvtpk(p1[8 * s + 2], p1[8 * s + 3]); w1.z = cvtpk(p1[8 * s + 4], p1[8 * s + 5]); w1.w = cvtpk(p1[8 * s + 6], p1[8 * s + 7]);
                pa[s] = __builtin_bit_cast(bf16x8, w0); pa[2 + s] = __builtin_bit_cast(bf16x8, w1);
            }
#pragma unroll
            for (int s = 0; s < 4; ++s) {
                const s16x4 l0 = vtr(Vb + s * 1024), h0 = vtr(Vb + s * 1024 + 512), l1 = vtr(Vb + 4096 + s * 1024), h1 = vtr(Vb + 4096 + s * 1024 + 512);
                const bf16x8 v0 = (bf16x8){l0[0], l0[1], l0[2], l0[3], h0[0], h0[1], h0[2], h0[3]}, v1 = (bf16x8){l1[0], l1[1], l1[2], l1[3], h1[0], h1[1], h1[2], h1[3]};
                o0 = __builtin_amdgcn_mfma_f32_32x32x16_bf16(pa[s], v0, o0, 0, 0, 0);
                o1 = __builtin_amdgcn_mfma_f32_32x32x16_bf16(pa[s], v1, o1, 0, 0, 0);
            }
        }
        asm volatile("s_waitcnt vmcnt(0) lgkmcnt(0)" ::: "memory"); __builtin_amdgcn_s_barrier();
    }
    lsum += __shfl_xor(lsum, 32);
    if (hi == 0) wsf[32 + r32] = lsum;
    asm volatile("s_waitcnt lgkmcnt(0)" ::: "memory");
    bf16_t* Ow = TM + (rowbase + q0 + wid * 32) * 1024 + h * 64 + r32;
#pragma unroll
    for (int r = 0; r < 16; ++r) { const int q = crow(r, hi); const float il = 1.f / wsf[32 + q];
        bf16_t* p = Ow + (size_t)q * 1024;
        p[0] = (bf16_t)f2bf(o0[r] * il * bf2f(p[0])); p[32] = (bf16_t)f2bf(o1[r] * il * bf2f(p[32])); }
    asm volatile("s_waitcnt lgkmcnt(0)" ::: "memory"); __builtin_amdgcn_s_barrier();
#undef ATT_DMA
}

__device__ __forceinline__ void attn_phase(const Args& a, ATT_LAS unsigned char* lds) {
    const int G = gridDim.x, bid = blockIdx.x;
    const int v = (G % 8 == 0) ? (bid % 8) * (G / 8) + bid / 8 : bid;
    const bf16_t* QN = (const bf16_t*)(a.ws + WS_QN); const bf16_t* QR = (const bf16_t*)(a.ws + WS_QR); const bf16_t* KN = (const bf16_t*)(a.ws + WS_KN);
    const bf16_t* KR = (const bf16_t*)(a.ws + WS_KR); const bf16_t* VV = (const bf16_t*)(a.ws + WS_VV); bf16_t* TM = (bf16_t*)(a.ws + WS_TM);
    for (int s = v; s < NB * NH * 16; s += G) {
        const int bh = (s >> 1) % (NB * NH), half = s & 1, rnd = s / (2 * NB * NH);
        const int j = 2 * (rnd >> 1) + half; const int qb = (rnd & 1) ? 15 - j : j;
        attn_unit(bh / NH, bh % NH, qb, QN, QR, KN, KR, VV, TM, lds);
    }
}
}

__device__ __forceinline__ void ph0_prep(const Args& a) {
    const int gtid = blockIdx.x * NTHR + opq(threadIdx.x), gsz = gridDim.x * NTHR;
    const float* c = a.in[1]; const int* pos = (const int*)a.in[2]; const float* w_ada = a.in[3]; const float* b_ada = a.in[4];
    float* mod = (float*)(a.ws + WS_MOD);
    for (int idx = gtid; idx < NB * 3072; idx += gsz) {
        const int b = idx / 3072, j = idx % 3072; float s = b_ada[j];
        for (int k = 0; k < DM; ++k) s += c[b * DM + k] * w_ada[(size_t)k * 3072 + j];
        mod[idx] = s;
    }
    float* rope = (float*)(a.ws + WS_ROPE);
    for (int idx = gtid; idx < NT * 16; idx += gsz) {
        const int tok = idx >> 4, i = idx & 15;
        const float inv = powf(10000.f, -(float)i / 16.f);
        const float ang = (float)pos[tok] * inv; float sn, cs; sincosf(ang, &sn, &cs);
        rope[(size_t)tok * 32 + i] = cs; rope[(size_t)tok * 32 + 16 + i] = sn;
    }
    const float* log_dt = a.in[7]; const float* a_re = a.in[8]; const float* a_im = a.in[9]; const float* b_re = a.in[10]; const float* b_im = a.in[11];
    float* abar = (float*)(a.ws + WS_SSMC); float* bbar = (float*)(a.ws + WS_SSMC + 65536);
    for (int idx = gtid; idx < NG * NS; idx += gsz) {
        const int g = idx / NS;
        const float dt = expf(log_dt[g]), lr = a_re[idx], li = a_im[idx];
        const float mag = expf(lr * dt); float sn, cs; sincosf(li * dt, &sn, &cs);
        const float abr = mag * cs, abi = mag * sn, den = lr * lr + li * li, nr = abr - 1.f, ni = abi;
        const float fr = (nr * lr + ni * li) / den, fi = (ni * lr - nr * li) / den;
        abar[idx * 2] = abr; abar[idx * 2 + 1] = abi;
        for (int q = 0; q < GP; ++q) { const float br = b_re[(size_t)idx * GP + q], bi = b_im[(size_t)idx * GP + q];
            bbar[((size_t)idx * GP + q) * 2] = fr * br - fi * bi; bbar[((size_t)idx * GP + q) * 2 + 1] = fr * bi + fi * br; }
    }
}

__device__ __forceinline__ void ph1_hnorm(const Args& a) {
    const int tid_ = opq(threadIdx.x), lane = tid_ & 63, gw = blockIdx.x * (NTHR / 64) + (tid_ >> 6), ngw = gridDim.x * (NTHR / 64);
    const float* x = a.in[0]; const float* g_pre = a.in[5]; const float* mod = (const float*)(a.ws + WS_MOD); bf16_t* HB = (bf16_t*)(a.ws + WS_HB);
    for (int m = gw; m < NT; m += ngw) {
        const int b = m / SEQ; const f32x4* xr = (const f32x4*)(x + (size_t)m * DM) + lane;
        f32x4 v[4]; float s = 0.f;
#pragma unroll
        for (int j = 0; j < 4; ++j) { v[j] = xr[64 * j]; s += (v[j].x * v[j].x + v[j].y * v[j].y) + (v[j].z * v[j].z + v[j].w * v[j].w); }
        const float rstd = 1.f / sqrtf(wave_sum(s) * (1.f / DM) + EPS);
        unsigned long long* o8 = (unsigned long long*)(HB + (size_t)m * DM) + lane;
#pragma unroll
        for (int j = 0; j < 4; ++j) { const int k = 256 * j + 4 * lane;
            const f32x4 g = *(const f32x4*)(g_pre + k), sh = *(const f32x4*)(mod + b * 3072 + k), sc = *(const f32x4*)(mod + b * 3072 + 1024 + k);
            const f32x4 h = v[j] * rstd * g * (sc + 1.f) + sh;
            o8[64 * j] = (unsigned long long)pk2(h.x, h.y) | ((unsigned long long)pk2(h.z, h.w) << 32); }
    }
}

struct BL2 { const float* W; __device__ __forceinline__ float b(int k, int j) const {
    int src;
    if (j < 1024) src = C_US + j; else if (j < 1280) src = C_QL + (j - 1024); else if (j < 1536) src = C_KL + (j - 1280);
    else if (j < 1568) { const int p = j - 1536; src = C_KR + ((p & 1) ? 16 + (p >> 1) : (p >> 1)); } else src = C_ZM + (j - 1568);
    return W[(size_t)k * INW + src]; } };
struct EP2 { bf16_t *US, *QL, *KL, *KR, *TM; float *ssq_q, *ssq_kv; const float* rope;
    __device__ __forceinline__ void e(int row, int j, float v0, float v1) const {
        if (j < 1024) { *(unsigned*)(US + ((size_t)(j >> 4) * NT + row) * 16 + (j & 15)) = pk2(v0, v1); }
        else if (j < 1280) { *(unsigned*)(QL + (size_t)row * 256 + (j - 1024)) = pk2(v0, v1); atomicAdd(ssq_q + row, v0 * v0 + v1 * v1); }
        else if (j < 1536) { *(unsigned*)(KL + (size_t)row * 256 + (j - 1280)) = pk2(v0, v1); atomicAdd(ssq_kv + row, v0 * v0 + v1 * v1); }
        else if (j < 1568) { const int p = j - 1536, i = p >> 1; const float cs = rope[(size_t)row * 32 + i], sn = rope[(size_t)row * 32 + 16 + i];
            *(unsigned*)(KR + (size_t)row * 32 + p) = pk2(v0 * cs - v1 * sn, v1 * cs + v0 * sn); }
        else { *(unsigned*)(TM + (size_t)row * 1024 + (j - 1568)) = pk2(siluf_(v0), siluf_(v1)); }
    } };

struct BL3q { const float* W; const float* g; __device__ __forceinline__ float b(int k, int j) const {
    int src; if (j < 1024) src = (j >> 6) * 96 + (j & 63); else { const int jj = j - 1024, h = jj >> 5, p = jj & 31; src = h * 96 + 64 + ((p & 1) ? 16 + (p >> 1) : (p >> 1)); }
    return W[(size_t)k * 1536 + src] * g[k]; } };
struct EP3q { bf16_t *QN, *QR; const float* ssq; const float* rope;
    __device__ __forceinline__ void e(int row, int j, float v0, float v1) const {
        const float rs = QSCALE / sqrtf(ssq[row] * (1.f / 256.f) + EPS); v0 *= rs; v1 *= rs;
        if (j < 1024) *(unsigned*)(QN + (size_t)row * 1024 + j) = pk2(v0, v1);
        else { const int jj = j - 1024, i = (jj & 31) >> 1; const float cs = rope[(size_t)row * 32 + i], sn = rope[(size_t)row * 32 + 16 + i];
            *(unsigned*)(QR + (size_t)row * 512 + jj) = pk2(v0 * cs - v1 * sn, v1 * cs + v0 * sn); }
    } };
struct BL3kv { const float* W; const float* g; __device__ __forceinline__ float b(int k, int j) const {
    const int src = (j < 1024) ? (j >> 6) * 128 + (j & 63) : ((j - 1024) >> 6) * 128 + 64 + (j & 63);
    return W[(size_t)k * 2048 + src] * g[k]; } };
struct EP3kv { bf16_t *KN, *VV; const float* ssq;
    __device__ __forceinline__ void e(int row, int j, float v0, float v1) const {
        const float rs = 1.f / sqrtf(ssq[row] * (1.f / 256.f) + EPS); v0 *= rs; v1 *= rs;
        if (j < 1024) *(unsigned*)(KN + (size_t)row * 1024 + j) = pk2(v0, v1); else *(unsigned*)(VV + (size_t)row * 1024 + (j - 1024)) = pk2(v0, v1);
    } };

__device__ __forceinline__ void ph4_attn(const Args& a, float* lds) {
    const bf16_t* QN = (const bf16_t*)(a.ws + WS_QN); const bf16_t* QR = (const bf16_t*)(a.ws + WS_QR); const bf16_t* KN = (const bf16_t*)(a.ws + WS_KN);
    const bf16_t* KR = (const bf16_t*)(a.ws + WS_KR); const bf16_t* VV = (const bf16_t*)(a.ws + WS_VV); bf16_t* TM = (bf16_t*)(a.ws + WS_TM);
    float* Kt = lds;
    float* Vt = lds + 64 * 100;
    const int tid = opq(threadIdx.x), wv = tid >> 6, half = wv >> 2;
    for (int item = blockIdx.x; item < NB * NH * 16; item += gridDim.x) {
        const int qb = item & 15, h = (item >> 4) & 15, b = item >> 8;
        const size_t tok = (size_t)b * SEQ + qb * 256 + (tid & 255);
        float q[96], o[32];
#pragma unroll
        for (int d = 0; d < 64; d += 2) { const unsigned w = *(const unsigned*)(QN + tok * 1024 + h * 64 + d); q[d] = bf2f(w); q[d + 1] = bf2f(w >> 16); }
#pragma unroll
        for (int d = 0; d < 32; d += 2) { const unsigned w = *(const unsigned*)(QR + tok * 512 + h * 32 + d); q[64 + d] = bf2f(w); q[64 + d + 1] = bf2f(w >> 16); }
#pragma unroll
        for (int d = 0; d < 32; ++d) o[d] = 0.f;
        float m = -1e30f, l = 0.f;
        const int mychunk = qb * 4 + (wv & 3), nkt = qb * 4 + 4;
        for (int kt = 0; kt < nkt; ++kt) {
            __syncthreads();
            const size_t kt0 = (size_t)b * SEQ + kt * 64;
            for (int e = tid; e < 64 * 32; e += NTHR) { const int key = e >> 5, d2 = (e & 31) * 2; const unsigned w = *(const unsigned*)(KN + (kt0 + key) * 1024 + h * 64 + d2); Kt[key * 100 + d2] = bf2f(w); Kt[key * 100 + d2 + 1] = bf2f(w >> 16); }
            for (int e = tid; e < 64 * 16; e += NTHR) { const int key = e >> 4, d2 = (e & 15) * 2; const unsigned w = *(const unsigned*)(KR + (kt0 + key) * 32 + d2); Kt[key * 100 + 64 + d2] = bf2f(w); Kt[key * 100 + 64 + d2 + 1] = bf2f(w >> 16); }
            for (int e = tid; e < 64 * 32; e += NTHR) { const int key = e >> 5, d2 = (e & 31) * 2; const unsigned w = *(const unsigned*)(VV + (kt0 + key) * 1024 + h * 64 + d2); Vt[key * 68 + d2] = bf2f(w); Vt[key * 68 + d2 + 1] = bf2f(w >> 16); }
            __syncthreads();
            if (kt <= mychunk) {
                for (int key = 0; key < 64; ++key) {
                    float s = 0.f;
#pragma unroll
                    for (int d = 0; d < 96; d += 4) { const f32x4 kk = *(const f32x4*)(Kt + key * 100 + d); s += q[d] * kk[0] + q[d + 1] * kk[1] + q[d + 2] * kk[2] + q[d + 3] * kk[3]; }
                    if (s > m) { const float f = exp2f(m - s); l *= f;
#pragma unroll
                        for (int d = 0; d < 32; ++d) o[d] *= f;
                        m = s; }
                    const float p = exp2f(s - m); l += p;
#pragma unroll
                    for (int d = 0; d < 32; d += 4) { const f32x4 vv = *(const f32x4*)(Vt + key * 68 + half * 32 + d); o[d] += p * vv[0]; o[d + 1] += p * vv[1]; o[d + 2] += p * vv[2]; o[d + 3] += p * vv[3]; }
                }
            }
        }
        const float il = 1.f / l;
#pragma unroll
        for (int d = 0; d < 32; d += 2) { unsigned* p = (unsigned*)(TM + tok * 1024 + h * 64 + half * 32 + d); const unsigned w = *p; *p = pk2(o[d] * il * bf2f(w), o[d + 1] * il * bf2f(w >> 16)); }
    }
}

__device__ __forceinline__ void ph5_ssm(const Args& a, float* lds) {
    const int tid = opq(threadIdx.x), lane = tid & 63, wv = tid >> 6;
    const bf16_t* US = (const bf16_t*)(a.ws + WS_US); bf16_t* YG = (bf16_t*)(a.ws + WS_YG);
    const float* abar = (const float*)(a.ws + WS_SSMC); const float* bbar = (const float*)(a.ws + WS_SSMC + 65536);
    const float* c_re = a.in[12]; const float* c_im = a.in[13]; const float* dsk = a.in[14];
    float* Xs = lds + wv * 4096;
    float* Cs = Xs + 1024; float* Us = Cs + 2048;
    for (int item = blockIdx.x * 8 + wv; item < NB * NG; item += gridDim.x * 8) {
        const int b = item / NG, g = item % NG;
        const float abr = abar[(g * NS + lane) * 2], abi = abar[(g * NS + lane) * 2 + 1];
        float bbr[16], bbi[16];
#pragma unroll
        for (int q = 0; q < 16; ++q) { bbr[q] = bbar[((size_t)(g * NS + lane) * 16 + q) * 2]; bbi[q] = bbar[((size_t)(g * NS + lane) * 16 + q) * 2 + 1]; }
        for (int p = 0; p < 16; ++p) { Cs[(p * 64 + lane) * 2] = c_re[((size_t)g * 16 + p) * 64 + lane]; Cs[(p * 64 + lane) * 2 + 1] = c_im[((size_t)g * 16 + p) * 64 + lane]; }
        float xr = 0.f, xi = 0.f;
        const bf16_t* ug = US + ((size_t)g * NT + (size_t)b * SEQ) * 16; bf16_t* yg = YG + ((size_t)g * NT + (size_t)b * SEQ) * 16;
        const int tt = lane >> 3, p0 = (lane & 7) * 2;
        const float d0 = dsk[g * 16 + p0], d1 = dsk[g * 16 + p0 + 1];
        for (int t0 = 0; t0 < SEQ; t0 += 8) {
            { const unsigned w = *(const unsigned*)(ug + (size_t)t0 * 16 + lane * 2); Us[lane * 2] = bf2f(w); Us[lane * 2 + 1] = bf2f(w >> 16); }
            asm volatile("s_waitcnt vmcnt(0) lgkmcnt(0)" ::: "memory");
#pragma unroll
            for (int t = 0; t < 8; ++t) {
                float bur = 0.f, bui = 0.f;
#pragma unroll
                for (int q = 0; q < 16; ++q) { const float u = Us[t * 16 + q]; bur += bbr[q] * u; bui += bbi[q] * u; }
                const float nr = abr * xr - abi * xi + bur, ni = abr * xi + abi * xr + bui; xr = nr; xi = ni;
                Xs[(t * 64 + lane) * 2] = xr; Xs[(t * 64 + lane) * 2 + 1] = xi;
            }
            asm volatile("s_waitcnt vmcnt(0) lgkmcnt(0)" ::: "memory");
            float y0 = 0.f, y1 = 0.f;
            for (int n = 0; n < 64; ++n) { const float vr = Xs[(tt * 64 + n) * 2], vi = Xs[(tt * 64 + n) * 2 + 1];
                y0 += Cs[(p0 * 64 + n) * 2] * vr - Cs[(p0 * 64 + n) * 2 + 1] * vi; y1 += Cs[((p0 + 1) * 64 + n) * 2] * vr - Cs[((p0 + 1) * 64 + n) * 2 + 1] * vi; }
            y0 += d0 * Us[tt * 16 + p0]; y1 += d1 * Us[tt * 16 + p0 + 1];
            *(unsigned*)(yg + (size_t)(t0 + tt) * 16 + p0) = pk2(gelu_tanh(y0), gelu_tanh(y1));
            asm volatile("s_waitcnt vmcnt(0) lgkmcnt(0)" ::: "memory");
        }
    }
}

struct BLzs { const float* W; __device__ __forceinline__ float b(int k, int j) const { return W[(size_t)k * INW + C_ZS + j]; } };
struct EPzs { bf16_t* ZS; __device__ __forceinline__ void e(int row, int j, float v0, float v1) const { *(unsigned*)(ZS + (size_t)row * 1024 + j) = pk2(siluf_(v0), siluf_(v1)); } };
struct BLglu { const float* W; __device__ __forceinline__ float b(int k, int j) const { return W[(size_t)k * 2048 + ((j & 1) ? 1024 + (j >> 1) : (j >> 1))]; } };
struct EPglu { bf16_t* TS; const bf16_t* ZS; const float* bias; __device__ __forceinline__ void e(int row, int j, float v0, float v1) const {
    const int jj = j >> 1; const float ga = v0 + bias[jj], gb = v1 + bias[1024 + jj]; TS[(size_t)row * 1024 + jj] = (bf16_t)f2bf(ga * sigmoidf_(gb) * bf2f(ZS[(size_t)row * 1024 + jj])); } };
struct BLgate { const float* W; __device__ __forceinline__ float b(int k, int j) const { return W[(size_t)k * INW + ((j & 1) ? C_GM + (j >> 1) : C_GS + (j >> 1))]; } };
struct EPgate { bf16_t *GS, *GM; __device__ __forceinline__ void e(int row, int j, float v0, float v1) const { const int jj = j >> 1; GS[(size_t)row * 1024 + jj] = (bf16_t)f2bf(sigmoidf_(v0)); GM[(size_t)row * 1024 + jj] = (bf16_t)f2bf(sigmoidf_(v1)); } };
struct BLplain { const float* W; int ldw; __device__ __forceinline__ float b(int k, int j) const { return W[(size_t)k * ldw + j]; } };
struct EPbs { float* P1; const bf16_t* GS; __device__ __forceinline__ void e(int row, int j, float v0, float v1) const {
    const unsigned w = *(const unsigned*)(GS + (size_t)row * 1024 + j); P1[(size_t)row * 1024 + j] = bf2f(w) * v0; P1[(size_t)row * 1024 + j + 1] = bf2f(w >> 16) * v1; } };
struct EPbm { const float* P1; const bf16_t* GM; bf16_t* MG; __device__ __forceinline__ void e(int row, int j, float v0, float v1) const {
    const unsigned w = *(const unsigned*)(GM + (size_t)row * 1024 + j); *(unsigned*)(MG + (size_t)row * 1024 + j) = pk2(P1[(size_t)row * 1024 + j] + bf2f(w) * v0, P1[(size_t)row * 1024 + j + 1] + bf2f(w >> 16) * v1); } };
struct EPout { float* O; __device__ __forceinline__ void e(int row, int j, float v0, float v1) const { O[(size_t)row * 1024 + j] = v0; O[(size_t)row * 1024 + j + 1] = v1; } };

__device__ __forceinline__ void ph_final(const Args& a) {
    const int tid_ = opq(threadIdx.x), lane = tid_ & 63, gw = blockIdx.x * (NTHR / 64) + (tid_ >> 6), ngw = gridDim.x * (NTHR / 64);
    const float* x = a.in[0]; const float* g_post = a.in[24]; const float* mod = (const float*)(a.ws + WS_MOD);
#if FAST_OUT
    const bf16_t* OB = (const bf16_t*)(a.ws + WS_OUTB); const float* SO = (const float*)(a.ws + WS_SO);
    for (int m = gw; m < NT; m += ngw) {
        const int b = m / SEQ; const f32x4* xr = (const f32x4*)(x + (size_t)m * DM) + lane;
        const f32x4 p0 = *(const f32x4*)(SO + (size_t)m * 16), p1 = *(const f32x4*)(SO + (size_t)m * 16 + 4), p2 = *(const f32x4*)(SO + (size_t)m * 16 + 8), p3 = *(const f32x4*)(SO + (size_t)m * 16 + 12);
        const f32x4 ps = (p0 + p1) + (p2 + p3);
        const float rstd = 1.f / sqrtf(((ps[0] + ps[1]) + (ps[2] + ps[3])) * (1.f / DM) + EPS);
        const u32x2* orow = (const u32x2*)(OB + (size_t)m * DM) + lane;
        f32x4* o = (f32x4*)(a.out + (size_t)m * DM) + lane;
#pragma unroll
        for (int j = 0; j < 4; ++j) { const int k = 256 * j + 4 * lane; const u32x2 w = orow[64 * j]; const f32x4 v = (f32x4){bf2f(w.x), bf2f(w.x >> 16), bf2f(w.y), bf2f(w.y >> 16)};
            const f32x4 g = *(const f32x4*)(g_post + k), gt = *(const f32x4*)(mod + b * 3072 + 2048 + k);
            o[64 * j] = xr[64 * j] + gt * (v * rstd * g); }
    }
#else
    const float* OF = (const float*)(a.ws + WS_OUTF);
    for (int m = gw; m < NT; m += ngw) {
        const int b = m / SEQ; const f32x4* orow = (const f32x4*)(OF + (size_t)m * DM) + lane; const f32x4* xr = (const f32x4*)(x + (size_t)m * DM) + lane;
        f32x4 v[4]; float s = 0.f;
#pragma unroll
        for (int j = 0; j < 4; ++j) { v[j] = orow[64 * j]; s += (v[j].x * v[j].x + v[j].y * v[j].y) + (v[j].z * v[j].z + v[j].w * v[j].w); }
        const float rstd = 1.f / sqrtf(wave_sum(s) * (1.f / DM) + EPS);
        f32x4* o = (f32x4*)(a.out + (size_t)m * DM) + lane;
#pragma unroll
        for (int j = 0; j < 4; ++j) { const int k = 256 * j + 4 * lane; const f32x4 g = *(const f32x4*)(g_post + k), gt = *(const f32x4*)(mod + b * 3072 + 2048 + k);
            o[64 * j] = xr[64 * j] + gt * (v[j] * rstd * g); }
    }
#endif
}

constexpr int NPHASE = 11;
__global__ void __launch_bounds__(NTHR, 2) mk_fwd(Args a) {
    extern __shared__ __attribute__((aligned(16))) unsigned char lds_raw[];
    float* lds = (float*)lds_raw;
    unsigned char* ws = a.ws;
#define SEAM(k) do { if (a.ph_lo <= (k) && (k) + 1 < a.ph_hi) { cg::this_grid().sync(); } } while (0)
#define IN(k) (a.ph_lo <= (k) && (k) < a.ph_hi)
    pg8::PG8_LAS_T* l3 = (pg8::PG8_LAS_T*)lds_raw;
    const int G = gridDim.x, bid = blockIdx.x;
    if (IN(0)) { ph0_prep(a); prep_weights(a, lds); } SEAM(0);
    if (IN(1)) { ph1_hnorm(a); } SEAM(1);
    if (IN(2)) {
#if FAST_G1A
        pg8::Gemm g{(const char*)(ws + WS_HB), (const char*)(ws + WS_HB), (const char*)(ws + WS_WINA), 2816, 1024, 1024, 0, 16}; pg8::StaticOrder S; S.init(NT, 2816, G, bid);
        pg8::EpiG1a E{(bf16_t*)(ws + WS_US), (bf16_t*)(ws + WS_TM), (bf16_t*)(ws + WS_QL), (bf16_t*)(ws + WS_KL), (bf16_t*)(ws + WS_KR), (float*)(ws + WS_SQ), (float*)(ws + WS_SKV), (const float*)(ws + WS_ROPE)};
        pg8::gemm_phase(l3, g, S, E);
#else
        ARow al{(const bf16_t*)(ws + WS_HB), 1024}; BL2 bl{a.in[6]};
        EP2 ep{(bf16_t*)(ws + WS_US), (bf16_t*)(ws + WS_QL), (bf16_t*)(ws + WS_KL), (bf16_t*)(ws + WS_KR), (bf16_t*)(ws + WS_TM), (float*)(ws + WS_CTL), (float*)(ws + WS_CTL + 131072), (const float*)(ws + WS_ROPE)};
        gemm_o(lds, NT, 2592, 1024, al, bl, ep);
#endif
    } SEAM(2);
    if (IN(3)) {
#if FAST_G2
        { pg8::Gemm g{(const char*)(ws + WS_QL), (const char*)(ws + WS_QL), (const char*)(ws + WS_WQ), 1536, 256, 256, 0, 4}; pg8::StaticOrder S; S.init(NT, 1536, G, bid);
          pg8::EpiG2q E{(bf16_t*)(ws + WS_QN), (bf16_t*)(ws + WS_QR), (const float*)(ws + WS_SQ), (const float*)(ws + WS_ROPE)}; pg8::gemm_phase(l3, g, S, E); }
        { pg8::Gemm g{(const char*)(ws + WS_KL), (const char*)(ws + WS_KL), (const char*)(ws + WS_WKV), 2048, 256, 256, 0, 4}; pg8::StaticOrder S; S.init(NT, 2048, G, bid);
          pg8::EpiG2kv E{(bf16_t*)(ws + WS_KN), (bf16_t*)(ws + WS_VV), (const float*)(ws + WS_SKV)}; pg8::gemm_phase(l3, g, S, E); }
#else
        { ARow al{(const bf16_t*)(ws + WS_QL), 256}; BL3q bl{a.in[18], a.in[17]}; EP3q ep{(bf16_t*)(ws + WS_QN), (bf16_t*)(ws + WS_QR), (const float*)(ws + WS_CTL), (const float*)(ws + WS_ROPE)};
          gemm_o(lds, NT, 1536, 256, al, bl, ep); }
        { ARow al{(const bf16_t*)(ws + WS_KL), 256}; BL3kv bl{a.in[20], a.in[19]}; EP3kv ep{(bf16_t*)(ws + WS_KN), (bf16_t*)(ws + WS_VV), (const float*)(ws + WS_CTL + 131072)};
          gemm_o(lds, NT, 2048, 256, al, bl, ep); }
#endif
    } SEAM(3);
#if FAST_ATT
    if (IN(4)) { att::attn_phase(a, (att::ATT_LAS_T*)lds_raw); } SEAM(4);
#else
    if (IN(4)) { ph4_attn(a, lds); } SEAM(4);
#endif
    if (IN(5)) {
#if FAST_ZS
        { pg8::Gemm g{(const char*)(ws + WS_HB), (const char*)(ws + WS_HB), (const char*)(ws + WS_WZS), 1024, 1024, 1024, 0, 16}; pg8::StaticOrder S; S.init(NT, 1024, G, bid);
          pg8::EpiZs E{(bf16_t*)(ws + WS_ZS)}; pg8::gemm_phase(l3, g, S, E); }
#else
        { ARow al{(const bf16_t*)(ws + WS_HB), 1024}; BLzs bl{a.in[6]}; EPzs ep{(bf16_t*)(ws + WS_ZS)}; gemm_o(lds, NT, 1024, 1024, al, bl, ep); }
#endif
        __syncthreads();
        ph5_ssm(a, lds);
    } SEAM(5);
    if (IN(6)) {
#if FAST_GLU
        { pg8::Gemm g{(const char*)(ws + WS_YG), (const char*)(ws + WS_YG), (const char*)(ws + WS_WGLU), 2048, 1024, 1024, 1, 16}; pg8::StaticOrder S; S.init(NT, 2048, G, bid);
          pg8::EpiGlu E{(bf16_t*)(ws + WS_TS), (const bf16_t*)(ws + WS_ZS), a.in[16]}; pg8::gemm_phase(l3, g, S, E); }
#else
        { AGrp al{(const bf16_t*)(ws + WS_YG)}; BLglu bl{a.in[15]}; EPglu ep{(bf16_t*)(ws + WS_TS), (const bf16_t*)(ws + WS_ZS), a.in[16]}; gemm_o(lds, NT, 2048, 1024, al, bl, ep); }
#endif
#if FAST_MERGE
        { pg8::Gemm g{(const char*)(ws + WS_HB), (const char*)(ws + WS_HB), (const char*)(ws + WS_WGATE), 2048, 1024, 1024, 0, 16}; pg8::StaticOrder S; S.init(NT, 2048, G, bid);
          pg8::EpiGate E{(bf16_t*)(ws + WS_RAT), (bf16_t*)(ws + WS_SGM)}; pg8::gemm_phase(l3, g, S, E); }
#else
        { ARow al{(const bf16_t*)(ws + WS_HB), 1024}; BLgate bl{a.in[6]}; EPgate ep{(bf16_t*)(ws + WS_GS), (bf16_t*)(ws + WS_GM)}; gemm_o(lds, NT, 2048, 1024, al, bl, ep); }
#endif
    } SEAM(6);
#if FAST_MERGE
    if (IN(7)) { pg8::Gemm g{(const char*)(ws + WS_TS), (const char*)(ws + WS_TM), (const char*)(ws + WS_WBR), 1024, 2048, 1024, 0, 16}; pg8::StaticOrder S; S.init(NT, 1024, G, bid);
        pg8::EpiMerge E{(const bf16_t*)(ws + WS_RAT), (const bf16_t*)(ws + WS_SGM), (bf16_t*)(ws + WS_MG)}; pg8::gemm_phase(l3, g, S, E); } SEAM(7);
    SEAM(8);
#else
    if (IN(7)) { ARow al{(const bf16_t*)(ws + WS_TS), 1024}; BLplain bl{a.in[21], 1024}; EPbs ep{(float*)(ws + WS_P1), (const bf16_t*)(ws + WS_GS)}; gemm_o(lds, NT, 1024, 1024, al, bl, ep); } SEAM(7);
    if (IN(8)) { ARow al{(const bf16_t*)(ws + WS_TM), 1024}; BLplain bl{a.in[22], 1024}; EPbm ep{(const float*)(ws + WS_P1), (const bf16_t*)(ws + WS_GM), (bf16_t*)(ws + WS_MG)}; gemm_o(lds, NT, 1024, 1024, al, bl, ep); } SEAM(8);
#endif
    if (IN(9)) {
#if FAST_OUT
        pg8::Gemm g{(const char*)(ws + WS_MG), (const char*)(ws + WS_MG), (const char*)(ws + WS_WOUT), 1024, 1024, 1024, 0, 16}; pg8::StaticOrder S; S.init(NT, 1024, G, bid);
        pg8::EpiOut E{(bf16_t*)(ws + WS_OUTB), (float*)(ws + WS_SO)}; pg8::gemm_phase(l3, g, S, E);
#else
        ARow al{(const bf16_t*)(ws + WS_MG), 1024}; BLplain bl{a.in[23], 1024}; EPout ep{(float*)(ws + WS_OUTF)}; gemm_o(lds, NT, 1024, 1024, al, bl, ep);
#endif
    } SEAM(9);
    if (IN(10)) { ph_final(a); }
#undef SEAM
#undef IN
}

extern "C" void kernel_launch(void* const* d_in, const int* in_sizes, int n_in, void* d_out, int out_size, void* d_ws, size_t ws_size, hipStream_t stream) {
    static int grid = 0;
    if (grid == 0) {
        if (n_in != 25 || out_size != NT * DM || ws_size < WS_END) { fprintf(stderr, "kernel_launch: unexpected shapes n_in %d out %d ws %zu\n", n_in, out_size, ws_size); grid = -1; return; }
        int dev = 0, cus = 0, per_cu = 0;
        hipGetDevice(&dev); hipDeviceGetAttribute(&cus, hipDeviceAttributeMultiprocessorCount, dev);
        hipFuncSetAttribute((const void*)mk_fwd, hipFuncAttributeMaxDynamicSharedMemorySize, LDS_BYTES);
        hipOccupancyMaxActiveBlocksPerMultiprocessor(&per_cu, (const void*)mk_fwd, NTHR, LDS_BYTES);
        (void)hipGetLastError();
        if (per_cu < 1) per_cu = 1;
        grid = cus * 1;
        fprintf(stderr, "kernel_launch: cus %d per_cu %d grid %d ws %zu\n", cus, per_cu, grid, ws_size);
    }
    if (grid < 0) return;
    hipMemsetAsync((char*)d_ws + WS_CTL, 0, 1 * MiB, stream);
    Args a{};
    for (int i = 0; i < 25; ++i) a.in[i] = (const float*)d_in[i];
    a.out = (float*)d_out; a.ws = (unsigned char*)d_ws;
#if MK_SINGLE
    a.ph_lo = 0; a.ph_hi = NPHASE;
    void* args[] = {&a};
    hipError_t e = hipLaunchCooperativeKernel((const void*)mk_fwd, dim3(grid), dim3(NTHR), args, LDS_BYTES, stream);
    if (e != hipSuccess) fprintf(stderr, "cooperative launch failed: %s (grid %d)\n", hipGetErrorString(e), grid);
#else
    for (int p = 0; p < NPHASE; ++p) { a.ph_lo = p; a.ph_hi = p + 1; hipLaunchKernelGGL(mk_fwd, dim3(grid), dim3(NTHR), LDS_BYTES, stream, a); }
#endif
}
```

```cpp
#include <hip/hip_runtime.h>
#include <hip/hip_cooperative_groups.h>
#include <cstdint>
#include <cstdio>
namespace cg = cooperative_groups;

#ifndef MK_SINGLE
#define MK_SINGLE 1
#endif
#ifndef FAST_ALL
#define FAST_ALL 1
#endif
#ifndef FAST_G1A
#define FAST_G1A FAST_ALL
#endif
#ifndef FAST_G2
#define FAST_G2 FAST_ALL
#endif
#ifndef FAST_ZS
#define FAST_ZS FAST_ALL
#endif
#ifndef FAST_GLU
#define FAST_GLU FAST_ALL
#endif
#ifndef FAST_MERGE
#define FAST_MERGE FAST_ALL
#endif
#ifndef FAST_OUT
#define FAST_OUT FAST_ALL
#endif
#ifndef FAST_ATT
#define FAST_ATT FAST_ALL
#endif
#ifndef FAST_SSM
#define FAST_SSM FAST_ALL
#endif

typedef unsigned short bf16_t;
typedef float f32x4 __attribute__((ext_vector_type(4)));
typedef unsigned u32x4 __attribute__((ext_vector_type(4)));
typedef unsigned u32x2 __attribute__((ext_vector_type(2)));

constexpr int NB = 8, SEQ = 4096, DM = 1024, NT = NB * SEQ;
constexpr int INW = 5664;
constexpr int C_US = 0, C_ZS = 1024, C_QL = 2048, C_KL = 2304, C_KR = 2560, C_ZM = 2592, C_GS = 3616, C_GM = 4640;
constexpr int NG = 64, GP = 16, NS = 64;
constexpr int NH = 16;
constexpr float EPS = 1e-6f;
constexpr float QSCALE = 0.10206207261596577f * 1.4426950408889634f;
constexpr int NTHR = 512;
constexpr int LDS_BYTES = 147456;

constexpr size_t MiB = 1u << 20;
constexpr size_t WS_CTL = 0;
constexpr size_t WS_MOD = 1 * MiB;
constexpr size_t WS_ROPE = 2 * MiB;
constexpr size_t WS_SSMC = 6 * MiB;
constexpr size_t WS_SSQ = 0;
constexpr size_t WS_WINA = 8 * MiB;
constexpr size_t WS_WZS = 14 * MiB;
constexpr size_t WS_WGATE = 16 * MiB;
constexpr size_t WS_WGLU = 20 * MiB;
constexpr size_t WS_WQ = 24 * MiB;
constexpr size_t WS_WKV = 25 * MiB;
constexpr size_t WS_WBR = 26 * MiB;
constexpr size_t WS_WOUT = 30 * MiB;
constexpr size_t WS_SQ = 274 * MiB;
constexpr size_t WS_SKV = 275 * MiB;
constexpr size_t WS_SO = 276 * MiB;
constexpr size_t WS_HB = 32 * MiB;
constexpr size_t WS_US = 96 * MiB;
constexpr size_t WS_TM = 160 * MiB;
constexpr size_t WS_QL = 224 * MiB;
constexpr size_t WS_KL = 240 * MiB;
constexpr size_t WS_KR = 256 * MiB;
constexpr size_t WS_QN = 288 * MiB;
constexpr size_t WS_QR = 352 * MiB;
constexpr size_t WS_KN = 384 * MiB;
constexpr size_t WS_VV = 448 * MiB;
constexpr size_t WS_ZS = 288 * MiB;
constexpr size_t WS_YG = 352 * MiB;
constexpr size_t WS_TS = 416 * MiB;
constexpr size_t WS_GS = 96 * MiB;
constexpr size_t WS_GM = 224 * MiB;
constexpr size_t WS_P1 = 288 * MiB;
constexpr size_t WS_MG = 32 * MiB;
constexpr size_t WS_OUTF = 288 * MiB;
constexpr size_t WS_RAT = 96 * MiB;
constexpr size_t WS_SGM = 224 * MiB;
constexpr size_t WS_OUTB = 288 * MiB;
constexpr size_t WS_END = 512 * MiB;

__device__ __forceinline__ unsigned f2bf(float f) { unsigned u = __builtin_bit_cast(unsigned, f); return (u + 0x7fffu + ((u >> 16) & 1u)) >> 16; }
__device__ __forceinline__ float bf2f(unsigned h) { return __builtin_bit_cast(float, (h & 0xffffu) << 16); }
__device__ __forceinline__ unsigned pk2(float lo, float hi) { return f2bf(lo) | (f2bf(hi) << 16); }
__device__ __forceinline__ float sigmoidf_(float v) { return 1.f / (1.f + __expf(-v)); }
__device__ __forceinline__ float siluf_(float v) { return v / (1.f + __expf(-v)); }
__device__ __forceinline__ float gelu_tanh(float v) { const float u = 0.7978845608028654f * (v + 0.044715f * v * v * v); return 0.5f * v * (1.f + tanhf(u)); }
__device__ __forceinline__ float wave_sum(float v) {
#pragma unroll
    for (int o = 1; o < 64; o <<= 1) v += __shfl_xor(v, o);
    return v;
}

__device__ __forceinline__ int opq(int x) { asm volatile("" : "+v"(x)); return x; }
struct Args { const float* in[25]; float* out; unsigned char* ws; int ph_lo, ph_hi; };

template <class AL, class BL, class EP>
__device__ __forceinline__ void gemm_o(float* lds, int M, int N, int K, const AL& al, const BL& bl, const EP& ep) {
    float* As = lds;
    float* Bs = lds + 16 * 132;
    const int tid = opq(threadIdx.x), ty = tid >> 4, tx = tid & 15;
    const int ntn = (N + 127) / 128, ntm = M / 128, ntiles = ntm * ntn;
    for (int tile = blockIdx.x; tile < ntiles; tile += gridDim.x) {
        const int tm = tile / ntn, tn = tile % ntn;
        const int row0 = tm * 128, col0 = tn * 128;
        float acc[4][8];
#pragma unroll
        for (int i = 0; i < 4; ++i)
#pragma unroll
            for (int j = 0; j < 8; ++j) acc[i][j] = 0.f;
        for (int k0 = 0; k0 < K; k0 += 16) {
            {
                const int r = tid >> 2, kk = (tid & 3) * 4;
                const bf16_t* p = al.a4(row0 + r, k0 + kk);
                const u32x2 w = *(const u32x2*)p;
                As[(kk + 0) * 132 + r] = bf2f(w.x); As[(kk + 1) * 132 + r] = bf2f(w.x >> 16);
                As[(kk + 2) * 132 + r] = bf2f(w.y); As[(kk + 3) * 132 + r] = bf2f(w.y >> 16);
            }
            {
                const int kk = tid >> 5, c = (tid & 31) * 4;
#pragma unroll
                for (int j = 0; j < 4; ++j) { const int col = col0 + c + j; Bs[kk * 132 + c + j] = (col < N) ? bl.b(k0 + kk, col) : 0.f; }
            }
            __syncthreads();
#pragma unroll 2
            for (int kk = 0; kk < 16; ++kk) {
                const f32x4 a = *(const f32x4*)(As + kk * 132 + ty * 4);
                const f32x4 b0 = *(const f32x4*)(Bs + kk * 132 + tx * 8), b1 = *(const f32x4*)(Bs + kk * 132 + tx * 8 + 4);
#pragma unroll
                for (int i = 0; i < 4; ++i) {
                    acc[i][0] += a[i] * b0[0]; acc[i][1] += a[i] * b0[1]; acc[i][2] += a[i] * b0[2]; acc[i][3] += a[i] * b0[3];
                    acc[i][4] += a[i] * b1[0]; acc[i][5] += a[i] * b1[1]; acc[i][6] += a[i] * b1[2]; acc[i][7] += a[i] * b1[3];
                }
            }
            __syncthreads();
        }
#pragma unroll
        for (int i = 0; i < 4; ++i)
#pragma unroll
            for (int j = 0; j < 8; j += 2) { const int col = col0 + tx * 8 + j; if (col < N) ep.e(row0 + ty * 4 + i, col, acc[i][j], acc[i][j + 1]); }
    }
}

struct ARow { const bf16_t* A; int lda; __device__ __forceinline__ const bf16_t* a4(int row, int k) const { return A + (size_t)row * lda + k; } };
struct AGrp { const bf16_t* A; __device__ __forceinline__ const bf16_t* a4(int row, int k) const { return A + ((size_t)(k >> 4) * NT + row) * 16 + (k & 15); } };

namespace pg8 {
#define PG8_LAS __attribute__((address_space(3)))
typedef PG8_LAS unsigned char PG8_LAS_T;
typedef short bf16x8 __attribute__((ext_vector_type(8)));
constexpr int BM = 256, BK = 64, HALF = 128, HTB = HALF * BK * 2, STAGE_BYTES = 8 * HTB, NXCD = 8, WGM = 8;
constexpr unsigned PLANE = (unsigned)NT * 32u;

__host__ __device__ __forceinline__ int lds_byte(int r, int c) { const int st = (r >> 4) * 2 + (c >> 5), rr = r & 15, cc = c & 31, ob = rr * 64 + cc * 2; return st * 1024 + (ob ^ (((ob >> 9) & 1) << 5)); }
__host__ __device__ __forceinline__ void stage_rc(int b, int& R, int& C) { const int st = b / 1024, sb = b % 1024, swz = sb ^ (((sb >> 9) & 1) << 5); R = (st >> 1) * 16 + swz / 64; C = (st & 1) * 32 + (swz % 64) / 2; }
__host__ __device__ __forceinline__ int perm32(int rho) { const int n = rho >> 4, i = rho & 15; return 8 * (i >> 2) + 4 * n + (i & 3); }

struct Unit { int pm, pn; };
struct Gemm { const char* A; const char* A2; const char* Bt; int N, K, lda, amode, tmid; };

struct StaticOrder {
    int nM, nN, nwg, G, c;
    __device__ void init(int M, int N, int G_, int c_) { nM = M / BM; nN = N / BM; nwg = nM * nN; G = G_; c = c_; }
    __device__ bool next(int i, Unit& u) const {
        const long L = (long)i * G + c; if (L >= nwg) return false;
        int wgid = (int)L; { const int q = nwg / NXCD, r = nwg % NXCD, xcd = wgid % NXCD, off = wgid / NXCD; wgid = (xcd < r ? xcd * (q + 1) : r * (q + 1) + (xcd - r) * q) + off; }
        const int nig = WGM * nN, gid = wgid / nig, fm = gid * WGM, gsz = (nM - fm) < WGM ? (nM - fm) : WGM;
        u.pm = fm + ((wgid % nig) % gsz); u.pn = (wgid % nig) / gsz; return true;
    }
};

typedef f32x4 Acc[2][2][4][2];

template <class Epi, class Sched>
__device__ __forceinline__ void gemm_phase(PG8_LAS unsigned char* lds, const Gemm g, const Sched& S, const Epi& E) {
    const int tid = opq(threadIdx.x), wid = __builtin_amdgcn_readfirstlane(tid >> 6), lane = tid & 63, wr = wid >> 2, wc = wid & 3, fr = lane & 15, fq = lane >> 4;
    const int K = g.K, nt = K / BK;
    unsigned voffA[2], voffB[2];
#pragma unroll
    for (int i = 0; i < 2; ++i) { int R, C; stage_rc(tid * 16 + i * 8192, R, C); const int Rb = (R & ~31) + perm32(R & 31);
        voffA[i] = g.amode == 0 ? (unsigned)(R * g.lda + C) * 2u : (unsigned)(C >> 4) * PLANE + (unsigned)R * 32u + (unsigned)(C & 15) * 2u;
        voffB[i] = (unsigned)(Rb * K + C) * 2u; }
    const size_t akstep = g.amode == 0 ? (size_t)(BK * 2) : (size_t)4 * PLANE;
    const size_t ahstep = g.amode == 0 ? (size_t)HALF * g.lda * 2 : (size_t)HALF * 32;
    const size_t atstep = 2 * ahstep;
    const size_t bkstep = (size_t)(BK * 2), bhstep = (size_t)HALF * K * 2, btstep = 2 * bhstep;
    const unsigned ldsw = (unsigned)wid * 1024u;
    const int aoff = lds_byte(wr * 64 + fr, fq * 8), boff = lds_byte(wc * 32 + fr, fq * 8);
    const int tmid = g.tmid;
    const char* const Alo = g.A; const char* const Ahi = g.A2 - (size_t)tmid * akstep;
#define PG8_AP(pm_, t_) ((((t_) < tmid) ? Alo : Ahi) + (size_t)(pm_) * atstep + (size_t)(t_) * akstep)
#define PG8_SA(b, h) (((b) * 2 + (h)) * HTB)
#define PG8_SB(b, h) ((4 + (b) * 2 + (h)) * HTB)
#define PG8_STAGE(bufoff, gbase, voff) do { _Pragma("unroll") for (int _i = 0; _i < 2; ++_i) \
        __builtin_amdgcn_global_load_lds((const unsigned*)((const char*)(gbase) + (voff)[_i]), (PG8_LAS unsigned*)(lds + (bufoff) + ldsw + _i * 8192), 16, 0, 0); } while (0)
#define PG8_LDA(dst, b, h) do { _Pragma("unroll") for (int m = 0; m < 4; ++m) _Pragma("unroll") for (int k = 0; k < 2; ++k) dst[m][k] = *(const PG8_LAS bf16x8*)(lds + PG8_SA(b, h) + aoff + m * 2048 + k * 1024); } while (0)
#define PG8_LDB(dst, b, h) do { _Pragma("unroll") for (int n = 0; n < 2; ++n) _Pragma("unroll") for (int k = 0; k < 2; ++k) dst[n][k] = *(const PG8_LAS bf16x8*)(lds + PG8_SB(b, h) + boff + n * 2048 + k * 1024); } while (0)
#define PG8_MMA(ai, bj, At, Bt) do { __builtin_amdgcn_s_setprio(1); _Pragma("unroll") for (int m = 0; m < 4; ++m) _Pragma("unroll") for (int n = 0; n < 2; ++n) _Pragma("unroll") for (int k = 0; k < 2; ++k) \
        acc[ai][bj][m][n] = __builtin_amdgcn_mfma_f32_16x16x32_bf16(Bt[n][k], At[m][k], acc[ai][bj][m][n], 0, 0, 0); __builtin_amdgcn_s_setprio(0); } while (0)
#define PG8_WAIT_V(n) asm volatile("s_waitcnt vmcnt(" #n ")" ::: "memory")
#define PG8_WAIT_L(n) asm volatile("s_waitcnt lgkmcnt(" #n ")" ::: "memory")
#define PG8_BAR __builtin_amdgcn_s_barrier()
#define PG8_SCHED __builtin_amdgcn_sched_barrier(0)
    Unit cur, nxt; int ui = 0;
    if (!S.next(0, cur)) return;
    Acc acc;
#pragma unroll
    for (int a = 0; a < 2; ++a)
#pragma unroll
        for (int b = 0; b < 2; ++b)
#pragma unroll
            for (int m = 0; m < 4; ++m)
#pragma unroll
                for (int n = 0; n < 2; ++n) acc[a][b][m][n] = (f32x4){0.f, 0.f, 0.f, 0.f};
    bf16x8 At[4][2], B0[2][2], B1[2][2];
    const char* cB = g.Bt + (size_t)cur.pn * btstep;
    {
        const char* cA0 = PG8_AP(cur.pm, 0); const char* cA1 = PG8_AP(cur.pm, 1);
        PG8_STAGE(PG8_SB(0, 0), cB, voffB); PG8_STAGE(PG8_SB(0, 1), cB + bhstep, voffB); PG8_STAGE(PG8_SA(0, 0), cA0, voffA); PG8_STAGE(PG8_SA(0, 1), cA0 + ahstep, voffA);
        if (wr == 1) PG8_BAR;
        PG8_WAIT_V(2); PG8_BAR;
        PG8_STAGE(PG8_SB(1, 0), cB + bkstep, voffB); PG8_STAGE(PG8_SA(1, 0), cA1, voffA); PG8_STAGE(PG8_SB(1, 1), cB + bhstep + bkstep, voffB);
        PG8_WAIT_V(6); PG8_BAR;
    }
    for (;;) {
        const bool has_next = S.next(ui + 1, nxt);
        const int npm = has_next ? nxt.pm : cur.pm;
        const char* nB = has_next ? g.Bt + (size_t)nxt.pn * btstep : cB;
#pragma unroll 1
        for (int t = 0; t < nt; t += 2) {
            const bool last = (t == nt - 2);
            if constexpr (Epi::HAS_MID) { if (t == tmid) E.mid(acc, cur, wr, wc, fr, fq); }
            const char* a1 = PG8_AP(cur.pm, t + 1);
            const char* a2 = last ? PG8_AP(npm, 0) : PG8_AP(cur.pm, t + 2);
            const char* a3 = last ? PG8_AP(npm, 1) : PG8_AP(cur.pm, t + 3);
            const char* b2 = last ? nB : cB + (size_t)(t + 2) * bkstep; const char* b3 = b2 + bkstep;
            PG8_LDB(B0, 0, 0); PG8_LDB(B1, 0, 1); PG8_SCHED; PG8_LDA(At, 0, 0); PG8_STAGE(PG8_SA(1, 1), a1 + ahstep, voffA);
            PG8_WAIT_V(8); PG8_WAIT_L(0); PG8_BAR; PG8_MMA(0, 0, At, B0); PG8_MMA(0, 1, At, B1); PG8_BAR; PG8_SCHED;
            PG8_LDA(At, 0, 1); PG8_STAGE(PG8_SB(0, 0), b2, voffB); PG8_STAGE(PG8_SB(0, 1), b2 + bhstep, voffB); PG8_STAGE(PG8_SA(0, 0), a2, voffA);
            PG8_WAIT_V(8); PG8_WAIT_L(0); PG8_BAR; PG8_MMA(1, 0, At, B0); PG8_MMA(1, 1, At, B1); PG8_BAR; PG8_SCHED;
            PG8_LDB(B0, 1, 0); PG8_LDB(B1, 1, 1); PG8_SCHED; PG8_LDA(At, 1, 0); PG8_STAGE(PG8_SA(0, 1), a2 + ahstep, voffA);
            PG8_WAIT_V(8); PG8_WAIT_L(0); PG8_BAR; PG8_MMA(0, 0, At, B0); PG8_MMA(0, 1, At, B1); PG8_BAR; PG8_SCHED;
            PG8_LDA(At, 1, 1); PG8_STAGE(PG8_SB(1, 0), b3, voffB); PG8_STAGE(PG8_SB(1, 1), b3 + bhstep, voffB); PG8_STAGE(PG8_SA(1, 0), a3, voffA);
            PG8_WAIT_V(8); PG8_WAIT_L(0); PG8_BAR; PG8_MMA(1, 0, At, B0); PG8_MMA(1, 1, At, B1); PG8_BAR; PG8_SCHED;
        }
        if (wr == 0) PG8_BAR;
        E(acc, cur, wr, wc, fr, fq);
        if (!has_next) break;
#pragma unroll
        for (int a = 0; a < 2; ++a)
#pragma unroll
            for (int b = 0; b < 2; ++b)
#pragma unroll
                for (int m = 0; m < 4; ++m)
#pragma unroll
                    for (int n = 0; n < 2; ++n) acc[a][b][m][n] = (f32x4){0.f, 0.f, 0.f, 0.f};
        cur = nxt; cB = nB; ++ui;
        if (wr == 1) PG8_BAR;
    }
    PG8_WAIT_V(0);
    PG8_BAR;
#undef PG8_AP
#undef PG8_SA
#undef PG8_SB
#undef PG8_STAGE
#undef PG8_LDA
#undef PG8_LDB
#undef PG8_MMA
#undef PG8_WAIT_V
#undef PG8_WAIT_L
#undef PG8_BAR
#undef PG8_SCHED
}

__device__ __forceinline__ unsigned cvt_pk_bf16(float lo, float hi) { unsigned r; asm volatile("v_cvt_pk_bf16_f32 %0, %1, %2" : "=v"(r) : "v"(lo), "v"(hi)); return r; }
__device__ __forceinline__ u32x4 pack8(const f32x4 a, const f32x4 b) { u32x4 w; w.x = cvt_pk_bf16(a[0], a[1]); w.y = cvt_pk_bf16(a[2], a[3]); w.z = cvt_pk_bf16(b[0], b[1]); w.w = cvt_pk_bf16(b[2], b[3]); return w; }
__device__ __forceinline__ void unpack8(const u32x4 w, f32x4& a, f32x4& b) { a = (f32x4){bf2f(w.x), bf2f(w.x >> 16), bf2f(w.y), bf2f(w.y >> 16)}; b = (f32x4){bf2f(w.z), bf2f(w.z >> 16), bf2f(w.w), bf2f(w.w >> 16)}; }
__device__ __forceinline__ f32x4 silu4(const f32x4 v) { return (f32x4){siluf_(v[0]), siluf_(v[1]), siluf_(v[2]), siluf_(v[3])}; }
__device__ __forceinline__ f32x4 sig4(const f32x4 v) { return (f32x4){sigmoidf_(v[0]), sigmoidf_(v[1]), sigmoidf_(v[2]), sigmoidf_(v[3])}; }
__device__ __forceinline__ float ssq4(const f32x4 v) { return (v[0] * v[0] + v[1] * v[1]) + (v[2] * v[2] + v[3] * v[3]); }
__device__ __forceinline__ void rope8(f32x4& a, f32x4& b, const f32x4 cs, const f32x4 sn) {
    const f32x4 a0 = a, b0 = b;
    a[0] = a0[0] * cs[0] - a0[1] * sn[0]; a[1] = a0[1] * cs[0] + a0[0] * sn[0]; a[2] = a0[2] * cs[1] - a0[3] * sn[1]; a[3] = a0[3] * cs[1] + a0[2] * sn[1];
    b[0] = b0[0] * cs[2] - b0[1] * sn[2]; b[1] = b0[1] * cs[2] + b0[0] * sn[2]; b[2] = b0[2] * cs[3] - b0[3] * sn[3]; b[3] = b0[3] * cs[3] + b0[2] * sn[3];
}
#define EPI_ROWS(...) _Pragma("unroll") for (int ai = 0; ai < 2; ++ai) _Pragma("unroll") for (int m = 0; m < 4; ++m) { const int row = u.pm * BM + ai * HALF + wr * 64 + m * 16 + fr; __VA_ARGS__ if (m & 1) asm volatile("" ::: "memory"); }

struct EpiG1a {
    static constexpr bool HAS_MID = false;
    bf16_t *US, *TM, *QL, *KL, *KR; float *SQ, *SKV; const float* rope;
    __device__ __forceinline__ void operator()(const Acc& acc, const Unit& u, int wr, int wc, int fr, int fq) const {
        const int pn = u.pn, cw = wc * 32 + 8 * fq;
        if (pn < 4) { EPI_ROWS(
            _Pragma("unroll") for (int bj = 0; bj < 2; ++bj) { const int c = pn * 256 + bj * 128 + cw;
                *(u32x4*)(US + ((size_t)(c >> 4) * NT + row) * 16 + (c & 15)) = pack8(acc[ai][bj][m][0], acc[ai][bj][m][1]); } ) }
        else if (pn < 8) { EPI_ROWS(
            _Pragma("unroll") for (int bj = 0; bj < 2; ++bj) { const int c = (pn - 4) * 256 + bj * 128 + cw;
                *(u32x4*)(TM + (size_t)row * 1024 + c) = pack8(silu4(acc[ai][bj][m][0]), silu4(acc[ai][bj][m][1])); } ) }
        else if (pn < 10) { bf16_t* dst = pn == 8 ? QL : KL; float* sp = pn == 8 ? SQ : SKV;
            EPI_ROWS( float s = 0.f;
            _Pragma("unroll") for (int bj = 0; bj < 2; ++bj) { const int c = bj * 128 + cw; s += ssq4(acc[ai][bj][m][0]) + ssq4(acc[ai][bj][m][1]);
                *(u32x4*)(dst + (size_t)row * 256 + c) = pack8(acc[ai][bj][m][0], acc[ai][bj][m][1]); }
            s += __shfl_xor(s, 16); s += __shfl_xor(s, 32); if (fq == 0) sp[(size_t)row * 4 + wc] = s; ) }
        else if (wc == 0) { EPI_ROWS(
            const f32x4 cs = *(const f32x4*)(rope + (size_t)row * 32 + 4 * fq), sn = *(const f32x4*)(rope + (size_t)row * 32 + 16 + 4 * fq);
            f32x4 a = acc[ai][0][m][0], b = acc[ai][0][m][1]; rope8(a, b, cs, sn);
            *(u32x4*)(KR + (size_t)row * 32 + 8 * fq) = pack8(a, b); ) }
    }
};
struct EpiG2q {
    static constexpr bool HAS_MID = false;
    bf16_t *QN, *QR; const float* SQ; const float* rope;
    __device__ __forceinline__ void operator()(const Acc& acc, const Unit& u, int wr, int wc, int fr, int fq) const {
        const int pn = u.pn, cw = wc * 32 + 8 * fq;
        float rsv[2][4];
        EPI_ROWS( const f32x4 sp = *(const f32x4*)(SQ + (size_t)row * 4); rsv[ai][m] = QSCALE / sqrtf(((sp[0] + sp[1]) + (sp[2] + sp[3])) * (1.f / 256.f) + EPS); )
        if (pn < 4) { EPI_ROWS( const float rs = rsv[ai][m];
                _Pragma("unroll") for (int bj = 0; bj < 2; ++bj) { const int c = pn * 256 + bj * 128 + cw; *(u32x4*)(QN + (size_t)row * 1024 + c) = pack8(acc[ai][bj][m][0] * rs, acc[ai][bj][m][1] * rs); } )
        } else { EPI_ROWS( const float rs = rsv[ai][m];
                const f32x4 cs = *(const f32x4*)(rope + (size_t)row * 32 + 4 * fq), sn = *(const f32x4*)(rope + (size_t)row * 32 + 16 + 4 * fq);
                _Pragma("unroll") for (int bj = 0; bj < 2; ++bj) { const int c = (pn - 4) * 256 + bj * 128 + cw; f32x4 a = acc[ai][bj][m][0] * rs, b = acc[ai][bj][m][1] * rs; rope8(a, b, cs, sn);
                    *(u32x4*)(QR + (size_t)row * 512 + c) = pack8(a, b); } ) }
    }
};
struct EpiG2kv {
    static constexpr bool HAS_MID = false;
    bf16_t *KN, *VV; const float* SKV;
    __device__ __forceinline__ void operator()(const Acc& acc, const Unit& u, int wr, int wc, int fr, int fq) const {
        const int pn = u.pn, cw = wc * 32 + 8 * fq; bf16_t* dst = pn < 4 ? KN : VV;
        float rsv[2][4];
        EPI_ROWS( const f32x4 sp = *(const f32x4*)(SKV + (size_t)row * 4); rsv[ai][m] = 1.f / sqrtf(((sp[0] + sp[1]) + (sp[2] + sp[3])) * (1.f / 256.f) + EPS); )
        EPI_ROWS( const float rs = rsv[ai][m];
            _Pragma("unroll") for (int bj = 0; bj < 2; ++bj) { const int c = (pn & 3) * 256 + bj * 128 + cw; *(u32x4*)(dst + (size_t)row * 1024 + c) = pack8(acc[ai][bj][m][0] * rs, acc[ai][bj][m][1] * rs); } )
    }
};
struct EpiZs {
    static constexpr bool HAS_MID = false;
    bf16_t* ZS;
    __device__ __forceinline__ void operator()(const Acc& acc, const Unit& u, int wr, int wc, int fr, int fq) const {
        const int cw = wc * 32 + 8 * fq;
        EPI_ROWS( _Pragma("unroll") for (int bj = 0; bj < 2; ++bj) { const int c = u.pn * 256 + bj * 128 + cw; *(u32x4*)(ZS + (size_t)row * 1024 + c) = pack8(silu4(acc[ai][bj][m][0]), silu4(acc[ai][bj][m][1])); } )
    }
};
struct EpiGlu {
    static constexpr bool HAS_MID = false;
    bf16_t* TS; const bf16_t* ZS; const float* bias;
    __device__ __forceinline__ void operator()(const Acc& acc, const Unit& u, int wr, int wc, int fr, int fq) const {
        const int jj = u.pn * 128 + wc * 32 + 8 * fq;
        const f32x4 ba0 = *(const f32x4*)(bias + jj), ba1 = *(const f32x4*)(bias + jj + 4), bb0 = *(const f32x4*)(bias + 1024 + jj), bb1 = *(const f32x4*)(bias + 1024 + jj + 4);
        EPI_ROWS( f32x4 z0, z1; unpack8(*(const u32x4*)(ZS + (size_t)row * 1024 + jj), z0, z1);
            const f32x4 o0 = (acc[ai][0][m][0] + ba0) * sig4(acc[ai][1][m][0] + bb0) * z0, o1 = (acc[ai][0][m][1] + ba1) * sig4(acc[ai][1][m][1] + bb1) * z1;
            *(u32x4*)(TS + (size_t)row * 1024 + jj) = pack8(o0, o1); )
    }
};
struct EpiGate {
    static constexpr bool HAS_MID = false;
    bf16_t *RAT, *SGM;
    __device__ __forceinline__ void operator()(const Acc& acc, const Unit& u, int wr, int wc, int fr, int fq) const {
        const int jj = u.pn * 128 + wc * 32 + 8 * fq;
        EPI_ROWS( const f32x4 s0 = sig4(acc[ai][0][m][0]), s1 = sig4(acc[ai][0][m][1]), m0 = sig4(acc[ai][1][m][0]), m1 = sig4(acc[ai][1][m][1]);
            *(u32x4*)(RAT + (size_t)row * 1024 + jj) = pack8(s0 / m0, s1 / m1); *(u32x4*)(SGM + (size_t)row * 1024 + jj) = pack8(m0, m1); )
    }
};
struct EpiMerge {
    static constexpr bool HAS_MID = true;
    const bf16_t *RAT, *SGM; bf16_t* MG;
    __device__ __forceinline__ void mid(Acc& acc, const Unit& u, int wr, int wc, int fr, int fq) const {
        const int cw = wc * 32 + 8 * fq;
#pragma unroll
        for (int ai = 0; ai < 2; ++ai) {
            u32x4 r[4][2];
#pragma unroll
            for (int m = 0; m < 4; ++m) { const int row = u.pm * BM + ai * HALF + wr * 64 + m * 16 + fr;
#pragma unroll
                for (int bj = 0; bj < 2; ++bj) r[m][bj] = *(const u32x4*)(RAT + (size_t)row * 1024 + u.pn * 256 + bj * 128 + cw); }
#pragma unroll
            for (int m = 0; m < 4; ++m)
#pragma unroll
                for (int bj = 0; bj < 2; ++bj) { f32x4 a, b; unpack8(r[m][bj], a, b); acc[ai][bj][m][0] *= a; acc[ai][bj][m][1] *= b; }
        }
        asm volatile("s_waitcnt vmcnt(0)" ::: "memory");
    }
    __device__ __forceinline__ void operator()(const Acc& acc, const Unit& u, int wr, int wc, int fr, int fq) const {
        const int cw = wc * 32 + 8 * fq;
        EPI_ROWS( _Pragma("unroll") for (int bj = 0; bj < 2; ++bj) { const int c = u.pn * 256 + bj * 128 + cw; f32x4 a, b; unpack8(*(const u32x4*)(SGM + (size_t)row * 1024 + c), a, b);
            *(u32x4*)(MG + (size_t)row * 1024 + c) = pack8(acc[ai][bj][m][0] * a, acc[ai][bj][m][1] * b); } )
    }
};
struct EpiOut {
    static constexpr bool HAS_MID = false;
    bf16_t* OUTB; float* SO;
    __device__ __forceinline__ void operator()(const Acc& acc, const Unit& u, int wr, int wc, int fr, int fq) const {
        const int cw = wc * 32 + 8 * fq;
        EPI_ROWS( float s = 0.f;
            _Pragma("unroll") for (int bj = 0; bj < 2; ++bj) { const int c = u.pn * 256 + bj * 128 + cw; s += ssq4(acc[ai][bj][m][0]) + ssq4(acc[ai][bj][m][1]);
                *(u32x4*)(OUTB + (size_t)row * 1024 + c) = pack8(acc[ai][bj][m][0], acc[ai][bj][m][1]); }
            s += __shfl_xor(s, 16); s += __shfl_xor(s, 32); if (fq == 0) SO[(size_t)row * 16 + u.pn * 4 + wc] = s; )
    }
};
}

template <class MAP>
__device__ __forceinline__ void tr_item(const float* W, int ldw, const MAP& map, const float* kscale, bf16_t* dst, int dpitch, int koff, int nblk, float* scr, int item, int lane) {
    const int kb = item / nblk, nb = item % nblk, k0 = 64 * kb, n0 = 32 * nb;
    const int src = map(n0 + (lane & 31));
#pragma unroll 8
    for (int i = 0; i < 32; ++i) { const int kk = 2 * i + (lane >> 5); float v = (src >= 0) ? W[(size_t)(k0 + kk) * ldw + src] : 0.f; if (kscale) v *= kscale[k0 + kk]; scr[kk * 33 + (lane & 31)] = v; }
    asm volatile("s_waitcnt lgkmcnt(0)" ::: "memory");
    const int c = lane & 7;
#pragma unroll
    for (int j = 0; j < 4; ++j) { const int n = (lane >> 3) + 8 * j; const float* sc = scr + (8 * c) * 33 + n;
        u32x4 o; o.x = pk2(sc[0 * 33], sc[1 * 33]); o.y = pk2(sc[2 * 33], sc[3 * 33]); o.z = pk2(sc[4 * 33], sc[5 * 33]); o.w = pk2(sc[6 * 33], sc[7 * 33]);
        *(u32x4*)(dst + (size_t)(n0 + n) * dpitch + koff + k0 + 8 * c) = o; }
    asm volatile("s_waitcnt lgkmcnt(0)" ::: "memory");
}
struct MapG1a { __device__ __forceinline__ int operator()(int j) const { if (j < 1024) return C_US + j; if (j < 2048) return C_ZM + (j - 1024); if (j < 2304) return C_QL + (j - 2048); if (j < 2560) return C_KL + (j - 2304);
    if (j < 2592) { const int p = j - 2560; return C_KR + ((p & 1) ? 16 + (p >> 1) : (p >> 1)); } return -1; } };
struct MapOff { int off; __device__ __forceinline__ int operator()(int j) const { return off + j; } };
struct MapPair { int offa, offb; __device__ __forceinline__ int operator()(int j) const { const int pn = j >> 8, w = j & 255, jj = pn * 128 + (w & 127); return offa + (w >> 7) * (offb - offa) + jj; } };
struct MapQ { __device__ __forceinline__ int operator()(int j) const { if (j < 1024) return (j >> 6) * 96 + (j & 63); const int jj = j - 1024, h = jj >> 5, p = jj & 31; return h * 96 + 64 + ((p & 1) ? 16 + (p >> 1) : (p >> 1)); } };
struct MapKV { __device__ __forceinline__ int operator()(int j) const { return (j < 1024) ? (j >> 6) * 128 + (j & 63) : ((j - 1024) >> 6) * 128 + 64 + (j & 63); } };

__device__ __forceinline__ void prep_weights(const Args& a, float* lds) {
    const int tid = opq(threadIdx.x), lane = tid & 63, wv = tid >> 6;
    float* scr = lds + wv * (64 * 33);
    const int gw = blockIdx.x * 8 + wv, ngw = gridDim.x * 8;
    unsigned char* ws = a.ws;
    constexpr int I0 = 16 * 88, I1 = 16 * 32, I2 = 16 * 64, I3 = 16 * 64, I4 = 4 * 48, I5 = 4 * 64, I6 = 16 * 32, I7 = 16 * 32, I8 = 16 * 32;
    constexpr int NITEMS = I0 + I1 + I2 + I3 + I4 + I5 + I6 + I7 + I8;
    for (int it = gw; it < NITEMS; it += ngw) {
        int r = it;
        if (r < I0) { tr_item(a.in[6], INW, MapG1a{}, nullptr, (bf16_t*)(ws + WS_WINA), 1024, 0, 88, scr, r, lane); continue; } r -= I0;
        if (r < I1) { tr_item(a.in[6], INW, MapOff{C_ZS}, nullptr, (bf16_t*)(ws + WS_WZS), 1024, 0, 32, scr, r, lane); continue; } r -= I1;
        if (r < I2) { tr_item(a.in[6], INW, MapPair{C_GS, C_GM}, nullptr, (bf16_t*)(ws + WS_WGATE), 1024, 0, 64, scr, r, lane); continue; } r -= I2;
        if (r < I3) { tr_item(a.in[15], 2048, MapPair{0, 1024}, nullptr, (bf16_t*)(ws + WS_WGLU), 1024, 0, 64, scr, r, lane); continue; } r -= I3;
        if (r < I4) { tr_item(a.in[18], 1536, MapQ{}, a.in[17], (bf16_t*)(ws + WS_WQ), 256, 0, 48, scr, r, lane); continue; } r -= I4;
        if (r < I5) { tr_item(a.in[20], 2048, MapKV{}, a.in[19], (bf16_t*)(ws + WS_WKV), 256, 0, 64, scr, r, lane); continue; } r -= I5;
        if (r < I6) { tr_item(a.in[21], 1024, MapOff{0}, nullptr, (bf16_t*)(ws + WS_WBR), 2048, 0, 32, scr, r, lane); continue; } r -= I6;
        if (r < I7) { tr_item(a.in[22], 1024, MapOff{0}, nullptr, (bf16_t*)(ws + WS_WBR), 2048, 1024, 32, scr, r, lane); continue; } r -= I7;
        tr_item(a.in[23], 1024, MapOff{0}, nullptr, (bf16_t*)(ws + WS_WOUT), 1024, 0, 32, scr, r, lane);
    }
}

namespace att {
#define ATT_LAS __attribute__((address_space(3)))
typedef ATT_LAS unsigned char ATT_LAS_T;
typedef short bf16x8 __attribute__((ext_vector_type(8)));
typedef short s16x4 __attribute__((ext_vector_type(4)));
typedef float f32x16 __attribute__((ext_vector_type(16)));
constexpr int KT = 12288, VT = 8192, BUFB = KT + VT, WSF_OFF = 2 * BUFB;
constexpr float THR = 8.f;
__device__ __forceinline__ int crow(int r, int hi) { return (r & 3) + 8 * (r >> 2) + 4 * hi; }
__device__ __forceinline__ unsigned cvtpk(float lo, float hi) { unsigned r; asm volatile("v_cvt_pk_bf16_f32 %0, %1, %2" : "=v"(r) : "v"(lo), "v"(hi)); return r; }
__device__ __forceinline__ s16x4 vtr(ATT_LAS const unsigned char* p) { return __builtin_bit_cast(s16x4, __builtin_amdgcn_ds_read_tr16_b64_v4i16((ATT_LAS s16x4*)p)); }

__device__ __forceinline__ void attn_unit(int b, int h, int qb, const bf16_t* QN, const bf16_t* QR, const bf16_t* KN, const bf16_t* KR, const bf16_t* VV, bf16_t* TM, ATT_LAS unsigned char* lds) {
    const int tid = opq(threadIdx.x), lane = tid & 63, r32 = lane & 31, hi = lane >> 5, wid = __builtin_amdgcn_readfirstlane(tid >> 6);
    const size_t rowbase = (size_t)b * SEQ; const int q0 = qb * 256;
    const size_t tokq = rowbase + q0 + wid * 32 + r32;
    bf16x8 qf[6];
#pragma unroll
    for (int d0 = 0; d0 < 4; ++d0) qf[d0] = *(const bf16x8*)(QN + tokq * 1024 + h * 64 + d0 * 16 + hi * 8);
#pragma unroll
    for (int d0 = 0; d0 < 2; ++d0) qf[4 + d0] = *(const bf16x8*)(QR + tokq * 512 + h * 32 + d0 * 16 + hi * 8);
    const bf16_t* ksrc = KN + (rowbase + lane) * 1024 + h * 64 + wid * 8;
    const bf16_t* rsrc = KR + (rowbase + lane) * 32 + (wid & 3) * 8;
    const bf16_t* vsrc = VV + (rowbase + 16 * (wid & 3) + (lane >> 2)) * 1024 + h * 64 + (wid >> 2) * 32 + (lane & 3) * 8;
    ATT_LAS float* wsf = (ATT_LAS float*)(lds + WSF_OFF) + wid * 64;
#define ATT_DMA(t, bufo) do { \
        __builtin_amdgcn_global_load_lds((const unsigned*)(ksrc + (size_t)(t) * 64 * 1024), (ATT_LAS unsigned*)(lds + (bufo) + wid * 1024), 16, 0, 0); \
        __builtin_amdgcn_global_load_lds((const unsigned*)(vsrc + (size_t)(t) * 64 * 1024), (ATT_LAS unsigned*)(lds + (bufo) + KT + wid * 1024), 16, 0, 0); \
        if (wid < 4) __builtin_amdgcn_global_load_lds((const unsigned*)(rsrc + (size_t)(t) * 64 * 32), (ATT_LAS unsigned*)(lds + (bufo) + (8 + wid) * 1024), 16, 0, 0); } while (0)
    const int nT = 4 * qb + 4, mychunk = 4 * qb + (wid >> 1);
    float mref = 0.f, lsum = 0.f;
    f32x16 o0, o1;
#pragma unroll
    for (int r = 0; r < 16; ++r) { o0[r] = 0.f; o1[r] = 0.f; }
    ATT_DMA(0, 0);
    asm volatile("s_waitcnt vmcnt(0)" ::: "memory"); __builtin_amdgcn_s_barrier();
    const int kfo = hi * 1024 + r32 * 16;
    const int vfo = ((lane >> 4) & 1) * 32 + (lane & 3) * 8 + (4 * hi + ((lane & 15) >> 2)) * 64;
#pragma unroll 1
    for (int t = 0; t < nT; ++t) {
        const int bufo = (t & 1) * BUFB;
        if (t + 1 < nT) ATT_DMA(t + 1, BUFB - bufo);
        if (t <= mychunk) {
            ATT_LAS const unsigned char* Kb = lds + bufo + kfo; ATT_LAS const unsigned char* Vb = lds + bufo + KT + vfo;
            f32x16 p0, p1;
#pragma unroll
            for (int r = 0; r < 16; ++r) { p0[r] = -mref; p1[r] = -mref; }
#pragma unroll
            for (int d0 = 0; d0 < 6; ++d0) {
                const bf16x8 a0 = *(ATT_LAS const bf16x8*)(Kb + d0 * 2048), a1 = *(ATT_LAS const bf16x8*)(Kb + d0 * 2048 + 512);
                p0 = __builtin_amdgcn_mfma_f32_32x32x16_bf16(a0, qf[d0], p0, 0, 0, 0);
                p1 = __builtin_amdgcn_mfma_f32_32x32x16_bf16(a1, qf[d0], p1, 0, 0, 0);
            }
            float rm = fmaxf(p0[0], p1[0]);
#pragma unroll
            for (int r = 1; r < 16; ++r) rm = fmaxf(rm, fmaxf(p0[r], p1[r]));
            rm = fmaxf(rm, __shfl_xor(rm, 32));
            if (t == 0 || __any(rm > THR)) {
                const float dl = (t == 0) ? rm : fmaxf(rm, 0.f);
                mref += dl;
#pragma unroll
                for (int r = 0; r < 16; ++r) { p0[r] -= dl; p1[r] -= dl; }
                const float f = __builtin_amdgcn_exp2f(-dl); lsum *= f;
                if (t != 0) {
                    if (hi == 0) wsf[r32] = f;
                    asm volatile("s_waitcnt lgkmcnt(0)" ::: "memory");
#pragma unroll
                    for (int r = 0; r < 16; ++r) { const float fr_ = wsf[crow(r, hi)]; o0[r] *= fr_; o1[r] *= fr_; }
                    asm volatile("s_waitcnt lgkmcnt(0)" ::: "memory");
                }
            }
            float ps = 0.f;
#pragma unroll
            for (int r = 0; r < 16; ++r) { p0[r] = __builtin_amdgcn_exp2f(p0[r]); p1[r] = __builtin_amdgcn_exp2f(p1[r]); ps += p0[r] + p1[r]; }
            lsum += ps;
            bf16x8 pa[4];
#pragma unroll
            for (int s = 0; s < 2; ++s) {
                u32x4 w0, w1;
                w0.x = cvtpk(p0[8 * s + 0], p0[8 * s + 1]); w0.y = cvtpk(p0[8 * s + 2], p0[8 * s + 3]); w0.z = cvtpk(p0[8 * s + 4], p0[8 * s + 5]); w0.w = cvtpk(p0[8 * s + 6], p0[8 * s + 7]);
                w1.x = cvtpk(p1[8 * s + 0], p1[8 * s + 1]); w1.y = cvtpk(p1[8 * s + 2], p1[8 * s + 3]); w1.z = cvtpk(p1[8 * s + 4], p1[8 * s + 5]); w1.w = cvtpk(p1[8 * s + 6], p1[8 * s + 7]);
                pa[s] = __builtin_bit_cast(bf16x8, w0); pa[2 + s] = __builtin_bit_cast(bf16x8, w1);
            }
#pragma unroll
            for (int s = 0; s < 4; ++s) {
                const s16x4 l0 = vtr(Vb + s * 1024), h0 = vtr(Vb + s * 1024 + 512), l1 = vtr(Vb + 4096 + s * 1024), h1 = vtr(Vb + 4096 + s * 1024 + 512);
                const bf16x8 v0 = (bf16x8){l0[0], l0[1], l0[2], l0[3], h0[0], h0[1], h0[2], h0[3]}, v1 = (bf16x8){l1[0], l1[1], l1[2], l1[3], h1[0], h1[1], h1[2], h1[3]};
                o0 = __builtin_amdgcn_mfma_f32_32x32x16_bf16(pa[s], v0, o0, 0, 0, 0);
                o1 = __builtin_amdgcn_mfma_f32_32x32x16_bf16(pa[s], v1, o1, 0, 0, 0);
            }
        }
        asm volatile("s_waitcnt vmcnt(0) lgkmcnt(0)" ::: "memory"); __builtin_amdgcn_s_barrier();
    }
    lsum += __shfl_xor(lsum, 32);
    if (hi == 0) wsf[32 + r32] = lsum;
    asm volatile("s_waitcnt lgkmcnt(0)" ::: "memory");
    bf16_t* Ow = TM + (rowbase + q0 + wid * 32) * 1024 + h * 64 + r32;
#pragma unroll
    for (int r = 0; r < 16; ++r) { const int q = crow(r, hi); const float il = 1.f / wsf[32 + q];
        bf16_t* p = Ow + (size_t)q * 1024;
        p[0] = (bf16_t)f2bf(o0[r] * il * bf2f(p[0])); p[32] = (bf16_t)f2bf(o1[r] * il * bf2f(p[32])); }
    asm volatile("s_waitcnt lgkmcnt(0)" ::: "memory"); __builtin_amdgcn_s_barrier();
#undef ATT_DMA
}

__device__ __forceinline__ void attn_phase(const Args& a, ATT_LAS unsigned char* lds) {
    const int G = gridDim.x, bid = blockIdx.x;
    const int v = (G % 8 == 0) ? (bid % 8) * (G / 8) + bid / 8 : bid;
    const bf16_t* QN = (const bf16_t*)(a.ws + WS_QN); const bf16_t* QR = (const bf16_t*)(a.ws + WS_QR); const bf16_t* KN = (const bf16_t*)(a.ws + WS_KN);
    const bf16_t* KR = (const bf16_t*)(a.ws + WS_KR); const bf16_t* VV = (const bf16_t*)(a.ws + WS_VV); bf16_t* TM = (bf16_t*)(a.ws + WS_TM);
    for (int s = v; s < NB * NH * 16; s += G) {
        const int bh = (s >> 1) % (NB * NH), half = s & 1, rnd = s / (2 * NB * NH);
        const int j = 2 * (rnd >> 1) + half; const int qb = (rnd & 1) ? 15 - j : j;
        attn_unit(bh / NH, bh % NH, qb, QN, QR, KN, KR, VV, TM, lds);
    }
}
}

namespace ssm {
#define SSM_LAS __attribute__((address_space(3)))
typedef SSM_LAS unsigned char SSM_LAS_T;
typedef short bf16x8 __attribute__((ext_vector_type(8)));
constexpr size_t WS_KTAB = 278 * MiB;
constexpr size_t WS_PW = 280 * MiB;
constexpr size_t WS_POW = 281 * MiB;
constexpr size_t WS_BBF = 284 * MiB;
constexpr size_t WS_SLOC = 258 * MiB;

__device__ __forceinline__ void prep_group(const Args& a, int g, float* lds) {
    const int tid = opq(threadIdx.x);
    float* POWL = lds;
    float* BbL = lds + 65 * 128;
    float* CL = BbL + 2048;
    const float* log_dt = a.in[7]; const float* a_re = a.in[8]; const float* a_im = a.in[9]; const float* b_re = a.in[10]; const float* b_im = a.in[11];
    const float* c_re = a.in[12]; const float* c_im = a.in[13]; const float* dsk = a.in[14];
    float* POWG = (float*)(a.ws + WS_POW) + (size_t)g * 65 * 128; bf16_t* BBF = (bf16_t*)(a.ws + WS_BBF) + (size_t)g * 128 * 16;
    bf16_t* KTAB = (bf16_t*)(a.ws + WS_KTAB) + (size_t)g * 64 * 256; bf16_t* PW = (bf16_t*)(a.ws + WS_PW) + (size_t)g * 64 * 128;
    __syncthreads();
    if (tid < 64) { const int n = tid, idx = g * NS + n;
        const float dt = expf(log_dt[g]), lr = a_re[idx], li = a_im[idx];
        const float mag = expf(lr * dt); float sn, cs; sincosf(li * dt, &sn, &cs);
        const float abr = mag * cs, abi = mag * sn, den = lr * lr + li * li, nr = abr - 1.f, ni = abi;
        const float fr = (nr * lr + ni * li) / den, fi = (ni * lr - nr * li) / den;
        for (int q = 0; q < GP; ++q) { const float br = b_re[(size_t)idx * GP + q], bi = b_im[(size_t)idx * GP + q];
            const float xr = fr * br - fi * bi, xi = fr * bi + fi * br; BbL[(n * 16 + q) * 2] = xr; BbL[(n * 16 + q) * 2 + 1] = xi;
            BBF[n * 16 + q] = (bf16_t)f2bf(xr); BBF[(64 + n) * 16 + q] = (bf16_t)f2bf(xi); }
        float pr = 1.f, pi = 0.f;
        for (int d = 0; d <= 64; ++d) { POWL[(d * 64 + n) * 2] = pr; POWL[(d * 64 + n) * 2 + 1] = pi; POWG[(d * 64 + n) * 2] = pr; POWG[(d * 64 + n) * 2 + 1] = pi;
            const float t = pr * abr - pi * abi; pi = pr * abi + pi * abr; pr = t; }
    }
    for (int e = tid; e < 1024; e += NTHR) { CL[e * 2] = c_re[(size_t)g * 1024 + e]; CL[e * 2 + 1] = c_im[(size_t)g * 1024 + e]; }
    __syncthreads();
    {
        const int pq = tid & 255, p = pq >> 4, q = pq & 15, dh = tid >> 8;
        float acc[32];
#pragma unroll
        for (int i = 0; i < 32; ++i) acc[i] = 0.f;
        for (int n = 0; n < 64; ++n) {
            const float cr = CL[(p * 64 + n) * 2], ci = CL[(p * 64 + n) * 2 + 1], br = BbL[(n * 16 + q) * 2], bi = BbL[(n * 16 + q) * 2 + 1];
            const float gr = cr * br - ci * bi, gi = cr * bi + ci * br;
#pragma unroll
            for (int i = 0; i < 32; ++i) { const int d = dh + 2 * i; acc[i] += gr * POWL[(d * 64 + n) * 2] - gi * POWL[(d * 64 + n) * 2 + 1]; }
        }
        if (dh == 0 && p == q) acc[0] += dsk[g * 16 + p];
#pragma unroll
        for (int i = 0; i < 32; ++i) KTAB[(dh + 2 * i) * 256 + pq] = (bf16_t)f2bf(acc[i]);
    }
    for (int e = tid; e < 64 * 64; e += NTHR) { const int t = e >> 6, n = e & 63;
        *(unsigned*)(PW + t * 128 + 2 * n) = pk2(POWL[((t + 1) * 64 + n) * 2], -POWL[((t + 1) * 64 + n) * 2 + 1]); }
    __syncthreads();
}

__device__ __forceinline__ f32x4 cmul_r(f32x4 ar, f32x4 ai, f32x4 br, f32x4 bi) { return ar * br - ai * bi; }
__device__ __forceinline__ f32x4 cmul_i(f32x4 ar, f32x4 ai, f32x4 br, f32x4 bi) { return ar * bi + ai * br; }

__device__ __forceinline__ void passA(const Args& a) {
    const int tid = opq(threadIdx.x), lane = tid & 63, wid = __builtin_amdgcn_readfirstlane(tid >> 6), j16 = lane & 15, kq = lane >> 4;
    const bf16_t* US = (const bf16_t*)(a.ws + WS_US); float* SLOC = (float*)(a.ws + WS_SLOC);
    for (int item = blockIdx.x; item < NG * 4; item += gridDim.x) {
        const int g = item >> 2, qtr = item & 3, b = wid;
        const bf16_t* BBF = (const bf16_t*)(a.ws + WS_BBF) + (size_t)g * 128 * 16; const float* POWG = (const float*)(a.ws + WS_POW) + (size_t)g * 65 * 128;
        bf16x8 bfr[4][2]; float abr[4], abi[4], a16r[4], a16i[4], afr_[4], afi_[4];
#pragma unroll
        for (int aa = 0; aa < 4; ++aa) { const int n = 16 * aa + j16;
#pragma unroll
            for (int ri = 0; ri < 2; ++ri) bfr[aa][ri] = (kq < 2) ? *(const bf16x8*)(BBF + (ri * 64 + n) * 16 + 8 * kq) : (bf16x8){0, 0, 0, 0, 0, 0, 0, 0};
            abr[aa] = POWG[(1 * 64 + n) * 2]; abi[aa] = POWG[(1 * 64 + n) * 2 + 1]; a16r[aa] = POWG[(16 * 64 + n) * 2]; a16i[aa] = POWG[(16 * 64 + n) * 2 + 1];
            afr_[aa] = POWG[((12 - 4 * kq) * 64 + n) * 2]; afi_[aa] = POWG[((12 - 4 * kq) * 64 + n) * 2 + 1]; }
#pragma unroll 1
        for (int c = qtr * 16; c < qtr * 16 + 16; ++c) {
            const size_t tok0 = (size_t)b * SEQ + c * 64;
            bf16x8 afr[4];
#pragma unroll
            for (int T = 0; T < 4; ++T) afr[T] = (kq < 2) ? *(const bf16x8*)(US + ((size_t)g * NT + tok0 + 16 * T + j16) * 16 + 8 * kq) : (bf16x8){0, 0, 0, 0, 0, 0, 0, 0};
            float* dst = SLOC + (((size_t)b * NG + g) * 64 + c) * 128;
#pragma unroll
            for (int aa = 0; aa < 4; ++aa) {
                float Hr = 0.f, Hi = 0.f;
#pragma unroll
                for (int T = 0; T < 4; ++T) {
                    const f32x4 z = {0.f, 0.f, 0.f, 0.f};
                    const f32x4 vr = __builtin_amdgcn_mfma_f32_16x16x32_bf16(afr[T], bfr[aa][0], z, 0, 0, 0), vi = __builtin_amdgcn_mfma_f32_16x16x32_bf16(afr[T], bfr[aa][1], z, 0, 0, 0);
                    float hr = vr[0], hi_ = vi[0];
#pragma unroll
                    for (int r = 1; r < 4; ++r) { const float t = hr * abr[aa] - hi_ * abi[aa] + vr[r]; hi_ = hr * abi[aa] + hi_ * abr[aa] + vi[r]; hr = t; }
                    const float t = Hr * a16r[aa] - Hi * a16i[aa] + hr; Hi = Hr * a16i[aa] + Hi * a16r[aa] + hi_; Hr = t;
                }
                float rr = afr_[aa] * Hr - afi_[aa] * Hi, ri_ = afr_[aa] * Hi + afi_[aa] * Hr;
                rr += __shfl_xor(rr, 16); ri_ += __shfl_xor(ri_, 16); rr += __shfl_xor(rr, 32); ri_ += __shfl_xor(ri_, 32);
                if (kq == 0) { typedef float f32x2_ __attribute__((ext_vector_type(2))); *(f32x2_*)(dst + 2 * (16 * aa + j16)) = (f32x2_){rr, ri_}; }
            }
        }
    }
}

constexpr int LB_KT = 0, LB_PW = 32768, LB_UB = 49152, UB_BYTES = 2560;
__device__ __forceinline__ float gelu_fast(float v) { const float u2 = 1.5957691216057308f * (v + 0.044715f * v * v * v); return v / (1.f + __expf(-u2)); }
__device__ __forceinline__ void passB(const Args& a, SSM_LAS_T* lds) {
    const int tid = opq(threadIdx.x), lane = tid & 63, wid = __builtin_amdgcn_readfirstlane(tid >> 6), j16 = lane & 15, kq = lane >> 4;
    const bf16_t* US = (const bf16_t*)(a.ws + WS_US); const float* SLOC = (const float*)(a.ws + WS_SLOC); bf16_t* YG = (bf16_t*)(a.ws + WS_YG);
    const float* c_re = a.in[12]; const float* c_im = a.in[13];
    SSM_LAS_T* UB = lds + LB_UB + wid * UB_BYTES;
    for (int item = blockIdx.x; item < NG * 4; item += gridDim.x) {
        const int g = item >> 2, qtr = item & 3, b = wid;
        __syncthreads();
        {   const u32x4* ks = (const u32x4*)(a.ws + WS_KTAB + (size_t)g * 32768); const u32x4* ps = (const u32x4*)(a.ws + WS_PW + (size_t)g * 16384);
            for (int e = tid; e < 2048; e += NTHR) *(SSM_LAS u32x4*)(lds + LB_KT + e * 16) = ks[e];
            for (int e = tid; e < 1024; e += NTHR) *(SSM_LAS u32x4*)(lds + LB_PW + e * 16) = ps[e];
            if (lane < 32) *(SSM_LAS u32x4*)(UB + lane * 16) = (u32x4){0u, 0u, 0u, 0u};
        }
        __syncthreads();
        const float* POWG = (const float*)(a.ws + WS_POW) + (size_t)g * 65 * 128;
        f32x4 cr[4], ci[4], a64r[4], a64i[4], sr[4], si[4];
#pragma unroll
        for (int ks = 0; ks < 4; ++ks) { const int n0 = 16 * ks + 4 * kq;
            cr[ks] = *(const f32x4*)(c_re + ((size_t)g * 16 + j16) * 64 + n0); ci[ks] = *(const f32x4*)(c_im + ((size_t)g * 16 + j16) * 64 + n0);
            const f32x4 w0 = *(const f32x4*)(POWG + (64 * 64 + n0) * 2), w1 = *(const f32x4*)(POWG + (64 * 64 + n0) * 2 + 4);
            a64r[ks] = (f32x4){w0[0], w0[2], w1[0], w1[2]}; a64i[ks] = (f32x4){w0[1], w0[3], w1[1], w1[3]};
            sr[ks] = (f32x4){0.f, 0.f, 0.f, 0.f}; si[ks] = (f32x4){0.f, 0.f, 0.f, 0.f}; }
        const float* slb = SLOC + (((size_t)b * NG + g) * 64) * 128 + 8 * kq;
#define SSM_STEP(cc) do { _Pragma("unroll") for (int ks = 0; ks < 4; ++ks) { const f32x4 w0 = *(const f32x4*)(slb + (size_t)(cc) * 128 + ks * 32), w1 = *(const f32x4*)(slb + (size_t)(cc) * 128 + ks * 32 + 4); \
            const f32x4 lr_ = (f32x4){w0[0], w0[2], w1[0], w1[2]}, li_ = (f32x4){w0[1], w0[3], w1[1], w1[3]}; \
            const f32x4 nr_ = cmul_r(a64r[ks], a64i[ks], sr[ks], si[ks]) + lr_, ni_ = cmul_i(a64r[ks], a64i[ks], sr[ks], si[ks]) + li_; sr[ks] = nr_; si[ks] = ni_; } } while (0)
#pragma unroll 1
        for (int c = 0; c < qtr * 16; ++c) SSM_STEP(c);
#pragma unroll 1
        for (int c = qtr * 16; c < qtr * 16 + 16; ++c) {
            const size_t tok0 = (size_t)b * SEQ + c * 64;
            {   const u32x4* up = (const u32x4*)(US + ((size_t)g * NT + tok0) * 16); const u32x4 u0 = up[lane], u1 = up[64 + lane];
                *(SSM_LAS u32x4*)(UB + 512 + lane * 16) = u0; *(SSM_LAS u32x4*)(UB + 512 + 1024 + lane * 16) = u1; }
            bf16x8 gfr[4];
#pragma unroll
            for (int ks = 0; ks < 4; ++ks) { const f32x4 gr = cmul_r(cr[ks], ci[ks], sr[ks], si[ks]), gi = cmul_i(cr[ks], ci[ks], sr[ks], si[ks]);
                u32x4 w; w.x = pg8::cvt_pk_bf16(gr[0], gi[0]); w.y = pg8::cvt_pk_bf16(gr[1], gi[1]); w.z = pg8::cvt_pk_bf16(gr[2], gi[2]); w.w = pg8::cvt_pk_bf16(gr[3], gi[3]); gfr[ks] = __builtin_bit_cast(bf16x8, w); }
            f32x4 acc[4];
#pragma unroll
            for (int T = 0; T < 4; ++T) { acc[T] = (f32x4){0.f, 0.f, 0.f, 0.f};
#pragma unroll
                for (int ks = 0; ks < 4; ++ks) { const bf16x8 pa = *(SSM_LAS const bf16x8*)(lds + LB_PW + (16 * T + j16) * 256 + ks * 64 + kq * 16);
                    acc[T] = __builtin_amdgcn_mfma_f32_16x16x32_bf16(pa, gfr[ks], acc[T], 0, 0, 0); } }
            asm volatile("s_waitcnt lgkmcnt(0)" ::: "memory");
            SSM_LAS const unsigned char* ua = UB + (16 + j16 - (kq >> 1)) * 32 + (kq & 1) * 16;
            SSM_LAS const unsigned char* kb = lds + LB_KT + (kq >> 1) * 512 + j16 * 32 + (kq & 1) * 16;
#pragma unroll
            for (int s = 48; s >= -14; s -= 2) {
                const bf16x8 ua_ = *(SSM_LAS const bf16x8*)(ua + s * 32);
#pragma unroll
                for (int T = 0; T < 4; ++T) if (16 * T >= s) { const bf16x8 kb_ = *(SSM_LAS const bf16x8*)(kb + (16 * T - s) * 512);
                    acc[T] = __builtin_amdgcn_mfma_f32_16x16x32_bf16(ua_, kb_, acc[T], 0, 0, 0); }
                if ((s & 2) == 0) __builtin_amdgcn_sched_barrier(0);
            }
            bf16_t* yp = YG + ((size_t)g * NT + tok0 + 4 * kq) * 16 + j16;
#pragma unroll
            for (int T = 0; T < 4; ++T)
#pragma unroll
                for (int r = 0; r < 4; ++r) yp[(16 * T + r) * 16] = (bf16_t)f2bf(gelu_fast(acc[T][r]));
            SSM_STEP(c);
            asm volatile("s_waitcnt lgkmcnt(0)" ::: "memory");
        }
#undef SSM_STEP
    }
}
}

__device__ __forceinline__ void ph0_prep(const Args& a) {
    const int gtid = blockIdx.x * NTHR + opq(threadIdx.x), gsz = gridDim.x * NTHR;
    const float* c = a.in[1]; const int* pos = (const int*)a.in[2]; const float* w_ada = a.in[3]; const float* b_ada = a.in[4];
    float* mod = (float*)(a.ws + WS_MOD);
    for (int idx = gtid; idx < NB * 3072; idx += gsz) {
        const int b = idx / 3072, j = idx % 3072; float s = b_ada[j];
        for (int k = 0; k < DM; ++k) s += c[b * DM + k] * w_ada[(size_t)k * 3072 + j];
        mod[idx] = s;
    }
    float* rope = (float*)(a.ws + WS_ROPE);
    for (int idx = gtid; idx < NT * 16; idx += gsz) {
        const int tok = idx >> 4, i = idx & 15;
        const float inv = powf(10000.f, -(float)i / 16.f);
        const float ang = (float)pos[tok] * inv; float sn, cs; sincosf(ang, &sn, &cs);
        rope[(size_t)tok * 32 + i] = cs; rope[(size_t)tok * 32 + 16 + i] = sn;
    }
    const float* log_dt = a.in[7]; const float* a_re = a.in[8]; const float* a_im = a.in[9]; const float* b_re = a.in[10]; const float* b_im = a.in[11];
    float* abar = (float*)(a.ws + WS_SSMC); float* bbar = (float*)(a.ws + WS_SSMC + 65536);
    for (int idx = gtid; idx < NG * NS; idx += gsz) {
        const int g = idx / NS;
        const float dt = expf(log_dt[g]), lr = a_re[idx], li = a_im[idx];
        const float mag = expf(lr * dt); float sn, cs; sincosf(li * dt, &sn, &cs);
        const float abr = mag * cs, abi = mag * sn, den = lr * lr + li * li, nr = abr - 1.f, ni = abi;
        const float fr = (nr * lr + ni * li) / den, fi = (ni * lr - nr * li) / den;
        abar[idx * 2] = abr; abar[idx * 2 + 1] = abi;
        for (int q = 0; q < GP; ++q) { const float br = b_re[(size_t)idx * GP + q], bi = b_im[(size_t)idx * GP + q];
            bbar[((size_t)idx * GP + q) * 2] = fr * br - fi * bi; bbar[((size_t)idx * GP + q) * 2 + 1] = fr * bi + fi * br; }
    }
}

__device__ __forceinline__ void ph1_hnorm(const Args& a) {
    const int tid_ = opq(threadIdx.x), lane = tid_ & 63, gw = blockIdx.x * (NTHR / 64) + (tid_ >> 6), ngw = gridDim.x * (NTHR / 64);
    const float* x = a.in[0]; const float* g_pre = a.in[5]; const float* mod = (const float*)(a.ws + WS_MOD); bf16_t* HB = (bf16_t*)(a.ws + WS_HB);
    for (int m = gw; m < NT; m += ngw) {
        const int b = m / SEQ; const f32x4* xr = (const f32x4*)(x + (size_t)m * DM) + lane;
        f32x4 v[4]; float s = 0.f;
#pragma unroll
        for (int j = 0; j < 4; ++j) { v[j] = xr[64 * j]; s += (v[j].x * v[j].x + v[j].y * v[j].y) + (v[j].z * v[j].z + v[j].w * v[j].w); }
        const float rstd = 1.f / sqrtf(wave_sum(s) * (1.f / DM) + EPS);
        unsigned long long* o8 = (unsigned long long*)(HB + (size_t)m * DM) + lane;
#pragma unroll
        for (int j = 0; j < 4; ++j) { const int k = 256 * j + 4 * lane;
            const f32x4 g = *(const f32x4*)(g_pre + k), sh = *(const f32x4*)(mod + b * 3072 + k), sc = *(const f32x4*)(mod + b * 3072 + 1024 + k);
            const f32x4 h = v[j] * rstd * g * (sc + 1.f) + sh;
            o8[64 * j] = (unsigned long long)pk2(h.x, h.y) | ((unsigned long long)pk2(h.z, h.w) << 32); }
    }
}

struct BL2 { const float* W; __device__ __forceinline__ float b(int k, int j) const {
    int src;
    if (j < 1024) src = C_US + j; else if (j < 1280) src = C_QL + (j - 1024); else if (j < 1536) src = C_KL + (j - 1280);
    else if (j < 1568) { const int p = j - 1536; src = C_KR + ((p & 1) ? 16 + (p >> 1) : (p >> 1)); } else src = C_ZM + (j - 1568);
    return W[(size_t)k * INW + src]; } };
struct EP2 { bf16_t *US, *QL, *KL, *KR, *TM; float *ssq_q, *ssq_kv; const float* rope;
    __device__ __forceinline__ void e(int row, int j, float v0, float v1) const {
        if (j < 1024) { *(unsigned*)(US + ((size_t)(j >> 4) * NT + row) * 16 + (j & 15)) = pk2(v0, v1); }
        else if (j < 1280) { *(unsigned*)(QL + (size_t)row * 256 + (j - 1024)) = pk2(v0, v1); atomicAdd(ssq_q + row, v0 * v0 + v1 * v1); }
        else if (j < 1536) { *(unsigned*)(KL + (size_t)row * 256 + (j - 1280)) = pk2(v0, v1); atomicAdd(ssq_kv + row, v0 * v0 + v1 * v1); }
        else if (j < 1568) { const int p = j - 1536, i = p >> 1; const float cs = rope[(size_t)row * 32 + i], sn = rope[(size_t)row * 32 + 16 + i];
            *(unsigned*)(KR + (size_t)row * 32 + p) = pk2(v0 * cs - v1 * sn, v1 * cs + v0 * sn); }
        else { *(unsigned*)(TM + (size_t)row * 1024 + (j - 1568)) = pk2(siluf_(v0), siluf_(v1)); }
    } };

struct BL3q { const float* W; const float* g; __device__ __forceinline__ float b(int k, int j) const {
    int src; if (j < 1024) src = (j >> 6) * 96 + (j & 63); else { const int jj = j - 1024, h = jj >> 5, p = jj & 31; src = h * 96 + 64 + ((p & 1) ? 16 + (p >> 1) : (p >> 1)); }
    return W[(size_t)k * 1536 + src] * g[k]; } };
struct EP3q { bf16_t *QN, *QR; const float* ssq; const float* rope;
    __device__ __forceinline__ void e(int row, int j, float v0, float v1) const {
        const float rs = QSCALE / sqrtf(ssq[row] * (1.f / 256.f) + EPS); v0 *= rs; v1 *= rs;
        if (j < 1024) *(unsigned*)(QN + (size_t)row * 1024 + j) = pk2(v0, v1);
        else { const int jj = j - 1024, i = (jj & 31) >> 1; const float cs = rope[(size_t)row * 32 + i], sn = rope[(size_t)row * 32 + 16 + i];
            *(unsigned*)(QR + (size_t)row * 512 + jj) = pk2(v0 * cs - v1 * sn, v1 * cs + v0 * sn); }
    } };
struct BL3kv { const float* W; const float* g; __device__ __forceinline__ float b(int k, int j) const {
    const int src = (j < 1024) ? (j >> 6) * 128 + (j & 63) : ((j - 1024) >> 6) * 128 + 64 + (j & 63);
    return W[(size_t)k * 2048 + src] * g[k]; } };
struct EP3kv { bf16_t *KN, *VV; const float* ssq;
    __device__ __forceinline__ void e(int row, int j, float v0, float v1) const {
        const float rs = 1.f / sqrtf(ssq[row] * (1.f / 256.f) + EPS); v0 *= rs; v1 *= rs;
        if (j < 1024) *(unsigned*)(KN + (size_t)row * 1024 + j) = pk2(v0, v1); else *(unsigned*)(VV + (size_t)row * 1024 + (j - 1024)) = pk2(v0, v1);
    } };

__device__ __forceinline__ void ph4_attn(const Args& a, float* lds) {
    const bf16_t* QN = (const bf16_t*)(a.ws + WS_QN); const bf16_t* QR = (const bf16_t*)(a.ws + WS_QR); const bf16_t* KN = (const bf16_t*)(a.ws + WS_KN);
    const bf16_t* KR = (const bf16_t*)(a.ws + WS_KR); const bf16_t* VV = (const bf16_t*)(a.ws + WS_VV); bf16_t* TM = (bf16_t*)(a.ws + WS_TM);
    float* Kt = lds;
    float* Vt = lds + 64 * 100;
    const int tid = opq(threadIdx.x), wv = tid >> 6, half = wv >> 2;
    for (int item = blockIdx.x; item < NB * NH * 16; item += gridDim.x) {
        const int qb = item & 15, h = (item >> 4) & 15, b = item >> 8;
        const size_t tok = (size_t)b * SEQ + qb * 256 + (tid & 255);
        float q[96], o[32];
#pragma unroll
        for (int d = 0; d < 64; d += 2) { const unsigned w = *(const unsigned*)(QN + tok * 1024 + h * 64 + d); q[d] = bf2f(w); q[d + 1] = bf2f(w >> 16); }
#pragma unroll
        for (int d = 0; d < 32; d += 2) { const unsigned w = *(const unsigned*)(QR + tok * 512 + h * 32 + d); q[64 + d] = bf2f(w); q[64 + d + 1] = bf2f(w >> 16); }
#pragma unroll
        for (int d = 0; d < 32; ++d) o[d] = 0.f;
        float m = -1e30f, l = 0.f;
        const int mychunk = qb * 4 + (wv & 3), nkt = qb * 4 + 4;
        for (int kt = 0; kt < nkt; ++kt) {
            __syncthreads();
            const size_t kt0 = (size_t)b * SEQ + kt * 64;
            for (int e = tid; e < 64 * 32; e += NTHR) { const int key = e >> 5, d2 = (e & 31) * 2; const unsigned w = *(const unsigned*)(KN + (kt0 + key) * 1024 + h * 64 + d2); Kt[key * 100 + d2] = bf2f(w); Kt[key * 100 + d2 + 1] = bf2f(w >> 16); }
            for (int e = tid; e < 64 * 16; e += NTHR) { const int key = e >> 4, d2 = (e & 15) * 2; const unsigned w = *(const unsigned*)(KR + (kt0 + key) * 32 + d2); Kt[key * 100 + 64 + d2] = bf2f(w); Kt[key * 100 + 64 + d2 + 1] = bf2f(w >> 16); }
            for (int e = tid; e < 64 * 32; e += NTHR) { const int key = e >> 5, d2 = (e & 31) * 2; const unsigned w = *(const unsigned*)(VV + (kt0 + key) * 1024 + h * 64 + d2); Vt[key * 68 + d2] = bf2f(w); Vt[key * 68 + d2 + 1] = bf2f(w >> 16); }
            __syncthreads();
            if (kt <= mychunk) {
                for (int key = 0; key < 64; ++key) {
                    float s = 0.f;
#pragma unroll
                    for (int d = 0; d < 96; d += 4) { const f32x4 kk = *(const f32x4*)(Kt + key * 100 + d); s += q[d] * kk[0] + q[d + 1] * kk[1] + q[d + 2] * kk[2] + q[d + 3] * kk[3]; }
                    if (s > m) { const float f = exp2f(m - s); l *= f;
#pragma unroll
                        for (int d = 0; d < 32; ++d) o[d] *= f;
                        m = s; }
                    const float p = exp2f(s - m); l += p;
#pragma unroll
                    for (int d = 0; d < 32; d += 4) { const f32x4 vv = *(const f32x4*)(Vt + key * 68 + half * 32 + d); o[d] += p * vv[0]; o[d + 1] += p * vv[1]; o[d + 2] += p * vv[2]; o[d + 3] += p * vv[3]; }
                }
            }
        }
        const float il = 1.f / l;
#pragma unroll
        for (int d = 0; d < 32; d += 2) { unsigned* p = (unsigned*)(TM + tok * 1024 + h * 64 + half * 32 + d); const unsigned w = *p; *p = pk2(o[d] * il * bf2f(w), o[d + 1] * il * bf2f(w >> 16)); }
    }
}

__device__ __forceinline__ void ph5_ssm(const Args& a, float* lds) {
    const int tid = opq(threadIdx.x), lane = tid & 63, wv = tid >> 6;
    const bf16_t* US = (const bf16_t*)(a.ws + WS_US); bf16_t* YG = (bf16_t*)(a.ws + WS_YG);
    const float* abar = (const float*)(a.ws + WS_SSMC); const float* bbar = (const float*)(a.ws + WS_SSMC + 65536);
    const float* c_re = a.in[12]; const float* c_im = a.in[13]; const float* dsk = a.in[14];
    float* Xs = lds + wv * 4096;
    float* Cs = Xs + 1024; float* Us = Cs + 2048;
    for (int item = blockIdx.x * 8 + wv; item < NB * NG; item += gridDim.x * 8) {
        const int b = item / NG, g = item % NG;
        const float abr = abar[(g * NS + lane) * 2], abi = abar[(g * NS + lane) * 2 + 1];
        float bbr[16], bbi[16];
#pragma unroll
        for (int q = 0; q < 16; ++q) { bbr[q] = bbar[((size_t)(g * NS + lane) * 16 + q) * 2]; bbi[q] = bbar[((size_t)(g * NS + lane) * 16 + q) * 2 + 1]; }
        for (int p = 0; p < 16; ++p) { Cs[(p * 64 + lane) * 2] = c_re[((size_t)g * 16 + p) * 64 + lane]; Cs[(p * 64 + lane) * 2 + 1] = c_im[((size_t)g * 16 + p) * 64 + lane]; }
        float xr = 0.f, xi = 0.f;
        const bf16_t* ug = US + ((size_t)g * NT + (size_t)b * SEQ) * 16; bf16_t* yg = YG + ((size_t)g * NT + (size_t)b * SEQ) * 16;
        const int tt = lane >> 3, p0 = (lane & 7) * 2;
        const float d0 = dsk[g * 16 + p0], d1 = dsk[g * 16 + p0 + 1];
        for (int t0 = 0; t0 < SEQ; t0 += 8) {
            { const unsigned w = *(const unsigned*)(ug + (size_t)t0 * 16 + lane * 2); Us[lane * 2] = bf2f(w); Us[lane * 2 + 1] = bf2f(w >> 16); }
            asm volatile("s_waitcnt vmcnt(0) lgkmcnt(0)" ::: "memory");
#pragma unroll
            for (int t = 0; t < 8; ++t) {
                float bur = 0.f, bui = 0.f;
#pragma unroll
                for (int q = 0; q < 16; ++q) { const float u = Us[t * 16 + q]; bur += bbr[q] * u; bui += bbi[q] * u; }
                const float nr = abr * xr - abi * xi + bur, ni = abr * xi + abi * xr + bui; xr = nr; xi = ni;
                Xs[(t * 64 + lane) * 2] = xr; Xs[(t * 64 + lane) * 2 + 1] = xi;
            }
            asm volatile("s_waitcnt vmcnt(0) lgkmcnt(0)" ::: "memory");
            float y0 = 0.f, y1 = 0.f;
            for (int n = 0; n < 64; ++n) { const float vr = Xs[(tt * 64 + n) * 2], vi = Xs[(tt * 64 + n) * 2 + 1];
                y0 += Cs[(p0 * 64 + n) * 2] * vr - Cs[(p0 * 64 + n) * 2 + 1] * vi; y1 += Cs[((p0 + 1) * 64 + n) * 2] * vr - Cs[((p0 + 1) * 64 + n) * 2 + 1] * vi; }
            y0 += d0 * Us[tt * 16 + p0]; y1 += d1 * Us[tt * 16 + p0 + 1];
            *(unsigned*)(yg + (size_t)(t0 + tt) * 16 + p0) = pk2(gelu_tanh(y0), gelu_tanh(y1));
            asm volatile("s_waitcnt vmcnt(0) lgkmcnt(0)" ::: "memory");
        }
    }
}

struct BLzs { const float* W; __device__ __forceinline__ float b(int k, int j) const { return W[(size_t)k * INW + C_ZS + j]; } };
struct EPzs { bf16_t* ZS; __device__ __forceinline__ void e(int row, int j, float v0, float v1) const { *(unsigned*)(ZS + (size_t)row * 1024 + j) = pk2(siluf_(v0), siluf_(v1)); } };
struct BLglu { const float* W; __device__ __forceinline__ float b(int k, int j) const { return W[(size_t)k * 2048 + ((j & 1) ? 1024 + (j >> 1) : (j >> 1))]; } };
struct EPglu { bf16_t* TS; const bf16_t* ZS; const float* bias; __device__ __forceinline__ void e(int row, int j, float v0, float v1) const {
    const int jj = j >> 1; const float ga = v0 + bias[jj], gb = v1 + bias[1024 + jj]; TS[(size_t)row * 1024 + jj] = (bf16_t)f2bf(ga * sigmoidf_(gb) * bf2f(ZS[(size_t)row * 1024 + jj])); } };
struct BLgate { const float* W; __device__ __forceinline__ float b(int k, int j) const { return W[(size_t)k * INW + ((j & 1) ? C_GM + (j >> 1) : C_GS + (j >> 1))]; } };
struct EPgate { bf16_t *GS, *GM; __device__ __forceinline__ void e(int row, int j, float v0, float v1) const { const int jj = j >> 1; GS[(size_t)row * 1024 + jj] = (bf16_t)f2bf(sigmoidf_(v0)); GM[(size_t)row * 1024 + jj] = (bf16_t)f2bf(sigmoidf_(v1)); } };
struct BLplain { const float* W; int ldw; __device__ __forceinline__ float b(int k, int j) const { return W[(size_t)k * ldw + j]; } };
struct EPbs { float* P1; const bf16_t* GS; __device__ __forceinline__ void e(int row, int j, float v0, float v1) const {
    const unsigned w = *(const unsigned*)(GS + (size_t)row * 1024 + j); P1[(size_t)row * 1024 + j] = bf2f(w) * v0; P1[(size_t)row * 1024 + j + 1] = bf2f(w >> 16) * v1; } };
struct EPbm { const float* P1; const bf16_t* GM; bf16_t* MG; __device__ __forceinline__ void e(int row, int j, float v0, float v1) const {
    const unsigned w = *(const unsigned*)(GM + (size_t)row * 1024 + j); *(unsigned*)(MG + (size_t)row * 1024 + j) = pk2(P1[(size_t)row * 1024 + j] + bf2f(w) * v0, P1[(size_t)row * 1024 + j + 1] + bf2f(w >> 16) * v1); } };
struct EPout { float* O; __device__ __forceinline__ void e(int row, int j, float v0, float v1) const { O[(size_t)row * 1024 + j] = v0; O[(size_t)row * 1024 + j + 1] = v1; } };

__device__ __forceinline__ void ph_final(const Args& a) {
    const int tid_ = opq(threadIdx.x), lane = tid_ & 63, gw = blockIdx.x * (NTHR / 64) + (tid_ >> 6), ngw = gridDim.x * (NTHR / 64);
    const float* x = a.in[0]; const float* g_post = a.in[24]; const float* mod = (const float*)(a.ws + WS_MOD);
#if FAST_OUT
    const bf16_t* OB = (const bf16_t*)(a.ws + WS_OUTB); const float* SO = (const float*)(a.ws + WS_SO);
    for (int m = gw; m < NT; m += ngw) {
        const int b = m / SEQ; const f32x4* xr = (const f32x4*)(x + (size_t)m * DM) + lane;
        const f32x4 p0 = *(const f32x4*)(SO + (size_t)m * 16), p1 = *(const f32x4*)(SO + (size_t)m * 16 + 4), p2 = *(const f32x4*)(SO + (size_t)m * 16 + 8), p3 = *(const f32x4*)(SO + (size_t)m * 16 + 12);
        const f32x4 ps = (p0 + p1) + (p2 + p3);
        const float rstd = 1.f / sqrtf(((ps[0] + ps[1]) + (ps[2] + ps[3])) * (1.f / DM) + EPS);
        const u32x2* orow = (const u32x2*)(OB + (size_t)m * DM) + lane;
        f32x4* o = (f32x4*)(a.out + (size_t)m * DM) + lane;
#pragma unroll
        for (int j = 0; j < 4; ++j) { const int k = 256 * j + 4 * lane; const u32x2 w = orow[64 * j]; const f32x4 v = (f32x4){bf2f(w.x), bf2f(w.x >> 16), bf2f(w.y), bf2f(w.y >> 16)};
            const f32x4 g = *(const f32x4*)(g_post + k), gt = *(const f32x4*)(mod + b * 3072 + 2048 + k);
            o[64 * j] = xr[64 * j] + gt * (v * rstd * g); }
    }
#else
    const float* OF = (const float*)(a.ws + WS_OUTF);
    for (int m = gw; m < NT; m += ngw) {
        const int b = m / SEQ; const f32x4* orow = (const f32x4*)(OF + (size_t)m * DM) + lane; const f32x4* xr = (const f32x4*)(x + (size_t)m * DM) + lane;
        f32x4 v[4]; float s = 0.f;
#pragma unroll
        for (int j = 0; j < 4; ++j) { v[j] = orow[64 * j]; s += (v[j].x * v[j].x + v[j].y * v[j].y) + (v[j].z * v[j].z + v[j].w * v[j].w); }
        const float rstd = 1.f / sqrtf(wave_sum(s) * (1.f / DM) + EPS);
        f32x4* o = (f32x4*)(a.out + (size_t)m * DM) + lane;
#pragma unroll
        for (int j = 0; j < 4; ++j) { const int k = 256 * j + 4 * lane; const f32x4 g = *(const f32x4*)(g_post + k), gt = *(const f32x4*)(mod + b * 3072 + 2048 + k);
            o[64 * j] = xr[64 * j] + gt * (v[j] * rstd * g); }
    }
#endif
}

constexpr int NPHASE = 11;
__global__ void __launch_bounds__(NTHR, 2) mk_fwd(Args a) {
    extern __shared__ __attribute__((aligned(16))) unsigned char lds_raw[];
    float* lds = (float*)lds_raw;
    unsigned char* ws = a.ws;
#define SEAM(k) do { if (a.ph_lo <= (k) && (k) + 1 < a.ph_hi) { cg::this_grid().sync(); } } while (0)
#define IN(k) (a.ph_lo <= (k) && (k) < a.ph_hi)
    pg8::PG8_LAS_T* l3 = (pg8::PG8_LAS_T*)lds_raw;
    const int G = gridDim.x, bid = blockIdx.x;
    if (IN(0)) { ph0_prep(a);
#if FAST_SSM
        for (int g = bid; g < NG; g += G) ssm::prep_group(a, g, lds);
        __syncthreads();
#endif
        prep_weights(a, lds); } SEAM(0);
    if (IN(1)) { ph1_hnorm(a); } SEAM(1);
    if (IN(2)) {
#if FAST_G1A
        pg8::Gemm g{(const char*)(ws + WS_HB), (const char*)(ws + WS_HB), (const char*)(ws + WS_WINA), 2816, 1024, 1024, 0, 16}; pg8::StaticOrder S; S.init(NT, 2816, G, bid);
        pg8::EpiG1a E{(bf16_t*)(ws + WS_US), (bf16_t*)(ws + WS_TM), (bf16_t*)(ws + WS_QL), (bf16_t*)(ws + WS_KL), (bf16_t*)(ws + WS_KR), (float*)(ws + WS_SQ), (float*)(ws + WS_SKV), (const float*)(ws + WS_ROPE)};
        pg8::gemm_phase(l3, g, S, E);
#else
        ARow al{(const bf16_t*)(ws + WS_HB), 1024}; BL2 bl{a.in[6]};
        EP2 ep{(bf16_t*)(ws + WS_US), (bf16_t*)(ws + WS_QL), (bf16_t*)(ws + WS_KL), (bf16_t*)(ws + WS_KR), (bf16_t*)(ws + WS_TM), (float*)(ws + WS_CTL), (float*)(ws + WS_CTL + 131072), (const float*)(ws + WS_ROPE)};
        gemm_o(lds, NT, 2592, 1024, al, bl, ep);
#endif
    } SEAM(2);
    if (IN(3)) {
#if FAST_G2
        { pg8::Gemm g{(const char*)(ws + WS_QL), (const char*)(ws + WS_QL), (const char*)(ws + WS_WQ), 1536, 256, 256, 0, 4}; pg8::StaticOrder S; S.init(NT, 1536, G, bid);
          pg8::EpiG2q E{(bf16_t*)(ws + WS_QN), (bf16_t*)(ws + WS_QR), (const float*)(ws + WS_SQ), (const float*)(ws + WS_ROPE)}; pg8::gemm_phase(l3, g, S, E); }
        { pg8::Gemm g{(const char*)(ws + WS_KL), (const char*)(ws + WS_KL), (const char*)(ws + WS_WKV), 2048, 256, 256, 0, 4}; pg8::StaticOrder S; S.init(NT, 2048, G, bid);
          pg8::EpiG2kv E{(bf16_t*)(ws + WS_KN), (bf16_t*)(ws + WS_VV), (const float*)(ws + WS_SKV)}; pg8::gemm_phase(l3, g, S, E); }
#if FAST_SSM
        ssm::passA(a);
#endif
#else
        { ARow al{(const bf16_t*)(ws + WS_QL), 256}; BL3q bl{a.in[18], a.in[17]}; EP3q ep{(bf16_t*)(ws + WS_QN), (bf16_t*)(ws + WS_QR), (const float*)(ws + WS_CTL), (const float*)(ws + WS_ROPE)};
          gemm_o(lds, NT, 1536, 256, al, bl, ep); }
        { ARow al{(const bf16_t*)(ws + WS_KL), 256}; BL3kv bl{a.in[20], a.in[19]}; EP3kv ep{(bf16_t*)(ws + WS_KN), (bf16_t*)(ws + WS_VV), (const float*)(ws + WS_CTL + 131072)};
          gemm_o(lds, NT, 2048, 256, al, bl, ep); }
#endif
    } SEAM(3);
#if FAST_ATT
    if (IN(4)) { att::attn_phase(a, (att::ATT_LAS_T*)lds_raw); } SEAM(4);
#else
    if (IN(4)) { ph4_attn(a, lds); } SEAM(4);
#endif
    if (IN(5)) {
#if FAST_ZS
        { pg8::Gemm g{(const char*)(ws + WS_HB), (const char*)(ws + WS_HB), (const char*)(ws + WS_WZS), 1024, 1024, 1024, 0, 16}; pg8::StaticOrder S; S.init(NT, 1024, G, bid);
          pg8::EpiZs E{(bf16_t*)(ws + WS_ZS)}; pg8::gemm_phase(l3, g, S, E); }
#else
        { ARow al{(const bf16_t*)(ws + WS_HB), 1024}; BLzs bl{a.in[6]}; EPzs ep{(bf16_t*)(ws + WS_ZS)}; gemm_o(lds, NT, 1024, 1024, al, bl, ep); }
#endif
        __syncthreads();
#if FAST_SSM
        ssm::passB(a, (ssm::SSM_LAS_T*)lds_raw);
#else
        ph5_ssm(a, lds);
#endif
    } SEAM(5);
    if (IN(6)) {
#if FAST_GLU
        { pg8::Gemm g{(const char*)(ws + WS_YG), (const char*)(ws + WS_YG), (const char*)(ws + WS_WGLU), 2048, 1024, 1024, 1, 16}; pg8::StaticOrder S; S.init(NT, 2048, G, bid);
          pg8::EpiGlu E{(bf16_t*)(ws + WS_TS), (const bf16_t*)(ws + WS_ZS), a.in[16]}; pg8::gemm_phase(l3, g, S, E); }
#else
        { AGrp al{(const bf16_t*)(ws + WS_YG)}; BLglu bl{a.in[15]}; EPglu ep{(bf16_t*)(ws + WS_TS), (const bf16_t*)(ws + WS_ZS), a.in[16]}; gemm_o(lds, NT, 2048, 1024, al, bl, ep); }
#endif
#if FAST_MERGE
        { pg8::Gemm g{(const char*)(ws + WS_HB), (const char*)(ws + WS_HB), (const char*)(ws + WS_WGATE), 2048, 1024, 1024, 0, 16}; pg8::StaticOrder S; S.init(NT, 2048, G, bid);
          pg8::EpiGate E{(bf16_t*)(ws + WS_RAT), (bf16_t*)(ws + WS_SGM)}; pg8::gemm_phase(l3, g, S, E); }
#else
        { ARow al{(const bf16_t*)(ws + WS_HB), 1024}; BLgate bl{a.in[6]}; EPgate ep{(bf16_t*)(ws + WS_GS), (bf16_t*)(ws + WS_GM)}; gemm_o(lds, NT, 2048, 1024, al, bl, ep); }
#endif
    } SEAM(6);
#if FAST_MERGE
    if (IN(7)) { pg8::Gemm g{(const char*)(ws + WS_TS), (const char*)(ws + WS_TM), (const char*)(ws + WS_WBR), 1024, 2048, 1024, 0, 16}; pg8::StaticOrder S; S.init(NT, 1024, G, bid);
        pg8::EpiMerge E{(const bf16_t*)(ws + WS_RAT), (const bf16_t*)(ws + WS_SGM), (bf16_t*)(ws + WS_MG)}; pg8::gemm_phase(l3, g, S, E); } SEAM(7);
    SEAM(8);
#else
    if (IN(7)) { ARow al{(const bf16_t*)(ws + WS_TS), 1024}; BLplain bl{a.in[21], 1024}; EPbs ep{(float*)(ws + WS_P1), (const bf16_t*)(ws + WS_GS)}; gemm_o(lds, NT, 1024, 1024, al, bl, ep); } SEAM(7);
    if (IN(8)) { ARow al{(const bf16_t*)(ws + WS_TM), 1024}; BLplain bl{a.in[22], 1024}; EPbm ep{(const float*)(ws + WS_P1), (const bf16_t*)(ws + WS_GM), (bf16_t*)(ws + WS_MG)}; gemm_o(lds, NT, 1024, 1024, al, bl, ep); } SEAM(8);
#endif
    if (IN(9)) {
#if FAST_OUT
        pg8::Gemm g{(const char*)(ws + WS_MG), (const char*)(ws + WS_MG), (const char*)(ws + WS_WOUT), 1024, 1024, 1024, 0, 16}; pg8::StaticOrder S; S.init(NT, 1024, G, bid);
        pg8::EpiOut E{(bf16_t*)(ws + WS_OUTB), (float*)(ws + WS_SO)}; pg8::gemm_phase(l3, g, S, E);
#else
        ARow al{(const bf16_t*)(ws + WS_MG), 1024}; BLplain bl{a.in[23], 1024}; EPout ep{(float*)(ws + WS_OUTF)}; gemm_o(lds, NT, 1024, 1024, al, bl, ep);
#endif
    } SEAM(9);
    if (IN(10)) { ph_final(a); }
#undef SEAM
#undef IN
}

extern "C" void kernel_launch(void* const* d_in, const int* in_sizes, int n_in, void* d_out, int out_size, void* d_ws, size_t ws_size, hipStream_t stream) {
    static int grid = 0;
    if (grid == 0) {
        if (n_in != 25 || out_size != NT * DM || ws_size < WS_END) { fprintf(stderr, "kernel_launch: unexpected shapes n_in %d out %d ws %zu\n", n_in, out_size, ws_size); grid = -1; return; }
        int dev = 0, cus = 0, per_cu = 0;
        hipGetDevice(&dev); hipDeviceGetAttribute(&cus, hipDeviceAttributeMultiprocessorCount, dev);
        hipFuncSetAttribute((const void*)mk_fwd, hipFuncAttributeMaxDynamicSharedMemorySize, LDS_BYTES);
        hipOccupancyMaxActiveBlocksPerMultiprocessor(&per_cu, (const void*)mk_fwd, NTHR, LDS_BYTES);
        (void)hipGetLastError();
        if (per_cu < 1) per_cu = 1;
        grid = cus * 1;
        fprintf(stderr, "kernel_launch: cus %d per_cu %d grid %d ws %zu\n", cus, per_cu, grid, ws_size);
    }
    if (grid < 0) return;
    hipMemsetAsync((char*)d_ws + WS_CTL, 0, 1 * MiB, stream);
    Args a{};
    for (int i = 0; i < 25; ++i) a.in[i] = (const float*)d_in[i];
    a.out = (float*)d_out; a.ws = (unsigned char*)d_ws;
#if MK_SINGLE
    a.ph_lo = 0; a.ph_hi = NPHASE;
    void* args[] = {&a};
    hipError_t e = hipLaunchCooperativeKernel((const void*)mk_fwd, dim3(grid), dim3(NTHR), args, LDS_BYTES, stream);
    if (e != hipSuccess) fprintf(stderr, "cooperative launch failed: %s (grid %d)\n", hipGetErrorString(e), grid);
#else
    for (int p = 0; p < NPHASE; ++p) { a.ph_lo = p; a.ph_hi = p + 1; hipLaunchKernelGGL(mk_fwd, dim3(grid), dim3(NTHR), LDS_BYTES, stream, a); }
#endif
}
```

```cpp
#include <hip/hip_runtime.h>
#include <hip/hip_cooperative_groups.h>
#include <cstdint>
#include <cstdio>
namespace cg = cooperative_groups;

#ifndef MK_SINGLE
#define MK_SINGLE 1
#endif
#ifndef FAST_ALL
#define FAST_ALL 1
#endif
#ifndef ATT_PROBE
#define ATT_PROBE 0
#endif
#ifndef PROBE_DUP
#define PROBE_DUP (-1)
#endif
#ifndef FAST_G1A
#define FAST_G1A FAST_ALL
#endif
#ifndef FAST_G2
#define FAST_G2 FAST_ALL
#endif
#ifndef FAST_ZS
#define FAST_ZS FAST_ALL
#endif
#ifndef FAST_GLU
#define FAST_GLU FAST_ALL
#endif
#ifndef FAST_MERGE
#define FAST_MERGE FAST_ALL
#endif
#ifndef FAST_OUT
#define FAST_OUT FAST_ALL
#endif
#ifndef FAST_ATT
#define FAST_ATT FAST_ALL
#endif
#ifndef FAST_SSM
#define FAST_SSM FAST_ALL
#endif

typedef unsigned short bf16_t;
typedef float f32x4 __attribute__((ext_vector_type(4)));
typedef unsigned u32x4 __attribute__((ext_vector_type(4)));
typedef unsigned u32x2 __attribute__((ext_vector_type(2)));

constexpr int NB = 8, SEQ = 4096, DM = 1024, NT = NB * SEQ;
constexpr int INW = 5664;
constexpr int C_US = 0, C_ZS = 1024, C_QL = 2048, C_KL = 2304, C_KR = 2560, C_ZM = 2592, C_GS = 3616, C_GM = 4640;
constexpr int NG = 64, GP = 16, NS = 64;
constexpr int NH = 16;
constexpr float EPS = 1e-6f;
constexpr float QSCALE = 0.10206207261596577f * 1.4426950408889634f;
constexpr int NTHR = 512;
constexpr int LDS_BYTES = 147456;

constexpr size_t MiB = 1u << 20;
constexpr size_t WS_CTL = 0;
constexpr size_t WS_MOD = 1 * MiB;
constexpr size_t WS_ROPE = 2 * MiB;
constexpr size_t WS_SSMC = 6 * MiB;
constexpr size_t WS_SSQ = 0;
constexpr size_t WS_WINA = 8 * MiB;
constexpr size_t WS_WZS = 14 * MiB;
constexpr size_t WS_WGATE = 16 * MiB;
constexpr size_t WS_WGLU = 20 * MiB;
constexpr size_t WS_WQ = 24 * MiB;
constexpr size_t WS_WKV = 25 * MiB;
constexpr size_t WS_WBR = 26 * MiB;
constexpr size_t WS_WOUT = 30 * MiB;
constexpr size_t WS_SQ = 274 * MiB;
constexpr size_t WS_SKV = 275 * MiB;
constexpr size_t WS_SO = 276 * MiB;
constexpr size_t WS_HB = 32 * MiB;
constexpr size_t WS_US = 96 * MiB;
constexpr size_t WS_TM = 160 * MiB;
constexpr size_t WS_QL = 224 * MiB;
constexpr size_t WS_KL = 240 * MiB;
constexpr size_t WS_KR = 256 * MiB;
constexpr size_t WS_QN = 288 * MiB;
constexpr size_t WS_QR = 352 * MiB;
constexpr size_t WS_KN = 384 * MiB;
constexpr size_t WS_VV = 448 * MiB;
constexpr size_t WS_ZS = 288 * MiB;
constexpr size_t WS_YG = 352 * MiB;
constexpr size_t WS_TS = 416 * MiB;
constexpr size_t WS_GS = 96 * MiB;
constexpr size_t WS_GM = 224 * MiB;
constexpr size_t WS_P1 = 288 * MiB;
constexpr size_t WS_MG = 32 * MiB;
constexpr size_t WS_OUTF = 288 * MiB;
constexpr size_t WS_RAT = 96 * MiB;
constexpr size_t WS_SGM = 224 * MiB;
constexpr size_t WS_OUTB = 288 * MiB;
constexpr size_t WS_END = 512 * MiB;

__device__ __forceinline__ unsigned f2bf(float f) { unsigned u = __builtin_bit_cast(unsigned, f); return (u + 0x7fffu + ((u >> 16) & 1u)) >> 16; }
__device__ __forceinline__ float bf2f(unsigned h) { return __builtin_bit_cast(float, (h & 0xffffu) << 16); }
__device__ __forceinline__ unsigned pk2(float lo, float hi) { return f2bf(lo) | (f2bf(hi) << 16); }
__device__ __forceinline__ float sigmoidf_(float v) { return 1.f / (1.f + __expf(-v)); }
__device__ __forceinline__ float siluf_(float v) { return v / (1.f + __expf(-v)); }
__device__ __forceinline__ float gelu_tanh(float v) { const float u = 0.7978845608028654f * (v + 0.044715f * v * v * v); return 0.5f * v * (1.f + tanhf(u)); }
__device__ __forceinline__ float wave_sum(float v) {
#pragma unroll
    for (int o = 1; o < 64; o <<= 1) v += __shfl_xor(v, o);
    return v;
}

__device__ __forceinline__ int opq(int x) { asm volatile("" : "+v"(x)); return x; }
struct Args { const float* in[25]; float* out; unsigned char* ws; int ph_lo, ph_hi; };

template <class AL, class BL, class EP>
__device__ __forceinline__ void gemm_o(float* lds, int M, int N, int K, const AL& al, const BL& bl, const EP& ep) {
    float* As = lds;
    float* Bs = lds + 16 * 132;
    const int tid = opq(threadIdx.x), ty = tid >> 4, tx = tid & 15;
    const int ntn = (N + 127) / 128, ntm = M / 128, ntiles = ntm * ntn;
    for (int tile = blockIdx.x; tile < ntiles; tile += gridDim.x) {
        const int tm = tile / ntn, tn = tile % ntn;
        const int row0 = tm * 128, col0 = tn * 128;
        float acc[4][8];
#pragma unroll
        for (int i = 0; i < 4; ++i)
#pragma unroll
            for (int j = 0; j < 8; ++j) acc[i][j] = 0.f;
        for (int k0 = 0; k0 < K; k0 += 16) {
            {
                const int r = tid >> 2, kk = (tid & 3) * 4;
                const bf16_t* p = al.a4(row0 + r, k0 + kk);
                const u32x2 w = *(const u32x2*)p;
                As[(kk + 0) * 132 + r] = bf2f(w.x); As[(kk + 1) * 132 + r] = bf2f(w.x >> 16);
                As[(kk + 2) * 132 + r] = bf2f(w.y); As[(kk + 3) * 132 + r] = bf2f(w.y >> 16);
            }
            {
                const int kk = tid >> 5, c = (tid & 31) * 4;
#pragma unroll
                for (int j = 0; j < 4; ++j) { const int col = col0 + c + j; Bs[kk * 132 + c + j] = (col < N) ? bl.b(k0 + kk, col) : 0.f; }
            }
            __syncthreads();
#pragma unroll 2
            for (int kk = 0; kk < 16; ++kk) {
                const f32x4 a = *(const f32x4*)(As + kk * 132 + ty * 4);
                const f32x4 b0 = *(const f32x4*)(Bs + kk * 132 + tx * 8), b1 = *(const f32x4*)(Bs + kk * 132 + tx * 8 + 4);
#pragma unroll
                for (int i = 0; i < 4; ++i) {
                    acc[i][0] += a[i] * b0[0]; acc[i][1] += a[i] * b0[1]; acc[i][2] += a[i] * b0[2]; acc[i][3] += a[i] * b0[3];
                    acc[i][4] += a[i] * b1[0]; acc[i][5] += a[i] * b1[1]; acc[i][6] += a[i] * b1[2]; acc[i][7] += a[i] * b1[3];
                }
            }
            __syncthreads();
        }
#pragma unroll
        for (int i = 0; i < 4; ++i)
#pragma unroll
            for (int j = 0; j < 8; j += 2) { const int col = col0 + tx * 8 + j; if (col < N) ep.e(row0 + ty * 4 + i, col, acc[i][j], acc[i][j + 1]); }
    }
}

struct ARow { const bf16_t* A; int lda; __device__ __forceinline__ const bf16_t* a4(int row, int k) const { return A + (size_t)row * lda + k; } };
struct AGrp { const bf16_t* A; __device__ __forceinline__ const bf16_t* a4(int row, int k) const { return A + ((size_t)(k >> 4) * NT + row) * 16 + (k & 15); } };

namespace pg8 {
#define PG8_LAS __attribute__((address_space(3)))
typedef PG8_LAS unsigned char PG8_LAS_T;
typedef short bf16x8 __attribute__((ext_vector_type(8)));
constexpr int BM = 256, BK = 64, HALF = 128, HTB = HALF * BK * 2, STAGE_BYTES = 8 * HTB, NXCD = 8, WGM = 8;
constexpr unsigned PLANE = (unsigned)NT * 32u;

__host__ __device__ __forceinline__ int lds_byte(int r, int c) { const int st = (r >> 4) * 2 + (c >> 5), rr = r & 15, cc = c & 31, ob = rr * 64 + cc * 2; return st * 1024 + (ob ^ (((ob >> 9) & 1) << 5)); }
__host__ __device__ __forceinline__ void stage_rc(int b, int& R, int& C) { const int st = b / 1024, sb = b % 1024, swz = sb ^ (((sb >> 9) & 1) << 5); R = (st >> 1) * 16 + swz / 64; C = (st & 1) * 32 + (swz % 64) / 2; }
__host__ __device__ __forceinline__ int perm32(int rho) { const int n = rho >> 4, i = rho & 15; return 8 * (i >> 2) + 4 * n + (i & 3); }

struct Unit { int pm, pn; };
struct Gemm { const char* A; const char* A2; const char* Bt; int N, K, lda, amode, tmid; };

struct StaticOrder {
    int nM, nN, nwg, G, c;
    __device__ void init(int M, int N, int G_, int c_) { nM = M / BM; nN = N / BM; nwg = nM * nN; G = G_; c = c_; }
    __device__ bool next(int i, Unit& u) const {
        const long L = (long)i * G + c; if (L >= nwg) return false;
        int wgid = (int)L; { const int q = nwg / NXCD, r = nwg % NXCD, xcd = wgid % NXCD, off = wgid / NXCD; wgid = (xcd < r ? xcd * (q + 1) : r * (q + 1) + (xcd - r) * q) + off; }
        const int nig = WGM * nN, gid = wgid / nig, fm = gid * WGM, gsz = (nM - fm) < WGM ? (nM - fm) : WGM;
        u.pm = fm + ((wgid % nig) % gsz); u.pn = (wgid % nig) / gsz; return true;
    }
};

typedef f32x4 Acc[2][2][4][2];

template <class Epi, class Sched>
__device__ __forceinline__ void gemm_phase(PG8_LAS unsigned char* lds, const Gemm g, const Sched& S, const Epi& E) {
    const int tid = opq(threadIdx.x), wid = __builtin_amdgcn_readfirstlane(tid >> 6), lane = tid & 63, wr = wid >> 2, wc = wid & 3, fr = lane & 15, fq = lane >> 4;
    const int K = g.K, nt = K / BK;
    unsigned voffA[2], voffB[2];
#pragma unroll
    for (int i = 0; i < 2; ++i) { int R, C; stage_rc(tid * 16 + i * 8192, R, C); const int Rb = (R & ~31) + perm32(R & 31);
        voffA[i] = g.amode == 0 ? (unsigned)(R * g.lda + C) * 2u : (unsigned)(C >> 4) * PLANE + (unsigned)R * 32u + (unsigned)(C & 15) * 2u;
        voffB[i] = (unsigned)(Rb * K + C) * 2u; }
    const size_t akstep = g.amode == 0 ? (size_t)(BK * 2) : (size_t)4 * PLANE;
    const size_t ahstep = g.amode == 0 ? (size_t)HALF * g.lda * 2 : (size_t)HALF * 32;
    const size_t atstep = 2 * ahstep;
    const size_t bkstep = (size_t)(BK * 2), bhstep = (size_t)HALF * K * 2, btstep = 2 * bhstep;
    const unsigned ldsw = (unsigned)wid * 1024u;
    const int aoff = lds_byte(wr * 64 + fr, fq * 8), boff = lds_byte(wc * 32 + fr, fq * 8);
    const int tmid = g.tmid;
    const char* const Alo = g.A; const char* const Ahi = g.A2 - (size_t)tmid * akstep;
#define PG8_AP(pm_, t_) ((((t_) < tmid) ? Alo : Ahi) + (size_t)(pm_) * atstep + (size_t)(t_) * akstep)
#define PG8_SA(b, h) (((b) * 2 + (h)) * HTB)
#define PG8_SB(b, h) ((4 + (b) * 2 + (h)) * HTB)
#define PG8_STAGE(bufoff, gbase, voff) do { _Pragma("unroll") for (int _i = 0; _i < 2; ++_i) \
        __builtin_amdgcn_global_load_lds((const unsigned*)((const char*)(gbase) + (voff)[_i]), (PG8_LAS unsigned*)(lds + (bufoff) + ldsw + _i * 8192), 16, 0, 0); } while (0)
#define PG8_LDA(dst, b, h) do { _Pragma("unroll") for (int m = 0; m < 4; ++m) _Pragma("unroll") for (int k = 0; k < 2; ++k) dst[m][k] = *(const PG8_LAS bf16x8*)(lds + PG8_SA(b, h) + aoff + m * 2048 + k * 1024); } while (0)
#define PG8_LDB(dst, b, h) do { _Pragma("unroll") for (int n = 0; n < 2; ++n) _Pragma("unroll") for (int k = 0; k < 2; ++k) dst[n][k] = *(const PG8_LAS bf16x8*)(lds + PG8_SB(b, h) + boff + n * 2048 + k * 1024); } while (0)
#define PG8_MMA(ai, bj, At, Bt) do { __builtin_amdgcn_s_setprio(1); _Pragma("unroll") for (int m = 0; m < 4; ++m) _Pragma("unroll") for (int n = 0; n < 2; ++n) _Pragma("unroll") for (int k = 0; k < 2; ++k) \
        acc[ai][bj][m][n] = __builtin_amdgcn_mfma_f32_16x16x32_bf16(Bt[n][k], At[m][k], acc[ai][bj][m][n], 0, 0, 0); __builtin_amdgcn_s_setprio(0); } while (0)
#define PG8_WAIT_V(n) asm volatile("s_waitcnt vmcnt(" #n ")" ::: "memory")
#define PG8_WAIT_L(n) asm volatile("s_waitcnt lgkmcnt(" #n ")" ::: "memory")
#define PG8_BAR __builtin_amdgcn_s_barrier()
#define PG8_SCHED __builtin_amdgcn_sched_barrier(0)
    Unit cur, nxt; int ui = 0;
    if (!S.next(0, cur)) return;
    Acc acc;
#pragma unroll
    for (int a = 0; a < 2; ++a)
#pragma unroll
        for (int b = 0; b < 2; ++b)
#pragma unroll
            for (int m = 0; m < 4; ++m)
#pragma unroll
                for (int n = 0; n < 2; ++n) acc[a][b][m][n] = (f32x4){0.f, 0.f, 0.f, 0.f};
    bf16x8 At[4][2], B0[2][2], B1[2][2];
    const char* cB = g.Bt + (size_t)cur.pn * btstep;
    {
        const char* cA0 = PG8_AP(cur.pm, 0); const char* cA1 = PG8_AP(cur.pm, 1);
        PG8_STAGE(PG8_SB(0, 0), cB, voffB); PG8_STAGE(PG8_SB(0, 1), cB + bhstep, voffB); PG8_STAGE(PG8_SA(0, 0), cA0, voffA); PG8_STAGE(PG8_SA(0, 1), cA0 + ahstep, voffA);
        if (wr == 1) PG8_BAR;
        PG8_WAIT_V(2); PG8_BAR;
        PG8_STAGE(PG8_SB(1, 0), cB + bkstep, voffB); PG8_STAGE(PG8_SA(1, 0), cA1, voffA); PG8_STAGE(PG8_SB(1, 1), cB + bhstep + bkstep, voffB);
        PG8_WAIT_V(6); PG8_BAR;
    }
    for (;;) {
        const bool has_next = S.next(ui + 1, nxt);
        const int npm = has_next ? nxt.pm : cur.pm;
        const char* nB = has_next ? g.Bt + (size_t)nxt.pn * btstep : cB;
#pragma unroll 1
        for (int t = 0; t < nt; t += 2) {
            const bool last = (t == nt - 2);
            if constexpr (Epi::HAS_MID) { if (t == tmid) E.mid(acc, cur, wr, wc, fr, fq); }
            const char* a1 = PG8_AP(cur.pm, t + 1);
            const char* a2 = last ? PG8_AP(npm, 0) : PG8_AP(cur.pm, t + 2);
            const char* a3 = last ? PG8_AP(npm, 1) : PG8_AP(cur.pm, t + 3);
            const char* b2 = last ? nB : cB + (size_t)(t + 2) * bkstep; const char* b3 = b2 + bkstep;
            PG8_LDB(B0, 0, 0); PG8_LDB(B1, 0, 1); PG8_SCHED; PG8_LDA(At, 0, 0); PG8_STAGE(PG8_SA(1, 1), a1 + ahstep, voffA);
            PG8_WAIT_V(8); PG8_WAIT_L(0); PG8_BAR; PG8_MMA(0, 0, At, B0); PG8_MMA(0, 1, At, B1); PG8_BAR; PG8_SCHED;
            PG8_LDA(At, 0, 1); PG8_STAGE(PG8_SB(0, 0), b2, voffB); PG8_STAGE(PG8_SB(0, 1), b2 + bhstep, voffB); PG8_STAGE(PG8_SA(0, 0), a2, voffA);
            PG8_WAIT_V(8); PG8_WAIT_L(0); PG8_BAR; PG8_MMA(1, 0, At, B0); PG8_MMA(1, 1, At, B1); PG8_BAR; PG8_SCHED;
            PG8_LDB(B0, 1, 0); PG8_LDB(B1, 1, 1); PG8_SCHED; PG8_LDA(At, 1, 0); PG8_STAGE(PG8_SA(0, 1), a2 + ahstep, voffA);
            PG8_WAIT_V(8); PG8_WAIT_L(0); PG8_BAR; PG8_MMA(0, 0, At, B0); PG8_MMA(0, 1, At, B1); PG8_BAR; PG8_SCHED;
            PG8_LDA(At, 1, 1); PG8_STAGE(PG8_SB(1, 0), b3, voffB); PG8_STAGE(PG8_SB(1, 1), b3 + bhstep, voffB); PG8_STAGE(PG8_SA(1, 0), a3, voffA);
            PG8_WAIT_V(8); PG8_WAIT_L(0); PG8_BAR; PG8_MMA(1, 0, At, B0); PG8_MMA(1, 1, At, B1); PG8_BAR; PG8_SCHED;
        }
        if (wr == 0) PG8_BAR;
        E(acc, cur, wr, wc, fr, fq);
        if (!has_next) break;
#pragma unroll
        for (int a = 0; a < 2; ++a)
#pragma unroll
            for (int b = 0; b < 2; ++b)
#pragma unroll
                for (int m = 0; m < 4; ++m)
#pragma unroll
                    for (int n = 0; n < 2; ++n) acc[a][b][m][n] = (f32x4){0.f, 0.f, 0.f, 0.f};
        cur = nxt; cB = nB; ++ui;
        if (wr == 1) PG8_BAR;
    }
    PG8_WAIT_V(0);
    PG8_BAR;
#undef PG8_AP
#undef PG8_SA
#undef PG8_SB
#undef PG8_STAGE
#undef PG8_LDA
#undef PG8_LDB
#undef PG8_MMA
#undef PG8_WAIT_V
#undef PG8_WAIT_L
#undef PG8_BAR
#undef PG8_SCHED
}

__device__ __forceinline__ unsigned cvt_pk_bf16(float lo, float hi) { unsigned r; asm volatile("v_cvt_pk_bf16_f32 %0, %1, %2" : "=v"(r) : "v"(lo), "v"(hi)); return r; }
__device__ __forceinline__ u32x4 pack8(const f32x4 a, const f32x4 b) { u32x4 w; w.x = cvt_pk_bf16(a[0], a[1]); w.y = cvt_pk_bf16(a[2], a[3]); w.z = cvt_pk_bf16(b[0], b[1]); w.w = cvt_pk_bf16(b[2], b[3]); return w; }
__device__ __forceinline__ void unpack8(const u32x4 w, f32x4& a, f32x4& b) { a = (f32x4){bf2f(w.x), bf2f(w.x >> 16), bf2f(w.y), bf2f(w.y >> 16)}; b = (f32x4){bf2f(w.z), bf2f(w.z >> 16), bf2f(w.w), bf2f(w.w >> 16)}; }
__device__ __forceinline__ f32x4 silu4(const f32x4 v) { return (f32x4){siluf_(v[0]), siluf_(v[1]), siluf_(v[2]), siluf_(v[3])}; }
__device__ __forceinline__ f32x4 sig4(const f32x4 v) { return (f32x4){sigmoidf_(v[0]), sigmoidf_(v[1]), sigmoidf_(v[2]), sigmoidf_(v[3])}; }
__device__ __forceinline__ float ssq4(const f32x4 v) { return (v[0] * v[0] + v[1] * v[1]) + (v[2] * v[2] + v[3] * v[3]); }
__device__ __forceinline__ void rope8(f32x4& a, f32x4& b, const f32x4 cs, const f32x4 sn) {
    const f32x4 a0 = a, b0 = b;
    a[0] = a0[0] * cs[0] - a0[1] * sn[0]; a[1] = a0[1] * cs[0] + a0[0] * sn[0]; a[2] = a0[2] * cs[1] - a0[3] * sn[1]; a[3] = a0[3] * cs[1] + a0[2] * sn[1];
    b[0] = b0[0] * cs[2] - b0[1] * sn[2]; b[1] = b0[1] * cs[2] + b0[0] * sn[2]; b[2] = b0[2] * cs[3] - b0[3] * sn[3]; b[3] = b0[3] * cs[3] + b0[2] * sn[3];
}
#define EPI_ROWS(...) _Pragma("unroll") for (int ai = 0; ai < 2; ++ai) _Pragma("unroll") for (int m = 0; m < 4; ++m) { const int row = u.pm * BM + ai * HALF + wr * 64 + m * 16 + fr; __VA_ARGS__ if (m & 1) asm volatile("" ::: "memory"); }

struct EpiG1a {
    static constexpr bool HAS_MID = false;
    bf16_t *US, *TM, *QL, *KL, *KR; float *SQ, *SKV; const float* rope;
    __device__ __forceinline__ void operator()(const Acc& acc, const Unit& u, int wr, int wc, int fr, int fq) const {
        const int pn = u.pn, cw = wc * 32 + 8 * fq;
        if (pn < 4) { EPI_ROWS(
            _Pragma("unroll") for (int bj = 0; bj < 2; ++bj) { const int c = pn * 256 + bj * 128 + cw;
                *(u32x4*)(US + ((size_t)(c >> 4) * NT + row) * 16 + (c & 15)) = pack8(acc[ai][bj][m][0], acc[ai][bj][m][1]); } ) }
        else if (pn < 8) { EPI_ROWS(
            _Pragma("unroll") for (int bj = 0; bj < 2; ++bj) { const int c = (pn - 4) * 256 + bj * 128 + cw;
                *(u32x4*)(TM + (size_t)row * 1024 + c) = pack8(silu4(acc[ai][bj][m][0]), silu4(acc[ai][bj][m][1])); } ) }
        else if (pn < 10) { bf16_t* dst = pn == 8 ? QL : KL; float* sp = pn == 8 ? SQ : SKV;
            EPI_ROWS( float s = 0.f;
            _Pragma("unroll") for (int bj = 0; bj < 2; ++bj) { const int c = bj * 128 + cw; s += ssq4(acc[ai][bj][m][0]) + ssq4(acc[ai][bj][m][1]);
                *(u32x4*)(dst + (size_t)row * 256 + c) = pack8(acc[ai][bj][m][0], acc[ai][bj][m][1]); }
            s += __shfl_xor(s, 16); s += __shfl_xor(s, 32); if (fq == 0) sp[(size_t)row * 4 + wc] = s; ) }
        else if (wc == 0) {
#pragma unroll
            for (int ai = 0; ai < 2; ++ai) {
                f32x4 csv[4], snv[4];
#pragma unroll
                for (int m = 0; m < 4; ++m) { const int row = u.pm * BM + ai * HALF + wr * 64 + m * 16 + fr; csv[m] = *(const f32x4*)(rope + (size_t)row * 32 + 4 * fq); snv[m] = *(const f32x4*)(rope + (size_t)row * 32 + 16 + 4 * fq); }
#pragma unroll
                for (int m = 0; m < 4; ++m) { const int row = u.pm * BM + ai * HALF + wr * 64 + m * 16 + fr;
                    f32x4 a = acc[ai][0][m][0], b = acc[ai][0][m][1]; rope8(a, b, csv[m], snv[m]);
                    *(u32x4*)(KR + (size_t)row * 32 + 8 * fq) = pack8(a, b); }
                asm volatile("" ::: "memory");
            } }
    }
};
struct EpiG2q {
    static constexpr bool HAS_MID = false;
    bf16_t *QN, *QR; const float* SQ; const float* rope;
    __device__ __forceinline__ void operator()(const Acc& acc, const Unit& u, int wr, int wc, int fr, int fq) const {
        const int pn = u.pn, cw = wc * 32 + 8 * fq;
        float rsv[2][4];
        EPI_ROWS( const f32x4 sp = *(const f32x4*)(SQ + (size_t)row * 4); rsv[ai][m] = QSCALE / sqrtf(((sp[0] + sp[1]) + (sp[2] + sp[3])) * (1.f / 256.f) + EPS); )
        if (pn < 4) { EPI_ROWS( const float rs = rsv[ai][m];
                _Pragma("unroll") for (int bj = 0; bj < 2; ++bj) { const int c = pn * 256 + bj * 128 + cw; *(u32x4*)(QN + (size_t)row * 1024 + c) = pack8(acc[ai][bj][m][0] * rs, acc[ai][bj][m][1] * rs); } )
        } else {
#pragma unroll
            for (int ai = 0; ai < 2; ++ai) {
                f32x4 csv[4], snv[4];
#pragma unroll
                for (int m = 0; m < 4; ++m) { const int row = u.pm * BM + ai * HALF + wr * 64 + m * 16 + fr; csv[m] = *(const f32x4*)(rope + (size_t)row * 32 + 4 * fq); snv[m] = *(const f32x4*)(rope + (size_t)row * 32 + 16 + 4 * fq); }
#pragma unroll
                for (int m = 0; m < 4; ++m) { const int row = u.pm * BM + ai * HALF + wr * 64 + m * 16 + fr; const float rs = rsv[ai][m];
#pragma unroll
                    for (int bj = 0; bj < 2; ++bj) { const int c = (pn - 4) * 256 + bj * 128 + cw; f32x4 a = acc[ai][bj][m][0] * rs, b = acc[ai][bj][m][1] * rs; rope8(a, b, csv[m], snv[m]);
                        *(u32x4*)(QR + (size_t)row * 512 + c) = pack8(a, b); } }
                asm volatile("" ::: "memory");
            } }
    }
};
struct EpiG2kv {
    static constexpr bool HAS_MID = false;
    bf16_t *KN, *VV; const float* SKV;
    __device__ __forceinline__ void operator()(const Acc& acc, const Unit& u, int wr, int wc, int fr, int fq) const {
        const int pn = u.pn, cw = wc * 32 + 8 * fq; bf16_t* dst = pn < 4 ? KN : VV;
        float rsv[2][4];
        EPI_ROWS( const f32x4 sp = *(const f32x4*)(SKV + (size_t)row * 4); rsv[ai][m] = 1.f / sqrtf(((sp[0] + sp[1]) + (sp[2] + sp[3])) * (1.f / 256.f) + EPS); )
        EPI_ROWS( const float rs = rsv[ai][m];
            _Pragma("unroll") for (int bj = 0; bj < 2; ++bj) { const int c = (pn & 3) * 256 + bj * 128 + cw; *(u32x4*)(dst + (size_t)row * 1024 + c) = pack8(acc[ai][bj][m][0] * rs, acc[ai][bj][m][1] * rs); } )
    }
};
struct EpiZs {
    static constexpr bool HAS_MID = false;
    bf16_t* ZS;
    __device__ __forceinline__ void operator()(const Acc& acc, const Unit& u, int wr, int wc, int fr, int fq) const {
        const int cw = wc * 32 + 8 * fq;
        EPI_ROWS( _Pragma("unroll") for (int bj = 0; bj < 2; ++bj) { const int c = u.pn * 256 + bj * 128 + cw; *(u32x4*)(ZS + (size_t)row * 1024 + c) = pack8(silu4(acc[ai][bj][m][0]), silu4(acc[ai][bj][m][1])); } )
    }
};
struct EpiGlu {
    static constexpr bool HAS_MID = false;
    bf16_t* TS; const bf16_t* ZS; const float* bias;
    __device__ __forceinline__ void operator()(const Acc& acc, const Unit& u, int wr, int wc, int fr, int fq) const {
        const int jj = u.pn * 128 + wc * 32 + 8 * fq;
        const f32x4 ba0 = *(const f32x4*)(bias + jj), ba1 = *(const f32x4*)(bias + jj + 4), bb0 = *(const f32x4*)(bias + 1024 + jj), bb1 = *(const f32x4*)(bias + 1024 + jj + 4);
        u32x4 zr[2][4];
#pragma unroll
        for (int ai = 0; ai < 2; ++ai)
#pragma unroll
            for (int m = 0; m < 4; ++m) zr[ai][m] = *(const u32x4*)(ZS + (size_t)(u.pm * BM + ai * HALF + wr * 64 + m * 16 + fr) * 1024 + jj);
        EPI_ROWS( f32x4 z0, z1; unpack8(zr[ai][m], z0, z1);
            const f32x4 o0 = (acc[ai][0][m][0] + ba0) * sig4(acc[ai][1][m][0] + bb0) * z0, o1 = (acc[ai][0][m][1] + ba1) * sig4(acc[ai][1][m][1] + bb1) * z1;
            *(u32x4*)(TS + (size_t)row * 1024 + jj) = pack8(o0, o1); )
    }
};
struct EpiGate {
    static constexpr bool HAS_MID = false;
    bf16_t *RAT, *SGM;
    __device__ __forceinline__ void operator()(const Acc& acc, const Unit& u, int wr, int wc, int fr, int fq) const {
        const int jj = u.pn * 128 + wc * 32 + 8 * fq;
        EPI_ROWS( const f32x4 s0 = sig4(acc[ai][0][m][0]), s1 = sig4(acc[ai][0][m][1]), m0 = sig4(acc[ai][1][m][0]), m1 = sig4(acc[ai][1][m][1]);
            *(u32x4*)(RAT + (size_t)row * 1024 + jj) = pack8(s0 / m0, s1 / m1); *(u32x4*)(SGM + (size_t)row * 1024 + jj) = pack8(m0, m1); )
    }
};
struct EpiMerge {
    static constexpr bool HAS_MID = true;
    const bf16_t *RAT, *SGM; bf16_t* MG;
    __device__ __forceinline__ void mid(Acc& acc, const Unit& u, int wr, int wc, int fr, int fq) const {
        const int cw = wc * 32 + 8 * fq;
#pragma unroll
        for (int ai = 0; ai < 2; ++ai) {
            u32x4 r[4][2];
#pragma unroll
            for (int m = 0; m < 4; ++m) { const int row = u.pm * BM + ai * HALF + wr * 64 + m * 16 + fr;
#pragma unroll
                for (int bj = 0; bj < 2; ++bj) r[m][bj] = *(const u32x4*)(RAT + (size_t)row * 1024 + u.pn * 256 + bj * 128 + cw); }
#pragma unroll
            for (int m = 0; m < 4; ++m)
#pragma unroll
                for (int bj = 0; bj < 2; ++bj) { f32x4 a, b; unpack8(r[m][bj], a, b); acc[ai][bj][m][0] *= a; acc[ai][bj][m][1] *= b; }
        }
        asm volatile("s_waitcnt vmcnt(0)" ::: "memory");
    }
    __device__ __forceinline__ void operator()(const Acc& acc, const Unit& u, int wr, int wc, int fr, int fq) const {
        const int cw = wc * 32 + 8 * fq;
#pragma unroll
        for (int ai = 0; ai < 2; ++ai) {
            u32x4 g[4][2];
#pragma unroll
            for (int m = 0; m < 4; ++m) { const int row = u.pm * BM + ai * HALF + wr * 64 + m * 16 + fr;
#pragma unroll
                for (int bj = 0; bj < 2; ++bj) g[m][bj] = *(const u32x4*)(SGM + (size_t)row * 1024 + u.pn * 256 + bj * 128 + cw); }
#pragma unroll
            for (int m = 0; m < 4; ++m) { const int row = u.pm * BM + ai * HALF + wr * 64 + m * 16 + fr;
#pragma unroll
                for (int bj = 0; bj < 2; ++bj) { f32x4 a, b; unpack8(g[m][bj], a, b);
                    *(u32x4*)(MG + (size_t)row * 1024 + u.pn * 256 + bj * 128 + cw) = pack8(acc[ai][bj][m][0] * a, acc[ai][bj][m][1] * b); } }
            asm volatile("" ::: "memory");
        }
    }
};
struct EpiOut {
    static constexpr bool HAS_MID = false;
    bf16_t* OUTB; float* SO;
    __device__ __forceinline__ void operator()(const Acc& acc, const Unit& u, int wr, int wc, int fr, int fq) const {
        const int cw = wc * 32 + 8 * fq;
        EPI_ROWS( float s = 0.f;
            _Pragma("unroll") for (int bj = 0; bj < 2; ++bj) { const int c = u.pn * 256 + bj * 128 + cw; s += ssq4(acc[ai][bj][m][0]) + ssq4(acc[ai][bj][m][1]);
                *(u32x4*)(OUTB + (size_t)row * 1024 + c) = pack8(acc[ai][bj][m][0], acc[ai][bj][m][1]); }
            s += __shfl_xor(s, 16); s += __shfl_xor(s, 32); if (fq == 0) SO[(size_t)row * 16 + u.pn * 4 + wc] = s; )
    }
};
}

template <class MAP>
__device__ __forceinline__ void tr_item(const float* W, int ldw, const MAP& map, const float* kscale, bf16_t* dst, int dpitch, int koff, int nblk, float* scr, int item, int lane) {
    const int kb = item / nblk, nb = item % nblk, k0 = 64 * kb, n0 = 32 * nb;
    const int src = map(n0 + (lane & 31));
#pragma unroll 8
    for (int i = 0; i < 32; ++i) { const int kk = 2 * i + (lane >> 5); float v = (src >= 0) ? W[(size_t)(k0 + kk) * ldw + src] : 0.f; if (kscale) v *= kscale[k0 + kk]; scr[kk * 33 + (lane & 31)] = v; }
    asm volatile("s_waitcnt lgkmcnt(0)" ::: "memory");
    const int c = lane & 7;
#pragma unroll
    for (int j = 0; j < 4; ++j) { const int n = (lane >> 3) + 8 * j; const float* sc = scr + (8 * c) * 33 + n;
        u32x4 o; o.x = pk2(sc[0 * 33], sc[1 * 33]); o.y = pk2(sc[2 * 33], sc[3 * 33]); o.z = pk2(sc[4 * 33], sc[5 * 33]); o.w = pk2(sc[6 * 33], sc[7 * 33]);
        *(u32x4*)(dst + (size_t)(n0 + n) * dpitch + koff + k0 + 8 * c) = o; }
    asm volatile("s_waitcnt lgkmcnt(0)" ::: "memory");
}
struct MapG1a { __device__ __forceinline__ int operator()(int j) const { if (j < 1024) return C_US + j; if (j < 2048) return C_ZM + (j - 1024); if (j < 2304) return C_QL + (j - 2048); if (j < 2560) return C_KL + (j - 2304);
    if (j < 2592) { const int p = j - 2560; return C_KR + ((p & 1) ? 16 + (p >> 1) : (p >> 1)); } return -1; } };
struct MapOff { int off; __device__ __forceinline__ int operator()(int j) const { return off + j; } };
struct MapPair { int offa, offb; __device__ __forceinline__ int operator()(int j) const { const int pn = j >> 8, w = j & 255, jj = pn * 128 + (w & 127); return offa + (w >> 7) * (offb - offa) + jj; } };
struct MapQ { __device__ __forceinline__ int operator()(int j) const { if (j < 1024) return (j >> 6) * 96 + (j & 63); const int jj = j - 1024, h = jj >> 5, p = jj & 31; return h * 96 + 64 + ((p & 1) ? 16 + (p >> 1) : (p >> 1)); } };
struct MapKV { __device__ __forceinline__ int operator()(int j) const { return (j < 1024) ? (j >> 6) * 128 + (j & 63) : ((j - 1024) >> 6) * 128 + 64 + (j & 63); } };

__device__ __forceinline__ void prep_weights(const Args& a, float* lds, int early, int wslot, int nslots) {
    const int tid = opq(threadIdx.x), lane = tid & 63, wv = tid >> 6;
    float* scr = lds + wv * (64 * 33);
    const int gw = wslot * 8 + wv, ngw = nslots * 8;
    unsigned char* ws = a.ws;
    constexpr int I0 = 16 * 88, I1 = 16 * 32, I2 = 16 * 64, I3 = 16 * 64, I4 = 4 * 48, I5 = 4 * 64, I6 = 16 * 32, I7 = 16 * 32, I8 = 16 * 32;
    if (early) {
        for (int it = gw; it < I0 + I4 + I5; it += ngw) {
            int r = it;
            if (r < I0) { tr_item(a.in[6], INW, MapG1a{}, nullptr, (bf16_t*)(ws + WS_WINA), 1024, 0, 88, scr, r, lane); continue; } r -= I0;
            if (r < I4) { tr_item(a.in[18], 1536, MapQ{}, a.in[17], (bf16_t*)(ws + WS_WQ), 256, 0, 48, scr, r, lane); continue; } r -= I4;
            tr_item(a.in[20], 2048, MapKV{}, a.in[19], (bf16_t*)(ws + WS_WKV), 256, 0, 64, scr, r, lane);
        }
    } else {
        for (int it = gw; it < I1 + I2 + I3 + I6 + I7 + I8; it += ngw) {
            int r = it;
            if (r < I1) { tr_item(a.in[6], INW, MapOff{C_ZS}, nullptr, (bf16_t*)(ws + WS_WZS), 1024, 0, 32, scr, r, lane); continue; } r -= I1;
            if (r < I2) { tr_item(a.in[6], INW, MapPair{C_GS, C_GM}, nullptr, (bf16_t*)(ws + WS_WGATE), 1024, 0, 64, scr, r, lane); continue; } r -= I2;
            if (r < I3) { tr_item(a.in[15], 2048, MapPair{0, 1024}, nullptr, (bf16_t*)(ws + WS_WGLU), 1024, 0, 64, scr, r, lane); continue; } r -= I3;
            if (r < I6) { tr_item(a.in[21], 1024, MapOff{0}, nullptr, (bf16_t*)(ws + WS_WBR), 2048, 0, 32, scr, r, lane); continue; } r -= I6;
            if (r < I7) { tr_item(a.in[22], 1024, MapOff{0}, nullptr, (bf16_t*)(ws + WS_WBR), 2048, 1024, 32, scr, r, lane); continue; } r -= I7;
            tr_item(a.in[23], 1024, MapOff{0}, nullptr, (bf16_t*)(ws + WS_WOUT), 1024, 0, 32, scr, r, lane);
        }
    }
}

namespace att {
#define ATT_LAS __attribute__((address_space(3)))
typedef ATT_LAS unsigned char ATT_LAS_T;
typedef short bf16x8 __attribute__((ext_vector_type(8)));
typedef short s16x4 __attribute__((ext_vector_type(4)));
typedef float f32x16 __attribute__((ext_vector_type(16)));
constexpr int KT = 12288, VT = 8192, BUFB = KT + VT, NRING = 4, WSF_OFF = NRING * BUFB;
constexpr float THR = 8.f;
__device__ __forceinline__ int crow(int r, int hi) { return (r & 3) + 8 * (r >> 2) + 4 * hi; }
typedef float f32x2_t __attribute__((ext_vector_type(2))); typedef __bf16 bf16x2_t __attribute__((ext_vector_type(2)));
__device__ __forceinline__ unsigned cvtpk(float lo, float hi) { f32x2_t v = {lo, hi}; bf16x2_t b = __builtin_convertvector(v, bf16x2_t); return __builtin_bit_cast(unsigned, b); }
#define ATT_SCHED_MAIN() do {} while (0)
__device__ __forceinline__ s16x4 vtr(ATT_LAS const unsigned char* p) { return __builtin_bit_cast(s16x4, __builtin_amdgcn_ds_read_tr16_b64_v4i16((ATT_LAS s16x4*)p)); }

__device__ __forceinline__ float max3f(float a, float b, float c) { return fmaxf(fmaxf(a, b), c); }
__device__ __forceinline__ void glds16(const void* gsrc, unsigned lds_dst) { unsigned keep;
    asm volatile("s_mov_b32 %0, m0\n\ts_mov_b32 m0, %2\n\ts_nop 0\n\tglobal_load_lds_dwordx4 %1, off\n\ts_mov_b32 m0, %0" : "=&s"(keep) : "v"(gsrc), "s"(lds_dst) : "memory"); }
__device__ __forceinline__ void attn_unit(int b, int h, int qb, const bf16_t* QN, const bf16_t* QR, const bf16_t* KN, const bf16_t* KR, const bf16_t* VV, bf16_t* TM, ATT_LAS unsigned char* lds, int do_store) {
    const int tid = opq(threadIdx.x), lane = tid & 63, r32 = lane & 31, hi = lane >> 5, wid = __builtin_amdgcn_readfirstlane(tid >> 6);
    const size_t rowbase = (size_t)b * SEQ; const int q0 = qb * 256;
    const size_t tokq = rowbase + q0 + wid * 32 + r32;
    bf16x8 qf[6];
#pragma unroll
    for (int d0 = 0; d0 < 4; ++d0) qf[d0] = *(const bf16x8*)(QN + tokq * 1024 + h * 64 + d0 * 16 + hi * 8);
#pragma unroll
    for (int d0 = 0; d0 < 2; ++d0) qf[4 + d0] = *(const bf16x8*)(QR + tokq * 512 + h * 32 + d0 * 16 + hi * 8);
    const bf16_t* ksrc = KN + (rowbase + lane) * 1024 + h * 64 + wid * 8;
    const bf16_t* rsrc = KR + (rowbase + lane) * 32 + (wid & 3) * 8;
    const bf16_t* vsrc = VV + (rowbase + 16 * (wid & 3) + (lane >> 2)) * 1024 + h * 64 + (wid >> 2) * 32 + (lane & 3) * 8;
    ATT_LAS float* wsf = (ATT_LAS float*)(lds + WSF_OFF) + wid * 64;
    constexpr int VOFF = NRING * KT;
    const unsigned lds0 = (unsigned)(size_t)lds;
#define ATT_DMAK(t, kb) do { \
        glds16(ksrc + (size_t)(t) * 64 * 1024, (unsigned)__builtin_amdgcn_readfirstlane(lds0 + (kb) * KT + wid * 1024)); \
        glds16(rsrc + (size_t)(t) * 64 * 32, (unsigned)__builtin_amdgcn_readfirstlane(lds0 + (kb) * KT + (8 + (wid & 3)) * 1024)); } while (0)
#define ATT_DMAV(t, vb) glds16(vsrc + (size_t)(t) * 64 * 1024, (unsigned)__builtin_amdgcn_readfirstlane(lds0 + VOFF + (vb) * VT + wid * 1024))
    const int nT = 4 * qb + 4, mychunk = 4 * qb + (wid >> 1);
    float mref = 0.f;
    f32x16 o0, o1, o2;
#pragma unroll
    for (int r = 0; r < 16; ++r) { o0[r] = 0.f; o1[r] = 0.f; o2[r] = 0.f; }
    const bf16x8 ones = {0x3f80, 0x3f80, 0x3f80, 0x3f80, 0x3f80, 0x3f80, 0x3f80, 0x3f80};
    const int kfo = hi * 1024 + r32 * 16;
    const int vfo = ((lane >> 4) & 1) * 32 + (lane & 3) * 8 + (4 * hi + ((lane & 15) >> 2)) * 64;
#define ATT_KLOAD(kb) do { ATT_LAS const unsigned char* Kb_ = lds + (kb) * KT + kfo; \
        _Pragma("unroll") for (int d0 = 0; d0 < 6; ++d0) { kf[2 * d0] = *(ATT_LAS const bf16x8*)(Kb_ + d0 * 2048); kf[2 * d0 + 1] = *(ATT_LAS const bf16x8*)(Kb_ + d0 * 2048 + 512); } } while (0)
#define ATT_QKM(P0, P1, cinit) do { \
        _Pragma("unroll") for (int r = 0; r < 16; ++r) { P0[r] = (cinit); P1[r] = (cinit); } \
        _Pragma("unroll") for (int d0 = 0; d0 < 6; ++d0) { \
            P0 = __builtin_amdgcn_mfma_f32_32x32x16_bf16(kf[2 * d0], qf[d0], P0, 0, 0, 0); P1 = __builtin_amdgcn_mfma_f32_32x32x16_bf16(kf[2 * d0 + 1], qf[d0], P1, 0, 0, 0); } } while (0)
#define ATT_MAXR(C0, C1, t) do { \
        float ra = max3f(C0[0], C0[1], C1[0]), rb = max3f(C0[2], C0[3], C1[1]); ra = max3f(ra, C1[2], C1[3]); \
        _Pragma("unroll") for (int r = 4; r < 16; r += 4) { ra = max3f(ra, C0[r], C0[r + 1]); rb = max3f(rb, C0[r + 2], C0[r + 3]); ra = max3f(ra, C1[r], C1[r + 1]); rb = max3f(rb, C1[r + 2], C1[r + 3]); } \
        float rm = fmaxf(ra, rb); { auto rr_ = __builtin_amdgcn_permlane32_swap(__float_as_uint(rm), __float_as_uint(rm), false, false); rm = fmaxf(__uint_as_float(rr_[0]), __uint_as_float(rr_[1])); } \
        if ((t) == 0 || __any(rm > THR)) { \
            const float dl = ((t) == 0) ? rm : fmaxf(rm, 0.f); mref += dl; \
            _Pragma("unroll") for (int r = 0; r < 16; ++r) { C0[r] -= dl; C1[r] -= dl; } \
            if ((t) != 0) { const float f = __builtin_amdgcn_exp2f(-dl); if (hi == 0) wsf[r32] = f; asm volatile("s_waitcnt lgkmcnt(0)" ::: "memory"); \
                _Pragma("unroll") for (int r = 0; r < 16; ++r) { const float fr_ = wsf[crow(r, hi)]; o0[r] *= fr_; o1[r] *= fr_; o2[r] *= fr_; } \
                asm volatile("s_waitcnt lgkmcnt(0)" ::: "memory"); } } } while (0)
#define ATT_EXPV(C0, C1, vb) \
        float ps0 = 0.f, ps1 = 0.f; \
        _Pragma("unroll") for (int r = 0; r < 16; ++r) { C0[r] = __builtin_amdgcn_exp2f(C0[r]); C1[r] = __builtin_amdgcn_exp2f(C1[r]); ps0 += C0[r]; ps1 += C1[r]; } \
        lsum += ps0 + ps1; \
        bf16x8 pa[4]; \
        _Pragma("unroll") for (int s_ = 0; s_ < 2; ++s_) { u32x4 w0, w1; \
            w0.x = cvtpk(C0[8 * s_ + 0], C0[8 * s_ + 1]); w0.y = cvtpk(C0[8 * s_ + 2], C0[8 * s_ + 3]); w0.z = cvtpk(C0[8 * s_ + 4], C0[8 * s_ + 5]); w0.w = cvtpk(C0[8 * s_ + 6], C0[8 * s_ + 7]); \
            w1.x = cvtpk(C1[8 * s_ + 0], C1[8 * s_ + 1]); w1.y = cvtpk(C1[8 * s_ + 2], C1[8 * s_ + 3]); w1.z = cvtpk(C1[8 * s_ + 4], C1[8 * s_ + 5]); w1.w = cvtpk(C1[8 * s_ + 6], C1[8 * s_ + 7]); \
            pa[s_] = __builtin_bit_cast(bf16x8, w0); pa[2 + s_] = __builtin_bit_cast(bf16x8, w1); } \
        ATT_LAS const unsigned char* Vb_ = lds + VOFF + (vb) * VT + vfo; \
        s16x4 vl_[8], vh_[8]; \
        _Pragma("unroll") for (int s_ = 0; s_ < 4; ++s_) { vl_[2 * s_] = vtr(Vb_ + s_ * 1024); vh_[2 * s_] = vtr(Vb_ + s_ * 1024 + 512); vl_[2 * s_ + 1] = vtr(Vb_ + 4096 + s_ * 1024); vh_[2 * s_ + 1] = vtr(Vb_ + 4096 + s_ * 1024 + 512); }
#define ATT_PVM() \
        _Pragma("unroll") for (int s_ = 0; s_ < 4; ++s_) { \
            const bf16x8 v0 = (bf16x8){vl_[2 * s_][0], vl_[2 * s_][1], vl_[2 * s_][2], vl_[2 * s_][3], vh_[2 * s_][0], vh_[2 * s_][1], vh_[2 * s_][2], vh_[2 * s_][3]}; \
            const bf16x8 v1 = (bf16x8){vl_[2 * s_ + 1][0], vl_[2 * s_ + 1][1], vl_[2 * s_ + 1][2], vl_[2 * s_ + 1][3], vh_[2 * s_ + 1][0], vh_[2 * s_ + 1][1], vh_[2 * s_ + 1][2], vh_[2 * s_ + 1][3]}; \
            o0 = __builtin_amdgcn_mfma_f32_32x32x16_bf16(pa[s_], v0, o0, 0, 0, 0); o1 = __builtin_amdgcn_mfma_f32_32x32x16_bf16(pa[s_], v1, o1, 0, 0, 0); }
#define ATT_WAITV(n) asm volatile("s_waitcnt vmcnt(" #n ")" ::: "memory")
#define ATT_BAR() do { asm volatile("s_waitcnt lgkmcnt(0)" ::: "memory"); __builtin_amdgcn_s_barrier(); } while (0)
#define SB_() __builtin_amdgcn_sched_barrier(0)
#define KL_(d0) do { kf[2 * (d0)] = *(ATT_LAS const bf16x8*)(Kn_ + (d0) * 2048); kf[2 * (d0) + 1] = *(ATT_LAS const bf16x8*)(Kn_ + (d0) * 2048 + 512); } while (0)
#define VL_(s_) do { vl_[2 * (s_)] = vtr(Vc_ + (s_) * 1024); vh_[2 * (s_)] = vtr(Vc_ + (s_) * 1024 + 512); vl_[2 * (s_) + 1] = vtr(Vc_ + 4096 + (s_) * 1024); vh_[2 * (s_) + 1] = vtr(Vc_ + 4096 + (s_) * 1024 + 512); } while (0)
#define VF_(i) (bf16x8){vl_[i][0], vl_[i][1], vl_[i][2], vl_[i][3], vh_[i][0], vh_[i][1], vh_[i][2], vh_[i][3]}
#define EX4_(C, b_) do { C[b_] = __builtin_amdgcn_exp2f(C[b_]); C[(b_) + 1] = __builtin_amdgcn_exp2f(C[(b_) + 1]); C[(b_) + 2] = __builtin_amdgcn_exp2f(C[(b_) + 2]); C[(b_) + 3] = __builtin_amdgcn_exp2f(C[(b_) + 3]); } while (0)
#define SUM4_(acc_, C, b_) do { acc_ += (C[b_] + C[(b_) + 1]) + (C[(b_) + 2] + C[(b_) + 3]); } while (0)
#define PK8_(C, b_) __builtin_bit_cast(bf16x8, (u32x4){cvtpk(C[b_], C[(b_) + 1]), cvtpk(C[(b_) + 2], C[(b_) + 3]), cvtpk(C[(b_) + 4], C[(b_) + 5]), cvtpk(C[(b_) + 6], C[(b_) + 7])})
#define QM0_(P, d0) P = __builtin_amdgcn_mfma_f32_32x32x16_bf16(kf[2 * (d0)], qf[d0], P, 0, 0, 0)
#define QM1_(P, d0) P = __builtin_amdgcn_mfma_f32_32x32x16_bf16(kf[2 * (d0) + 1], qf[d0], P, 0, 0, 0)
#define ATT_STEP(CUR0, CUR1, NXT0, NXT1, t) do { \
        if ((t) + 4 < nT) ATT_DMAK((t) + 4, (t) & 3); \
        if ((t) + 3 < nT) ATT_DMAV((t) + 3, ((t) + 3) & 3); \
        const bool nv_ = ((t) + 1 <= mychunk) && ((t) + 1 < nT); \
        if ((t) <= mychunk) { \
            ATT_LAS const unsigned char* Kn_ = lds + (((t) + 1) & 3) * KT + kfo; ATT_LAS const unsigned char* Vc_ = lds + VOFF + ((t) & 3) * VT + vfo; \
            s16x4 vl_[8], vh_[8]; bf16x8 pa0_, pa1_, pa2_, pa3_; \
            if (nv_) { KL_(0); KL_(1); KL_(2); } \
            ATT_MAXR(CUR0, CUR1, t); \
            if (nv_) { \
                SB_(); \
                _Pragma("unroll") for (int r = 0; r < 16; ++r) { NXT0[r] = -mref; NXT1[r] = -mref; } \
                SB_(); \
                QM0_(NXT0, 0); EX4_(CUR0, 0); SB_(); \
                QM1_(NXT1, 0); KL_(3); EX4_(CUR0, 4); SB_(); \
                QM0_(NXT0, 1); EX4_(CUR0, 8); SB_(); \
                QM1_(NXT1, 1); KL_(4); EX4_(CUR0, 12); pa0_ = PK8_(CUR0, 0); SB_(); \
                QM0_(NXT0, 2); EX4_(CUR1, 0); SB_(); \
                QM1_(NXT1, 2); KL_(5); EX4_(CUR1, 4); pa1_ = PK8_(CUR0, 8); SB_(); \
                QM0_(NXT0, 3); EX4_(CUR1, 8); SB_(); \
                QM1_(NXT1, 3); EX4_(CUR1, 12); SB_(); \
                QM0_(NXT0, 4); pa2_ = PK8_(CUR1, 0); SB_(); \
                QM1_(NXT1, 4); VL_(0); SB_(); \
                QM0_(NXT0, 5); pa3_ = PK8_(CUR1, 8); SB_(); \
                QM1_(NXT1, 5); VL_(1); SB_(); \
                o0 = __builtin_amdgcn_mfma_f32_32x32x16_bf16(pa0_, VF_(0), o0, 0, 0, 0); SB_(); \
                o1 = __builtin_amdgcn_mfma_f32_32x32x16_bf16(pa0_, VF_(1), o1, 0, 0, 0); VL_(2); SB_(); \
                o2 = __builtin_amdgcn_mfma_f32_32x32x16_bf16(pa0_, ones, o2, 0, 0, 0); SB_(); \
                o0 = __builtin_amdgcn_mfma_f32_32x32x16_bf16(pa1_, VF_(2), o0, 0, 0, 0); SB_(); \
                o1 = __builtin_amdgcn_mfma_f32_32x32x16_bf16(pa1_, VF_(3), o1, 0, 0, 0); VL_(3); SB_(); \
                o2 = __builtin_amdgcn_mfma_f32_32x32x16_bf16(pa1_, ones, o2, 0, 0, 0); SB_(); \
                o0 = __builtin_amdgcn_mfma_f32_32x32x16_bf16(pa2_, VF_(4), o0, 0, 0, 0); SB_(); \
                o1 = __builtin_amdgcn_mfma_f32_32x32x16_bf16(pa2_, VF_(5), o1, 0, 0, 0); SB_(); \
                o2 = __builtin_amdgcn_mfma_f32_32x32x16_bf16(pa2_, ones, o2, 0, 0, 0); SB_(); \
                o0 = __builtin_amdgcn_mfma_f32_32x32x16_bf16(pa3_, VF_(6), o0, 0, 0, 0); SB_(); \
                o1 = __builtin_amdgcn_mfma_f32_32x32x16_bf16(pa3_, VF_(7), o1, 0, 0, 0); SB_(); \
                o2 = __builtin_amdgcn_mfma_f32_32x32x16_bf16(pa3_, ones, o2, 0, 0, 0); SB_(); \
            } else { \
                VL_(0); VL_(1); VL_(2); VL_(3); \
                _Pragma("unroll") for (int r = 0; r < 16; r += 4) { EX4_(CUR0, r); EX4_(CUR1, r); } \
                pa0_ = PK8_(CUR0, 0); pa1_ = PK8_(CUR0, 8); pa2_ = PK8_(CUR1, 0); pa3_ = PK8_(CUR1, 8); \
                o0 = __builtin_amdgcn_mfma_f32_32x32x16_bf16(pa0_, VF_(0), o0, 0, 0, 0); o1 = __builtin_amdgcn_mfma_f32_32x32x16_bf16(pa0_, VF_(1), o1, 0, 0, 0); o2 = __builtin_amdgcn_mfma_f32_32x32x16_bf16(pa0_, ones, o2, 0, 0, 0); \
                o0 = __builtin_amdgcn_mfma_f32_32x32x16_bf16(pa1_, VF_(2), o0, 0, 0, 0); o1 = __builtin_amdgcn_mfma_f32_32x32x16_bf16(pa1_, VF_(3), o1, 0, 0, 0); o2 = __builtin_amdgcn_mfma_f32_32x32x16_bf16(pa1_, ones, o2, 0, 0, 0); \
                o0 = __builtin_amdgcn_mfma_f32_32x32x16_bf16(pa2_, VF_(4), o0, 0, 0, 0); o1 = __builtin_amdgcn_mfma_f32_32x32x16_bf16(pa2_, VF_(5), o1, 0, 0, 0); o2 = __builtin_amdgcn_mfma_f32_32x32x16_bf16(pa2_, ones, o2, 0, 0, 0); \
                o0 = __builtin_amdgcn_mfma_f32_32x32x16_bf16(pa3_, VF_(6), o0, 0, 0, 0); o1 = __builtin_amdgcn_mfma_f32_32x32x16_bf16(pa3_, VF_(7), o1, 0, 0, 0); o2 = __builtin_amdgcn_mfma_f32_32x32x16_bf16(pa3_, ones, o2, 0, 0, 0); \
            } \
        } \
        if ((t) + 4 < nT) ATT_WAITV(6); else if ((t) + 4 == nT) ATT_WAITV(4); else if ((t) + 3 == nT) ATT_WAITV(1); else ATT_WAITV(0); \
        ATT_BAR(); } while (0)
    bf16x8 kf[12];
    f32x16 pA0, pA1, pB0, pB1;
    ATT_DMAK(0, 0); ATT_DMAV(0, 0); ATT_DMAK(1, 1);
    ATT_WAITV(0); ATT_BAR();
    ATT_DMAK(2, 2); ATT_DMAV(1, 1); ATT_DMAK(3, 3); ATT_DMAV(2, 2);
    ATT_KLOAD(0); ATT_QKM(pA0, pA1, 0.f);
    ATT_BAR();
#pragma unroll 1
    for (int t = 0; t < nT; t += 2) {
        ATT_STEP(pA0, pA1, pB0, pB1, t);
        ATT_STEP(pB0, pB1, pA0, pA1, t + 1);
    }
    ATT_LAS bf16_t* stg = (ATT_LAS bf16_t*)(lds + wid * 4096);
#pragma unroll
    for (int r = 0; r < 16; ++r) { const int q = crow(r, hi); const float il = 1.f / o2[r];
        stg[q * 64 + r32] = (bf16_t)f2bf(o0[r] * il); stg[q * 64 + 32 + r32] = (bf16_t)f2bf(o1[r] * il); }
    asm volatile("s_waitcnt lgkmcnt(0)" ::: "memory");
    bf16_t* Ow = TM + (rowbase + q0 + wid * 32) * 1024 + h * 64 + (lane & 7) * 8;
    u32x4 zv[4];
#pragma unroll
    for (int i = 0; i < 4; ++i) zv[i] = *(const u32x4*)(Ow + (size_t)(i * 8 + (lane >> 3)) * 1024);
#pragma unroll
    for (int i = 0; i < 4; ++i) { const int row = i * 8 + (lane >> 3);
        const u32x4 ov = *(ATT_LAS const u32x4*)(stg + row * 64 + (lane & 7) * 8);
        f32x4 a0, a1, z0, z1; pg8::unpack8(ov, a0, a1); pg8::unpack8(zv[i], z0, z1);
        if (do_store) *(u32x4*)(Ow + (size_t)row * 1024) = pg8::pack8(a0 * z0, a1 * z1); }
    asm volatile("s_waitcnt lgkmcnt(0)" ::: "memory"); __builtin_amdgcn_s_barrier();
#undef ATT_DMAK
#undef ATT_DMAV
#undef SB_
#undef KL_
#undef VL_
#undef VF_
#undef EX4_
#undef SUM4_
#undef PK8_
#undef QM0_
#undef QM1_
#undef ATT_KLOAD
#undef ATT_QKM
#undef ATT_MAXR
#undef ATT_EXPV
#undef ATT_PVM
#undef ATT_WAITV
#undef ATT_BAR
#undef ATT_STEP
}

__device__ __forceinline__ void attn_phase(const Args& a, ATT_LAS unsigned char* lds, int do_store) {
    const int G = gridDim.x, bid = blockIdx.x;
    const int v = (G % 8 == 0) ? (bid % 8) * (G / 8) + bid / 8 : bid;
    const bf16_t* QN = (const bf16_t*)(a.ws + WS_QN); const bf16_t* QR = (const bf16_t*)(a.ws + WS_QR); const bf16_t* KN = (const bf16_t*)(a.ws + WS_KN);
    const bf16_t* KR = (const bf16_t*)(a.ws + WS_KR); const bf16_t* VV = (const bf16_t*)(a.ws + WS_VV); bf16_t* TM = (bf16_t*)(a.ws + WS_TM);
    for (int s = v; s < NB * NH * 16; s += G) {
        const int bh = (s >> 1) % (NB * NH), half = s & 1, rnd = s / (2 * NB * NH);
        const int j = 2 * (rnd >> 1) + half; const int qb = (rnd & 1) ? 15 - j : j;
        attn_unit(bh / NH, bh % NH, qb, QN, QR, KN, KR, VV, TM, lds, do_store);
    }
}
}

namespace ssm {
#define SSM_LAS __attribute__((address_space(3)))
typedef SSM_LAS unsigned char SSM_LAS_T;
typedef short bf16x8 __attribute__((ext_vector_type(8)));
constexpr size_t WS_KTAB = 278 * MiB;
constexpr size_t WS_PW = 280 * MiB;
constexpr size_t WS_POW = 281 * MiB;
constexpr size_t WS_BBF = 284 * MiB;
constexpr size_t WS_SLOC = 258 * MiB;

__device__ __forceinline__ void prep_group(const Args& a, int g, float* lds) {
    const int tid = opq(threadIdx.x);
    float* POWL = lds;
    float* BbL = lds + 65 * 128;
    float* CL = BbL + 2048;
    const float* log_dt = a.in[7]; const float* a_re = a.in[8]; const float* a_im = a.in[9]; const float* b_re = a.in[10]; const float* b_im = a.in[11];
    const float* c_re = a.in[12]; const float* c_im = a.in[13]; const float* dsk = a.in[14];
    float* POWG = (float*)(a.ws + WS_POW) + (size_t)g * 65 * 128; bf16_t* BBF = (bf16_t*)(a.ws + WS_BBF) + (size_t)g * 128 * 16;
    bf16_t* KTAB = (bf16_t*)(a.ws + WS_KTAB) + (size_t)g * 64 * 256; bf16_t* PW = (bf16_t*)(a.ws + WS_PW) + (size_t)g * 64 * 128;
    __syncthreads();
    if (tid < 64) { const int n = tid, idx = g * NS + n;
        const float dt = expf(log_dt[g]), lr = a_re[idx], li = a_im[idx];
        const float mag = expf(lr * dt); float sn, cs; sincosf(li * dt, &sn, &cs);
        const float abr = mag * cs, abi = mag * sn, den = lr * lr + li * li, nr = abr - 1.f, ni = abi;
        const float fr = (nr * lr + ni * li) / den, fi = (ni * lr - nr * li) / den;
        for (int q = 0; q < GP; ++q) { const float br = b_re[(size_t)idx * GP + q], bi = b_im[(size_t)idx * GP + q];
            const float xr = fr * br - fi * bi, xi = fr * bi + fi * br; BbL[(n * 16 + q) * 2] = xr; BbL[(n * 16 + q) * 2 + 1] = xi;
            BBF[n * 16 + q] = (bf16_t)f2bf(xr); BBF[(64 + n) * 16 + q] = (bf16_t)f2bf(xi); }
        float pr = 1.f, pi = 0.f;
        for (int d = 0; d <= 64; ++d) { POWL[(d * 64 + n) * 2] = pr; POWL[(d * 64 + n) * 2 + 1] = pi; POWG[(d * 64 + n) * 2] = pr; POWG[(d * 64 + n) * 2 + 1] = pi;
            const float t = pr * abr - pi * abi; pi = pr * abi + pi * abr; pr = t; }
    }
    for (int e = tid; e < 1024; e += NTHR) { CL[e * 2] = c_re[(size_t)g * 1024 + e]; CL[e * 2 + 1] = c_im[(size_t)g * 1024 + e]; }
    __syncthreads();
    {
        const int pq = tid & 255, p = pq >> 4, q = pq & 15, dh = tid >> 8;
        float acc[32];
#pragma unroll
        for (int i = 0; i < 32; ++i) acc[i] = 0.f;
        for (int n = 0; n < 64; ++n) {
            const float cr = CL[(p * 64 + n) * 2], ci = CL[(p * 64 + n) * 2 + 1], br = BbL[(n * 16 + q) * 2], bi = BbL[(n * 16 + q) * 2 + 1];
            const float gr = cr * br - ci * bi, gi = cr * bi + ci * br;
#pragma unroll
            for (int i = 0; i < 32; ++i) { const int d = dh + 2 * i; acc[i] += gr * POWL[(d * 64 + n) * 2] - gi * POWL[(d * 64 + n) * 2 + 1]; }
        }
        if (dh == 0 && p == q) acc[0] += dsk[g * 16 + p];
#pragma unroll
        for (int i = 0; i < 32; ++i) KTAB[(dh + 2 * i) * 256 + pq] = (bf16_t)f2bf(acc[i]);
    }
    for (int e = tid; e < 64 * 64; e += NTHR) { const int t = e >> 6, n = e & 63;
        *(unsigned*)(PW + t * 128 + 2 * n) = pk2(POWL[((t + 1) * 64 + n) * 2], -POWL[((t + 1) * 64 + n) * 2 + 1]); }
    __syncthreads();
}

__device__ __forceinline__ f32x4 cmul_r(f32x4 ar, f32x4 ai, f32x4 br, f32x4 bi) { return ar * br - ai * bi; }
__device__ __forceinline__ f32x4 cmul_i(f32x4 ar, f32x4 ai, f32x4 br, f32x4 bi) { return ar * bi + ai * br; }

__device__ __forceinline__ void passA(const Args& a) {
    const int tid = opq(threadIdx.x), lane = tid & 63, wid = __builtin_amdgcn_readfirstlane(tid >> 6), j16 = lane & 15, kq = lane >> 4;
    const bf16_t* US = (const bf16_t*)(a.ws + WS_US); float* SLOC = (float*)(a.ws + WS_SLOC);
    for (int item = blockIdx.x; item < NG * 4; item += gridDim.x) {
        const int g = item >> 2, qtr = item & 3, b = wid;
        const bf16_t* BBF = (const bf16_t*)(a.ws + WS_BBF) + (size_t)g * 128 * 16; const float* POWG = (const float*)(a.ws + WS_POW) + (size_t)g * 65 * 128;
        bf16x8 bfr[4][2]; float abr[4], abi[4], a16r[4], a16i[4], afr_[4], afi_[4];
        const bf16x8 zf = {0, 0, 0, 0, 0, 0, 0, 0};
#pragma unroll
        for (int aa = 0; aa < 4; ++aa) { const int n = 16 * aa + j16;
#pragma unroll
            for (int ri = 0; ri < 2; ++ri) bfr[aa][ri] = (kq < 2) ? *(const bf16x8*)(BBF + (ri * 64 + n) * 16 + 8 * kq) : zf;
            abr[aa] = POWG[(1 * 64 + n) * 2]; abi[aa] = POWG[(1 * 64 + n) * 2 + 1]; a16r[aa] = POWG[(16 * 64 + n) * 2]; a16i[aa] = POWG[(16 * 64 + n) * 2 + 1];
            afr_[aa] = POWG[((12 - 4 * kq) * 64 + n) * 2]; afi_[aa] = POWG[((12 - 4 * kq) * 64 + n) * 2 + 1]; }
        const bf16_t* ubase = US + ((size_t)g * NT + (size_t)b * SEQ + qtr * 1024 + j16) * 16 + 8 * (kq & 1);
        bf16x8 nfr[4];
#pragma unroll
        for (int T = 0; T < 4; ++T) nfr[T] = (kq < 2) ? *(const bf16x8*)(ubase + T * 256) : zf;
#pragma unroll 1
        for (int cl = 0; cl < 16; ++cl) {
            const int c = qtr * 16 + cl;
            bf16x8 afr[4];
#pragma unroll
            for (int T = 0; T < 4; ++T) afr[T] = nfr[T];
            if (cl + 1 < 16) {
#pragma unroll
                for (int T = 0; T < 4; ++T) nfr[T] = (kq < 2) ? *(const bf16x8*)(ubase + (cl + 1) * 1024 + T * 256) : zf; }
            float* dst = SLOC + (((size_t)b * NG + g) * 64 + c) * 128;
#pragma unroll
            for (int aa = 0; aa < 4; ++aa) {
                float Hr = 0.f, Hi = 0.f;
#pragma unroll
                for (int T = 0; T < 4; ++T) {
                    const f32x4 z = {0.f, 0.f, 0.f, 0.f};
                    const f32x4 vr = __builtin_amdgcn_mfma_f32_16x16x32_bf16(afr[T], bfr[aa][0], z, 0, 0, 0), vi = __builtin_amdgcn_mfma_f32_16x16x32_bf16(afr[T], bfr[aa][1], z, 0, 0, 0);
                    float hr = vr[0], hi_ = vi[0];
#pragma unroll
                    for (int r = 1; r < 4; ++r) { const float t = hr * abr[aa] - hi_ * abi[aa] + vr[r]; hi_ = hr * abi[aa] + hi_ * abr[aa] + vi[r]; hr = t; }
                    const float t = Hr * a16r[aa] - Hi * a16i[aa] + hr; Hi = Hr * a16i[aa] + Hi * a16r[aa] + hi_; Hr = t;
                }
                float rr = afr_[aa] * Hr - afi_[aa] * Hi, ri_ = afr_[aa] * Hi + afi_[aa] * Hr;
                rr += __shfl_xor(rr, 16); ri_ += __shfl_xor(ri_, 16); rr += __shfl_xor(rr, 32); ri_ += __shfl_xor(ri_, 32);
                if (kq == 0) { typedef float f32x2_ __attribute__((ext_vector_type(2))); *(f32x2_*)(dst + 2 * (16 * aa + j16)) = (f32x2_){rr, ri_}; }
            }
        }
    }
}

__device__ __forceinline__ void scan_states(const Args& a) {
    const int tid = opq(threadIdx.x), lane = tid & 63, wid = __builtin_amdgcn_readfirstlane(tid >> 6);
    typedef float f32x2_ __attribute__((ext_vector_type(2)));
    if (wid >= 2) return;
    for (int seq = blockIdx.x * 2 + wid; seq < NB * NG; seq += gridDim.x * 2) {
        const int g = seq % NG;
        const float* POWG = (const float*)(a.ws + WS_POW) + (size_t)g * 65 * 128;
        const float ar = POWG[(64 * 64 + lane) * 2], ai = POWG[(64 * 64 + lane) * 2 + 1];
        f32x2_* sl = (f32x2_*)((float*)(a.ws + WS_SLOC) + (size_t)seq * 64 * 128) + lane;
        float sr = 0.f, si = 0.f;
        f32x2_ cur[8], nxt[8];
#pragma unroll
        for (int i = 0; i < 8; ++i) cur[i] = sl[i * 64];
#pragma unroll 1
        for (int cb = 0; cb < 8; ++cb) {
            if (cb + 1 < 8) {
#pragma unroll
                for (int i = 0; i < 8; ++i) nxt[i] = sl[((cb + 1) * 8 + i) * 64]; }
#pragma unroll
            for (int i = 0; i < 8; ++i) { sl[(cb * 8 + i) * 64] = (f32x2_){sr, si};
                const float t = ar * sr - ai * si + cur[i].x; si = ar * si + ai * sr + cur[i].y; sr = t; }
#pragma unroll
            for (int i = 0; i < 8; ++i) cur[i] = nxt[i];
        }
    }
}

constexpr int LB_KT = 0, LB_PW = 32768, LB_CR = 49152, LB_CI = 53248, LB_UB = 57344, UB_BYTES = 5120;
__device__ __forceinline__ float gelu_fast(float v) { const float u2 = 1.5957691216057308f * (v + 0.044715f * v * v * v); return v / (1.f + __expf(-u2)); }
__device__ __forceinline__ void passB(const Args& a, SSM_LAS_T* lds) {
    const int tid = opq(threadIdx.x), lane = tid & 63, wid = __builtin_amdgcn_readfirstlane(tid >> 6), j16 = lane & 15, kq = lane >> 4;
    const bf16_t* US = (const bf16_t*)(a.ws + WS_US); const float* SIN = (const float*)(a.ws + WS_SLOC); bf16_t* YG = (bf16_t*)(a.ws + WS_YG);
    const float* c_re = a.in[12]; const float* c_im = a.in[13];
    SSM_LAS_T* UB = lds + LB_UB + wid * UB_BYTES;
    for (int item = blockIdx.x; item < NG * 4; item += gridDim.x) {
        const int g = item >> 2, qtr = item & 3, b = wid;
        __syncthreads();
        {   const u32x4* ks = (const u32x4*)(a.ws + WS_KTAB + (size_t)g * 32768); const u32x4* ps = (const u32x4*)(a.ws + WS_PW + (size_t)g * 16384);
            for (int e = tid; e < 2048; e += NTHR) *(SSM_LAS u32x4*)(lds + LB_KT + e * 16) = ks[e];
            for (int e = tid; e < 1024; e += NTHR) *(SSM_LAS u32x4*)(lds + LB_PW + e * 16) = ps[e];
            if (tid < 256) *(SSM_LAS u32x4*)(lds + LB_CR + tid * 16) = *(const u32x4*)(c_re + (size_t)g * 1024 + tid * 4);
            else *(SSM_LAS u32x4*)(lds + LB_CI + (tid - 256) * 16) = *(const u32x4*)(c_im + (size_t)g * 1024 + (tid - 256) * 4);
            if (lane < 32) { *(SSM_LAS u32x4*)(UB + lane * 16) = (u32x4){0u, 0u, 0u, 0u}; *(SSM_LAS u32x4*)(UB + 2560 + lane * 16) = (u32x4){0u, 0u, 0u, 0u}; }
        }
        __syncthreads();
        const size_t tokq = (size_t)b * SEQ + qtr * 1024;
        const u32x4* up = (const u32x4*)(US + ((size_t)g * NT + tokq) * 16) + lane;
        const float* sp = SIN + (((size_t)b * NG + g) * 64 + qtr * 16) * 128 + 8 * kq;
        u32x4 un[4]; f32x4 sn[2][8];
#define SSM_PREF(pr) do { _Pragma("unroll") for (int i = 0; i < 4; ++i) un[i] = up[(pr) * 256 + i * 64]; \
            _Pragma("unroll") for (int ch = 0; ch < 2; ++ch) _Pragma("unroll") for (int ks = 0; ks < 4; ++ks) { sn[ch][2 * ks] = *(const f32x4*)(sp + (size_t)(2 * (pr) + ch) * 128 + ks * 32); sn[ch][2 * ks + 1] = *(const f32x4*)(sp + (size_t)(2 * (pr) + ch) * 128 + ks * 32 + 4); } } while (0)
        SSM_PREF(0);
        bf16x8 gfr[2][4];
#pragma unroll 1
        for (int pr = 0; pr < 8; ++pr) {
            *(SSM_LAS u32x4*)(UB + 512 + lane * 16) = un[0]; *(SSM_LAS u32x4*)(UB + 512 + 1024 + lane * 16) = un[1];
            *(SSM_LAS u32x4*)(UB + 2560 + 512 + lane * 16) = un[2]; *(SSM_LAS u32x4*)(UB + 2560 + 512 + 1024 + lane * 16) = un[3];
#pragma unroll
            for (int ks = 0; ks < 4; ++ks) { const int n0 = 16 * ks + 4 * kq;
                const f32x4 cr = *(SSM_LAS const f32x4*)(lds + LB_CR + (j16 * 64 + n0) * 4), ci = *(SSM_LAS const f32x4*)(lds + LB_CI + (j16 * 64 + n0) * 4);
#pragma unroll
                for (int ch = 0; ch < 2; ++ch) { const f32x4 w0 = sn[ch][2 * ks], w1 = sn[ch][2 * ks + 1];
                    const f32x4 sr = (f32x4){w0[0], w0[2], w1[0], w1[2]}, si = (f32x4){w0[1], w0[3], w1[1], w1[3]};
                    const f32x4 gr = cmul_r(cr, ci, sr, si), gi = cmul_i(cr, ci, sr, si);
                    u32x4 w; w.x = pg8::cvt_pk_bf16(gr[0], gi[0]); w.y = pg8::cvt_pk_bf16(gr[1], gi[1]); w.z = pg8::cvt_pk_bf16(gr[2], gi[2]); w.w = pg8::cvt_pk_bf16(gr[3], gi[3]); gfr[ch][ks] = __builtin_bit_cast(bf16x8, w); } }
            if (pr + 1 < 8) SSM_PREF(pr + 1);
            f32x4 acc[2][4];
#pragma unroll
            for (int T = 0; T < 4; ++T) { acc[0][T] = (f32x4){0.f, 0.f, 0.f, 0.f}; acc[1][T] = (f32x4){0.f, 0.f, 0.f, 0.f};
#pragma unroll
                for (int ks = 0; ks < 4; ++ks) { const bf16x8 pa = *(SSM_LAS const bf16x8*)(lds + LB_PW + (16 * T + j16) * 256 + ks * 64 + kq * 16);
                    acc[0][T] = __builtin_amdgcn_mfma_f32_16x16x32_bf16(pa, gfr[0][ks], acc[0][T], 0, 0, 0);
                    acc[1][T] = __builtin_amdgcn_mfma_f32_16x16x32_bf16(pa, gfr[1][ks], acc[1][T], 0, 0, 0); } }
            __builtin_amdgcn_sched_barrier(0);
            SSM_LAS const unsigned char* ua = UB + (16 + j16 - (kq >> 1)) * 32 + (kq & 1) * 16;
            SSM_LAS const unsigned char* kb = lds + LB_KT + (kq >> 1) * 512 + j16 * 32 + (kq & 1) * 16;
#pragma unroll
            for (int s = 48; s >= -14; s -= 2) {
                const bf16x8 ua0 = *(SSM_LAS const bf16x8*)(ua + s * 32), ua1 = *(SSM_LAS const bf16x8*)(ua + 2560 + s * 32);
#pragma unroll
                for (int T = 0; T < 4; ++T) if (16 * T >= s) { const bf16x8 kb_ = *(SSM_LAS const bf16x8*)(kb + (16 * T - s) * 512);
                    acc[0][T] = __builtin_amdgcn_mfma_f32_16x16x32_bf16(ua0, kb_, acc[0][T], 0, 0, 0);
                    acc[1][T] = __builtin_amdgcn_mfma_f32_16x16x32_bf16(ua1, kb_, acc[1][T], 0, 0, 0); }
                if ((s & 6) == 0) __builtin_amdgcn_sched_barrier(0);
            }
            bf16_t* yp = YG + ((size_t)g * NT + tokq + pr * 128 + 4 * kq) * 16 + j16;
#pragma unroll
            for (int ch = 0; ch < 2; ++ch)
#pragma unroll
                for (int T = 0; T < 4; ++T)
#pragma unroll
                    for (int r = 0; r < 4; ++r) yp[(ch * 64 + 16 * T + r) * 16] = (bf16_t)f2bf(gelu_fast(acc[ch][T][r]));
            __builtin_amdgcn_sched_barrier(0);
        }
#undef SSM_PREF
    }
}
}

#define XLAS __attribute__((address_space(3)))
#define XB_TMO      128
#define XB_XCNT(j)  (256  + 64 * (j))
#define XB_XSUB(j)  (1280 + 64 * (j))
#define XB_XGEN(j)  (2304 + 64 * (j))
#define XB_TOP      3328
#define XB_TOPGEN   3392
#define XCD_BAR_WORDS 3456
#define XB_SPIN_CAP (1u << 18)
__device__ __forceinline__ unsigned xb_ld(unsigned* p)              { return __hip_atomic_load(p, __ATOMIC_RELAXED, __HIP_MEMORY_SCOPE_AGENT); }
__device__ __forceinline__ unsigned xb_add(unsigned* p, unsigned v) { return __hip_atomic_fetch_add(p, v, __ATOMIC_RELAXED, __HIP_MEMORY_SCOPE_AGENT); }
__device__ __forceinline__ unsigned xb_xcc_id() { return (unsigned)__builtin_amdgcn_s_getreg((3 << 11) | 20) & 0xFu; }
#define XB_SPIN(cond, bar) do { unsigned _sp = 0; while (cond) { __builtin_amdgcn_s_sleep(1); \
    if ((++_sp & 255u) == 0u) { if (xb_ld(&(bar)[XB_TMO])) break; if (_sp > XB_SPIN_CAP) { atomicAdd(&(bar)[XB_TMO], 1u); break; } } } } while (0)
struct XcdBarrier { unsigned* bar; unsigned x; volatile XLAS unsigned* st; };
__device__ __forceinline__ XcdBarrier xcd_barrier_post(unsigned* bar, volatile XLAS unsigned* st) {
    XcdBarrier b; b.bar = bar; b.x = xb_xcc_id(); b.st = st;
    if (threadIdx.x == 0) (void)xb_add(&bar[XB_XCNT(b.x)], 1u);
    return b;
}
__device__ __forceinline__ void xcd_barrier_complete(unsigned* bar, unsigned x, unsigned& nloc, unsigned& nx) {
    const unsigned G = gridDim.x * gridDim.y * gridDim.z;
    unsigned sum, cnt, mine, sp = 0u;
    for (;;) {
        sum = 0u; cnt = 0u; mine = 0u;
#pragma unroll
        for (unsigned j = 0; j < 16; ++j) { const unsigned c = xb_ld(&bar[XB_XCNT(j)]); sum += c; cnt += (c > 0u) ? 1u : 0u; mine = (j == x) ? c : mine; }
        if (sum == G) break;
        __builtin_amdgcn_s_sleep(1);
        if ((++sp & 255u) == 0u) { if (xb_ld(&bar[XB_TMO])) break; if (sp > XB_SPIN_CAP) { atomicAdd(&bar[XB_TMO], 1u); break; } }
    }
    nloc = mine > 0u ? mine : 1u; nx = cnt > 0u ? cnt : 1u;
}
__device__ __forceinline__ void xcd_barrier(const XcdBarrier& b) {
    asm volatile("s_waitcnt vmcnt(0)" ::: "memory");
    __syncthreads();
    if (threadIdx.x == 0) {
        unsigned* bar = b.bar;
        __builtin_amdgcn_s_waitcnt(0);
        unsigned nloc = b.st[0], nx = b.st[1];
        if (nloc == 0u) { xcd_barrier_complete(bar, b.x, nloc, nx); b.st[0] = nloc; b.st[1] = nx; }
        const unsigned old = xb_add(&bar[XB_XSUB(b.x)], 1u);
        const unsigned gen = old / nloc;
        if (old + 1u == (gen + 1u) * nloc) {
            __builtin_amdgcn_fence(__ATOMIC_RELEASE, "agent");
            asm volatile("s_waitcnt vmcnt(0)" ::: "memory");
            const unsigned og = xb_add(&bar[XB_TOP], 1u);
            const unsigned tg = og / nx;
            if (og + 1u == (tg + 1u) * nx) xb_add(&bar[XB_TOPGEN], 1u);
            else XB_SPIN(xb_ld(&bar[XB_TOPGEN]) == tg, bar);
            __builtin_amdgcn_fence(__ATOMIC_ACQUIRE, "agent");
            xb_add(&bar[XB_XGEN(b.x)], 1u);
            asm volatile("s_waitcnt vmcnt(0)" ::: "memory");
        } else {
            XB_SPIN(xb_ld(&bar[XB_XGEN(b.x)]) == gen, bar);
            __builtin_amdgcn_fence(__ATOMIC_ACQUIRE, "agent");
            asm volatile("s_waitcnt vmcnt(0)" ::: "memory");
        }
    }
    __syncthreads();
}

__device__ __forceinline__ void ph0_prep(const Args& a, float* lds) {
    const int tid = opq(threadIdx.x), gtid = blockIdx.x * NTHR + tid, gsz = gridDim.x * NTHR;
    const float* c = a.in[1]; const int* pos = (const int*)a.in[2]; const float* w_ada = a.in[3]; const float* b_ada = a.in[4];
    float* mod = (float*)(a.ws + WS_MOD);
    for (int item = (int)gridDim.x - 1 - (int)blockIdx.x; item < 48; item += gridDim.x) {
        const int col = item * 64 + (tid & 63), ks = __builtin_amdgcn_readfirstlane(tid >> 6);
        float acc[NB];
#pragma unroll
        for (int b = 0; b < NB; ++b) acc[b] = 0.f;
#pragma unroll 4
        for (int k = ks * 128; k < ks * 128 + 128; ++k) { const float w = w_ada[(size_t)k * 3072 + col];
#pragma unroll
            for (int b = 0; b < NB; ++b) acc[b] += c[b * DM + k] * w; }
        __syncthreads();
#pragma unroll
        for (int b = 0; b < NB; ++b) lds[(ks * NB + b) * 64 + (tid & 63)] = acc[b];
        __syncthreads();
        { const int b = tid >> 6, cc = tid & 63; float s2 = b_ada[item * 64 + cc];
#pragma unroll
            for (int k2 = 0; k2 < 8; ++k2) s2 += lds[(k2 * NB + b) * 64 + cc];
            mod[b * 3072 + item * 64 + cc] = s2; }
        __syncthreads();
    }
    float* rope = (float*)(a.ws + WS_ROPE);
    for (int idx = gtid; idx < NT * 16; idx += gsz) {
        const int tok = idx >> 4, i = idx & 15;
        const float inv = powf(10000.f, -(float)i / 16.f);
        const float ang = (float)pos[tok] * inv; float sn, cs; sincosf(ang, &sn, &cs);
        rope[(size_t)tok * 32 + i] = cs; rope[(size_t)tok * 32 + 16 + i] = sn;
    }
#if !FAST_SSM
    const float* log_dt = a.in[7]; const float* a_re = a.in[8]; const float* a_im = a.in[9]; const float* b_re = a.in[10]; const float* b_im = a.in[11];
    float* abar = (float*)(a.ws + WS_SSMC); float* bbar = (float*)(a.ws + WS_SSMC + 65536);
    for (int idx = gtid; idx < NG * NS; idx += gsz) {
        const int g = idx / NS;
        const float dt = expf(log_dt[g]), lr = a_re[idx], li = a_im[idx];
        const float mag = expf(lr * dt); float sn, cs; sincosf(li * dt, &sn, &cs);
        const float abr = mag * cs, abi = mag * sn, den = lr * lr + li * li, nr = abr - 1.f, ni = abi;
        const float fr = (nr * lr + ni * li) / den, fi = (ni * lr - nr * li) / den;
        abar[idx * 2] = abr; abar[idx * 2 + 1] = abi;
        for (int q = 0; q < GP; ++q) { const float br = b_re[(size_t)idx * GP + q], bi = b_im[(size_t)idx * GP + q];
            bbar[((size_t)idx * GP + q) * 2] = fr * br - fi * bi; bbar[((size_t)idx * GP + q) * 2 + 1] = fr * bi + fi * br; }
    }
#endif
}

__device__ __forceinline__ void ph1_hnorm(const Args& a) {
    const int tid_ = opq(threadIdx.x), lane = tid_ & 63, gw = blockIdx.x * (NTHR / 64) + (tid_ >> 6), ngw = gridDim.x * (NTHR / 64);
    const float* x = a.in[0]; const float* g_pre = a.in[5]; const float* mod = (const float*)(a.ws + WS_MOD); bf16_t* HB = (bf16_t*)(a.ws + WS_HB);
    for (int m = gw; m < NT; m += ngw) {
        const int b = m / SEQ; const f32x4* xr = (const f32x4*)(x + (size_t)m * DM) + lane;
        f32x4 v[4]; float s = 0.f;
#pragma unroll
        for (int j = 0; j < 4; ++j) { v[j] = xr[64 * j]; s += (v[j].x * v[j].x + v[j].y * v[j].y) + (v[j].z * v[j].z + v[j].w * v[j].w); }
        const float rstd = 1.f / sqrtf(wave_sum(s) * (1.f / DM) + EPS);
        unsigned long long* o8 = (unsigned long long*)(HB + (size_t)m * DM) + lane;
#pragma unroll
        for (int j = 0; j < 4; ++j) { const int k = 256 * j + 4 * lane;
            const f32x4 g = *(const f32x4*)(g_pre + k), sh = *(const f32x4*)(mod + b * 3072 + k), sc = *(const f32x4*)(mod + b * 3072 + 1024 + k);
            const f32x4 h = v[j] * rstd * g * (sc + 1.f) + sh;
            o8[64 * j] = (unsigned long long)pk2(h.x, h.y) | ((unsigned long long)pk2(h.z, h.w) << 32); }
    }
}

struct BL2 { const float* W; __device__ __forceinline__ float b(int k, int j) const {
    int src;
    if (j < 1024) src = C_US + j; else if (j < 1280) src = C_QL + (j - 1024); else if (j < 1536) src = C_KL + (j - 1280);
    else if (j < 1568) { const int p = j - 1536; src = C_KR + ((p & 1) ? 16 + (p >> 1) : (p >> 1)); } else src = C_ZM + (j - 1568);
    return W[(size_t)k * INW + src]; } };
struct EP2 { bf16_t *US, *QL, *KL, *KR, *TM; float *ssq_q, *ssq_kv; const float* rope;
    __device__ __forceinline__ void e(int row, int j, float v0, float v1) const {
        if (j < 1024) { *(unsigned*)(US + ((size_t)(j >> 4) * NT + row) * 16 + (j & 15)) = pk2(v0, v1); }
        else if (j < 1280) { *(unsigned*)(QL + (size_t)row * 256 + (j - 1024)) = pk2(v0, v1); atomicAdd(ssq_q + row, v0 * v0 + v1 * v1); }
        else if (j < 1536) { *(unsigned*)(KL + (size_t)row * 256 + (j - 1280)) = pk2(v0, v1); atomicAdd(ssq_kv + row, v0 * v0 + v1 * v1); }
        else if (j < 1568) { const int p = j - 1536, i = p >> 1; const float cs = rope[(size_t)row * 32 + i], sn = rope[(size_t)row * 32 + 16 + i];
            *(unsigned*)(KR + (size_t)row * 32 + p) = pk2(v0 * cs - v1 * sn, v1 * cs + v0 * sn); }
        else { *(unsigned*)(TM + (size_t)row * 1024 + (j - 1568)) = pk2(siluf_(v0), siluf_(v1)); }
    } };

struct BL3q { const float* W; const float* g; __device__ __forceinline__ float b(int k, int j) const {
    int src; if (j < 1024) src = (j >> 6) * 96 + (j & 63); else { const int jj = j - 1024, h = jj >> 5, p = jj & 31; src = h * 96 + 64 + ((p & 1) ? 16 + (p >> 1) : (p >> 1)); }
    return W[(size_t)k * 1536 + src] * g[k]; } };
struct EP3q { bf16_t *QN, *QR; const float* ssq; const float* rope;
    __device__ __forceinline__ void e(int row, int j, float v0, float v1) const {
        const float rs = QSCALE / sqrtf(ssq[row] * (1.f / 256.f) + EPS); v0 *= rs; v1 *= rs;
        if (j < 1024) *(unsigned*)(QN + (size_t)row * 1024 + j) = pk2(v0, v1);
        else { const int jj = j - 1024, i = (jj & 31) >> 1; const float cs = rope[(size_t)row * 32 + i], sn = rope[(size_t)row * 32 + 16 + i];
            *(unsigned*)(QR + (size_t)row * 512 + jj) = pk2(v0 * cs - v1 * sn, v1 * cs + v0 * sn); }
    } };
struct BL3kv { const float* W; const float* g; __device__ __forceinline__ float b(int k, int j) const {
    const int src = (j < 1024) ? (j >> 6) * 128 + (j & 63) : ((j - 1024) >> 6) * 128 + 64 + (j & 63);
    return W[(size_t)k * 2048 + src] * g[k]; } };
struct EP3kv { bf16_t *KN, *VV; const float* ssq;
    __device__ __forceinline__ void e(int row, int j, float v0, float v1) const {
        const float rs = 1.f / sqrtf(ssq[row] * (1.f / 256.f) + EPS); v0 *= rs; v1 *= rs;
        if (j < 1024) *(unsigned*)(KN + (size_t)row * 1024 + j) = pk2(v0, v1); else *(unsigned*)(VV + (size_t)row * 1024 + (j - 1024)) = pk2(v0, v1);
    } };

__device__ __forceinline__ void ph4_attn(const Args& a, float* lds) {
    const bf16_t* QN = (const bf16_t*)(a.ws + WS_QN); const bf16_t* QR = (const bf16_t*)(a.ws + WS_QR); const bf16_t* KN = (const bf16_t*)(a.ws + WS_KN);
    const bf16_t* KR = (const bf16_t*)(a.ws + WS_KR); const bf16_t* VV = (const bf16_t*)(a.ws + WS_VV); bf16_t* TM = (bf16_t*)(a.ws + WS_TM);
    float* Kt = lds;
    float* Vt = lds + 64 * 100;
    const int tid = opq(threadIdx.x), wv = tid >> 6, half = wv >> 2;
    for (int item = blockIdx.x; item < NB * NH * 16; item += gridDim.x) {
        const int qb = item & 15, h = (item >> 4) & 15, b = item >> 8;
        const size_t tok = (size_t)b * SEQ + qb * 256 + (tid & 255);
        float q[96], o[32];
#pragma unroll
        for (int d = 0; d < 64; d += 2) { const unsigned w = *(const unsigned*)(QN + tok * 1024 + h * 64 + d); q[d] = bf2f(w); q[d + 1] = bf2f(w >> 16); }
#pragma unroll
        for (int d = 0; d < 32; d += 2) { const unsigned w = *(const unsigned*)(QR + tok * 512 + h * 32 + d); q[64 + d] = bf2f(w); q[64 + d + 1] = bf2f(w >> 16); }
#pragma unroll
        for (int d = 0; d < 32; ++d) o[d] = 0.f;
        float m = -1e30f, l = 0.f;
        const int mychunk = qb * 4 + (wv & 3), nkt = qb * 4 + 4;
        for (int kt = 0; kt < nkt; ++kt) {
            __syncthreads();
            const size_t kt0 = (size_t)b * SEQ + kt * 64;
            for (int e = tid; e < 64 * 32; e += NTHR) { const int key = e >> 5, d2 = (e & 31) * 2; const unsigned w = *(const unsigned*)(KN + (kt0 + key) * 1024 + h * 64 + d2); Kt[key * 100 + d2] = bf2f(w); Kt[key * 100 + d2 + 1] = bf2f(w >> 16); }
            for (int e = tid; e < 64 * 16; e += NTHR) { const int key = e >> 4, d2 = (e & 15) * 2; const unsigned w = *(const unsigned*)(KR + (kt0 + key) * 32 + d2); Kt[key * 100 + 64 + d2] = bf2f(w); Kt[key * 100 + 64 + d2 + 1] = bf2f(w >> 16); }
            for (int e = tid; e < 64 * 32; e += NTHR) { const int key = e >> 5, d2 = (e & 31) * 2; const unsigned w = *(const unsigned*)(VV + (kt0 + key) * 1024 + h * 64 + d2); Vt[key * 68 + d2] = bf2f(w); Vt[key * 68 + d2 + 1] = bf2f(w >> 16); }
            __syncthreads();
            if (kt <= mychunk) {
                for (int key = 0; key < 64; ++key) {
                    float s = 0.f;
#pragma unroll
                    for (int d = 0; d < 96; d += 4) { const f32x4 kk = *(const f32x4*)(Kt + key * 100 + d); s += q[d] * kk[0] + q[d + 1] * kk[1] + q[d + 2] * kk[2] + q[d + 3] * kk[3]; }
                    if (s > m) { const float f = exp2f(m - s); l *= f;
#pragma unroll
                        for (int d = 0; d < 32; ++d) o[d] *= f;
                        m = s; }
                    const float p = exp2f(s - m); l += p;
#pragma unroll
                    for (int d = 0; d < 32; d += 4) { const f32x4 vv = *(const f32x4*)(Vt + key * 68 + half * 32 + d); o[d] += p * vv[0]; o[d + 1] += p * vv[1]; o[d + 2] += p * vv[2]; o[d + 3] += p * vv[3]; }
                }
            }
        }
        const float il = 1.f / l;
#pragma unroll
        for (int d = 0; d < 32; d += 2) { unsigned* p = (unsigned*)(TM + tok * 1024 + h * 64 + half * 32 + d); const unsigned w = *p; *p = pk2(o[d] * il * bf2f(w), o[d + 1] * il * bf2f(w >> 16)); }
    }
}

__device__ __forceinline__ void ph5_ssm(const Args& a, float* lds) {
    const int tid = opq(threadIdx.x), lane = tid & 63, wv = tid >> 6;
    const bf16_t* US = (const bf16_t*)(a.ws + WS_US); bf16_t* YG = (bf16_t*)(a.ws + WS_YG);
    const float* abar = (const float*)(a.ws + WS_SSMC); const float* bbar = (const float*)(a.ws + WS_SSMC + 65536);
    const float* c_re = a.in[12]; const float* c_im = a.in[13]; const float* dsk = a.in[14];
    float* Xs = lds + wv * 4096;
    float* Cs = Xs + 1024; float* Us = Cs + 2048;
    for (int item = blockIdx.x * 8 + wv; item < NB * NG; item += gridDim.x * 8) {
        const int b = item / NG, g = item % NG;
        const float abr = abar[(g * NS + lane) * 2], abi = abar[(g * NS + lane) * 2 + 1];
        float bbr[16], bbi[16];
#pragma unroll
        for (int q = 0; q < 16; ++q) { bbr[q] = bbar[((size_t)(g * NS + lane) * 16 + q) * 2]; bbi[q] = bbar[((size_t)(g * NS + lane) * 16 + q) * 2 + 1]; }
        for (int p = 0; p < 16; ++p) { Cs[(p * 64 + lane) * 2] = c_re[((size_t)g * 16 + p) * 64 + lane]; Cs[(p * 64 + lane) * 2 + 1] = c_im[((size_t)g * 16 + p) * 64 + lane]; }
        float xr = 0.f, xi = 0.f;
        const bf16_t* ug = US + ((size_t)g * NT + (size_t)b * SEQ) * 16; bf16_t* yg = YG + ((size_t)g * NT + (size_t)b * SEQ) * 16;
        const int tt = lane >> 3, p0 = (lane & 7) * 2;
        const float d0 = dsk[g * 16 + p0], d1 = dsk[g * 16 + p0 + 1];
        for (int t0 = 0; t0 < SEQ; t0 += 8) {
            { const unsigned w = *(const unsigned*)(ug + (size_t)t0 * 16 + lane * 2); Us[lane * 2] = bf2f(w); Us[lane * 2 + 1] = bf2f(w >> 16); }
            asm volatile("s_waitcnt vmcnt(0) lgkmcnt(0)" ::: "memory");
#pragma unroll
            for (int t = 0; t < 8; ++t) {
                float bur = 0.f, bui = 0.f;
#pragma unroll
                for (int q = 0; q < 16; ++q) { const float u = Us[t * 16 + q]; bur += bbr[q] * u; bui += bbi[q] * u; }
                const float nr = abr * xr - abi * xi + bur, ni = abr * xi + abi * xr + bui; xr = nr; xi = ni;
                Xs[(t * 64 + lane) * 2] = xr; Xs[(t * 64 + lane) * 2 + 1] = xi;
            }
            asm volatile("s_waitcnt vmcnt(0) lgkmcnt(0)" ::: "memory");
            float y0 = 0.f, y1 = 0.f;
            for (int n = 0; n < 64; ++n) { const float vr = Xs[(tt * 64 + n) * 2], vi = Xs[(tt * 64 + n) * 2 + 1];
                y0 += Cs[(p0 * 64 + n) * 2] * vr - Cs[(p0 * 64 + n) * 2 + 1] * vi; y1 += Cs[((p0 + 1) * 64 + n) * 2] * vr - Cs[((p0 + 1) * 64 + n) * 2 + 1] * vi; }
            y0 += d0 * Us[tt * 16 + p0]; y1 += d1 * Us[tt * 16 + p0 + 1];
            *(unsigned*)(yg + (size_t)(t0 + tt) * 16 + p0) = pk2(gelu_tanh(y0), gelu_tanh(y1));
            asm volatile("s_waitcnt vmcnt(0) lgkmcnt(0)" ::: "memory");
        }
    }
}

struct BLzs { const float* W; __device__ __forceinline__ float b(int k, int j) const { return W[(size_t)k * INW + C_ZS + j]; } };
struct EPzs { bf16_t* ZS; __device__ __forceinline__ void e(int row, int j, float v0, float v1) const { *(unsigned*)(ZS + (size_t)row * 1024 + j) = pk2(siluf_(v0), siluf_(v1)); } };
struct BLglu { const float* W; __device__ __forceinline__ float b(int k, int j) const { return W[(size_t)k * 2048 + ((j & 1) ? 1024 + (j >> 1) : (j >> 1))]; } };
struct EPglu { bf16_t* TS; const bf16_t* ZS; const float* bias; __device__ __forceinline__ void e(int row, int j, float v0, float v1) const {
    const int jj = j >> 1; const float ga = v0 + bias[jj], gb = v1 + bias[1024 + jj]; TS[(size_t)row * 1024 + jj] = (bf16_t)f2bf(ga * sigmoidf_(gb) * bf2f(ZS[(size_t)row * 1024 + jj])); } };
struct BLgate { const float* W; __device__ __forceinline__ float b(int k, int j) const { return W[(size_t)k * INW + ((j & 1) ? C_GM + (j >> 1) : C_GS + (j >> 1))]; } };
struct EPgate { bf16_t *GS, *GM; __device__ __forceinline__ void e(int row, int j, float v0, float v1) const { const int jj = j >> 1; GS[(size_t)row * 1024 + jj] = (bf16_t)f2bf(sigmoidf_(v0)); GM[(size_t)row * 1024 + jj] = (bf16_t)f2bf(sigmoidf_(v1)); } };
struct BLplain { const float* W; int ldw; __device__ __forceinline__ float b(int k, int j) const { return W[(size_t)k * ldw + j]; } };
struct EPbs { float* P1; const bf16_t* GS; __device__ __forceinline__ void e(int row, int j, float v0, float v1) const {
    const unsigned w = *(const unsigned*)(GS + (size_t)row * 1024 + j); P1[(size_t)row * 1024 + j] = bf2f(w) * v0; P1[(size_t)row * 1024 + j + 1] = bf2f(w >> 16) * v1; } };
struct EPbm { const float* P1; const bf16_t* GM; bf16_t* MG; __device__ __forceinline__ void e(int row, int j, float v0, float v1) const {
    const unsigned w = *(const unsigned*)(GM + (size_t)row * 1024 + j); *(unsigned*)(MG + (size_t)row * 1024 + j) = pk2(P1[(size_t)row * 1024 + j] + bf2f(w) * v0, P1[(size_t)row * 1024 + j + 1] + bf2f(w >> 16) * v1); } };
struct EPout { float* O; __device__ __forceinline__ void e(int row, int j, float v0, float v1) const { O[(size_t)row * 1024 + j] = v0; O[(size_t)row * 1024 + j + 1] = v1; } };

__device__ __forceinline__ void ph_final(const Args& a) {
    const int tid_ = opq(threadIdx.x), lane = tid_ & 63, gw = blockIdx.x * (NTHR / 64) + (tid_ >> 6), ngw = gridDim.x * (NTHR / 64);
    const float* x = a.in[0]; const float* g_post = a.in[24]; const float* mod = (const float*)(a.ws + WS_MOD);
#if FAST_OUT
    const bf16_t* OB = (const bf16_t*)(a.ws + WS_OUTB); const float* SO = (const float*)(a.ws + WS_SO);
    for (int m = gw; m < NT; m += ngw) {
        const int b = m / SEQ; const f32x4* xr = (const f32x4*)(x + (size_t)m * DM) + lane;
        const f32x4 p0 = *(const f32x4*)(SO + (size_t)m * 16), p1 = *(const f32x4*)(SO + (size_t)m * 16 + 4), p2 = *(const f32x4*)(SO + (size_t)m * 16 + 8), p3 = *(const f32x4*)(SO + (size_t)m * 16 + 12);
        const f32x4 ps = (p0 + p1) + (p2 + p3);
        const float rstd = 1.f / sqrtf(((ps[0] + ps[1]) + (ps[2] + ps[3])) * (1.f / DM) + EPS);
        const u32x2* orow = (const u32x2*)(OB + (size_t)m * DM) + lane;
        f32x4* o = (f32x4*)(a.out + (size_t)m * DM) + lane;
#pragma unroll
        for (int j = 0; j < 4; ++j) { const int k = 256 * j + 4 * lane; const u32x2 w = orow[64 * j]; const f32x4 v = (f32x4){bf2f(w.x), bf2f(w.x >> 16), bf2f(w.y), bf2f(w.y >> 16)};
            const f32x4 g = *(const f32x4*)(g_post + k), gt = *(const f32x4*)(mod + b * 3072 + 2048 + k);
            o[64 * j] = xr[64 * j] + gt * (v * rstd * g); }
    }
#else
    const float* OF = (const float*)(a.ws + WS_OUTF);
    for (int m = gw; m < NT; m += ngw) {
        const int b = m / SEQ; const f32x4* orow = (const f32x4*)(OF + (size_t)m * DM) + lane; const f32x4* xr = (const f32x4*)(x + (size_t)m * DM) + lane;
        f32x4 v[4]; float s = 0.f;
#pragma unroll
        for (int j = 0; j < 4; ++j) { v[j] = orow[64 * j]; s += (v[j].x * v[j].x + v[j].y * v[j].y) + (v[j].z * v[j].z + v[j].w * v[j].w); }
        const float rstd = 1.f / sqrtf(wave_sum(s) * (1.f / DM) + EPS);
        f32x4* o = (f32x4*)(a.out + (size_t)m * DM) + lane;
#pragma unroll
        for (int j = 0; j < 4; ++j) { const int k = 256 * j + 4 * lane; const f32x4 g = *(const f32x4*)(g_post + k), gt = *(const f32x4*)(mod + b * 3072 + 2048 + k);
            o[64 * j] = xr[64 * j] + gt * (v[j] * rstd * g); }
    }
#endif
}

constexpr int NPHASE = 11;
__global__ void __launch_bounds__(NTHR, 2) mk_fwd(Args a) {
    extern __shared__ __attribute__((aligned(16))) unsigned char lds_raw[];
    float* lds = (float*)lds_raw;
    unsigned char* ws = a.ws;
    constexpr int MISC_OFF = 131072 + 320;
    volatile XLAS unsigned* MISC = (volatile XLAS unsigned*)((XLAS unsigned char*)lds_raw + MISC_OFF);
    if (threadIdx.x < 32) MISC[threadIdx.x] = 0u;
    __syncthreads();
    XcdBarrier xbar = xcd_barrier_post((unsigned*)(a.ws + WS_CTL + 524288), MISC + 8);
#define SEAM(k) do { if (a.ph_lo <= (k) && (k) + 1 < a.ph_hi) { if (a.ph_hi < 0) cg::this_grid().sync(); else xcd_barrier(xbar); } } while (0)
#define IN(k) (a.ph_lo <= (k) && (k) < a.ph_hi)
    pg8::PG8_LAS_T* l3 = (pg8::PG8_LAS_T*)lds_raw;
    const int G = gridDim.x, bid = blockIdx.x;
    if (IN(0)) for (int rep_ = 0; rep_ < (0 == PROBE_DUP ? 2 : 1); ++rep_) { if (rep_) xcd_barrier(xbar); ph0_prep(a, lds);
#if FAST_SSM
        for (int g = bid; g < NG; g += G) ssm::prep_group(a, g, lds);
        __syncthreads();
#endif
        prep_weights(a, lds, 1, bid, G); } SEAM(0);
    if (IN(1)) for (int rep_ = 0; rep_ < (1 == PROBE_DUP ? 2 : 1); ++rep_) { if (rep_) xcd_barrier(xbar); ph1_hnorm(a); } SEAM(1);
    if (IN(2)) for (int rep_ = 0; rep_ < (2 == PROBE_DUP ? 2 : 1); ++rep_) { if (rep_) xcd_barrier(xbar);
#if FAST_G1A
        pg8::Gemm g{(const char*)(ws + WS_HB), (const char*)(ws + WS_HB), (const char*)(ws + WS_WINA), 2816, 1024, 1024, 0, 16}; pg8::StaticOrder S; S.init(NT, 2816, G, bid);
        pg8::EpiG1a E{(bf16_t*)(ws + WS_US), (bf16_t*)(ws + WS_TM), (bf16_t*)(ws + WS_QL), (bf16_t*)(ws + WS_KL), (bf16_t*)(ws + WS_KR), (float*)(ws + WS_SQ), (float*)(ws + WS_SKV), (const float*)(ws + WS_ROPE)};
        pg8::gemm_phase(l3, g, S, E);
        { const int nfull = (NT / 256 * 11) - 5 * G;
          if (G == 256 && bid >= nfull) prep_weights(a, lds, 0, bid - nfull, G - nfull); else if (G != 256) prep_weights(a, lds, 0, bid, G); }
#else
        ARow al{(const bf16_t*)(ws + WS_HB), 1024}; BL2 bl{a.in[6]};
        EP2 ep{(bf16_t*)(ws + WS_US), (bf16_t*)(ws + WS_QL), (bf16_t*)(ws + WS_KL), (bf16_t*)(ws + WS_KR), (bf16_t*)(ws + WS_TM), (float*)(ws + WS_CTL), (float*)(ws + WS_CTL + 131072), (const float*)(ws + WS_ROPE)};
        gemm_o(lds, NT, 2592, 1024, al, bl, ep);
#endif
    } SEAM(2);
    if (IN(3)) for (int rep_ = 0; rep_ < (3 == PROBE_DUP ? 2 : 1); ++rep_) { if (rep_) xcd_barrier(xbar);
#if FAST_G2
        { pg8::Gemm g{(const char*)(ws + WS_QL), (const char*)(ws + WS_QL), (const char*)(ws + WS_WQ), 1536, 256, 256, 0, 4}; pg8::StaticOrder S; S.init(NT, 1536, G, bid);
          pg8::EpiG2q E{(bf16_t*)(ws + WS_QN), (bf16_t*)(ws + WS_QR), (const float*)(ws + WS_SQ), (const float*)(ws + WS_ROPE)}; pg8::gemm_phase(l3, g, S, E); }
        { pg8::Gemm g{(const char*)(ws + WS_KL), (const char*)(ws + WS_KL), (const char*)(ws + WS_WKV), 2048, 256, 256, 0, 4}; pg8::StaticOrder S; S.init(NT, 2048, G, bid);
          pg8::EpiG2kv E{(bf16_t*)(ws + WS_KN), (bf16_t*)(ws + WS_VV), (const float*)(ws + WS_SKV)}; pg8::gemm_phase(l3, g, S, E); }
#if FAST_SSM
        ssm::passA(a);
#endif
#else
        { ARow al{(const bf16_t*)(ws + WS_QL), 256}; BL3q bl{a.in[18], a.in[17]}; EP3q ep{(bf16_t*)(ws + WS_QN), (bf16_t*)(ws + WS_QR), (const float*)(ws + WS_CTL), (const float*)(ws + WS_ROPE)};
          gemm_o(lds, NT, 1536, 256, al, bl, ep); }
        { ARow al{(const bf16_t*)(ws + WS_KL), 256}; BL3kv bl{a.in[20], a.in[19]}; EP3kv ep{(bf16_t*)(ws + WS_KN), (bf16_t*)(ws + WS_VV), (const float*)(ws + WS_CTL + 131072)};
          gemm_o(lds, NT, 2048, 256, al, bl, ep); }
#endif
    } SEAM(3);
#if FAST_ATT
    if (IN(4)) { for (int rep_ = 0; rep_ < (4 == PROBE_DUP ? 2 : 1); ++rep_) { if (rep_) xcd_barrier(xbar);
#if FAST_SSM
        ssm::scan_states(a);
#endif
        att::attn_phase(a, (att::ATT_LAS_T*)lds_raw, (4 == PROBE_DUP) ? (rep_ + a.ph_lo) : 1); } } SEAM(4);
#else
    if (IN(4)) { ph4_attn(a, lds); } SEAM(4);
#endif
    if (IN(5)) for (int rep_ = 0; rep_ < (5 == PROBE_DUP ? 2 : 1); ++rep_) { if (rep_) xcd_barrier(xbar);
#if FAST_ZS
        { pg8::Gemm g{(const char*)(ws + WS_HB), (const char*)(ws + WS_HB), (const char*)(ws + WS_WZS), 1024, 1024, 1024, 0, 16}; pg8::StaticOrder S; S.init(NT, 1024, G, bid);
          pg8::EpiZs E{(bf16_t*)(ws + WS_ZS)}; pg8::gemm_phase(l3, g, S, E); }
#else
        { ARow al{(const bf16_t*)(ws + WS_HB), 1024}; BLzs bl{a.in[6]}; EPzs ep{(bf16_t*)(ws + WS_ZS)}; gemm_o(lds, NT, 1024, 1024, al, bl, ep); }
#endif
        __syncthreads();
#if FAST_SSM
        ssm::passB(a, (ssm::SSM_LAS_T*)lds_raw);
#else
        ph5_ssm(a, lds);
#endif
    } SEAM(5);
    if (IN(6)) for (int rep_ = 0; rep_ < (6 == PROBE_DUP ? 2 : 1); ++rep_) { if (rep_) xcd_barrier(xbar);
#if FAST_GLU
        { pg8::Gemm g{(const char*)(ws + WS_YG), (const char*)(ws + WS_YG), (const char*)(ws + WS_WGLU), 2048, 1024, 1024, 1, 16}; pg8::StaticOrder S; S.init(NT, 2048, G, bid);
          pg8::EpiGlu E{(bf16_t*)(ws + WS_TS), (const bf16_t*)(ws + WS_ZS), a.in[16]}; pg8::gemm_phase(l3, g, S, E); }
#else
        { AGrp al{(const bf16_t*)(ws + WS_YG)}; BLglu bl{a.in[15]}; EPglu ep{(bf16_t*)(ws + WS_TS), (const bf16_t*)(ws + WS_ZS), a.in[16]}; gemm_o(lds, NT, 2048, 1024, al, bl, ep); }
#endif
#if FAST_MERGE
        { pg8::Gemm g{(const char*)(ws + WS_HB), (const char*)(ws + WS_HB), (const char*)(ws + WS_WGATE), 2048, 1024, 1024, 0, 16}; pg8::StaticOrder S; S.init(NT, 2048, G, bid);
          pg8::EpiGate E{(bf16_t*)(ws + WS_RAT), (bf16_t*)(ws + WS_SGM)}; pg8::gemm_phase(l3, g, S, E); }
#else
        { ARow al{(const bf16_t*)(ws + WS_HB), 1024}; BLgate bl{a.in[6]}; EPgate ep{(bf16_t*)(ws + WS_GS), (bf16_t*)(ws + WS_GM)}; gemm_o(lds, NT, 2048, 1024, al, bl, ep); }
#endif
    } SEAM(6);
#if FAST_MERGE
    if (IN(7)) for (int rep_ = 0; rep_ < (7 == PROBE_DUP ? 2 : 1); ++rep_) { if (rep_) xcd_barrier(xbar); pg8::Gemm g{(const char*)(ws + WS_TS), (const char*)(ws + WS_TM), (const char*)(ws + WS_WBR), 1024, 2048, 1024, 0, 16}; pg8::StaticOrder S; S.init(NT, 1024, G, bid);
        pg8::EpiMerge E{(const bf16_t*)(ws + WS_RAT), (const bf16_t*)(ws + WS_SGM), (bf16_t*)(ws + WS_MG)}; pg8::gemm_phase(l3, g, S, E); } SEAM(7);
#else
    if (IN(7)) { ARow al{(const bf16_t*)(ws + WS_TS), 1024}; BLplain bl{a.in[21], 1024}; EPbs ep{(float*)(ws + WS_P1), (const bf16_t*)(ws + WS_GS)}; gemm_o(lds, NT, 1024, 1024, al, bl, ep); } SEAM(7);
    if (IN(8)) { ARow al{(const bf16_t*)(ws + WS_TM), 1024}; BLplain bl{a.in[22], 1024}; EPbm ep{(const float*)(ws + WS_P1), (const bf16_t*)(ws + WS_GM), (bf16_t*)(ws + WS_MG)}; gemm_o(lds, NT, 1024, 1024, al, bl, ep); } SEAM(8);
#endif
    if (IN(9)) for (int rep_ = 0; rep_ < (9 == PROBE_DUP ? 2 : 1); ++rep_) { if (rep_) xcd_barrier(xbar);
#if FAST_OUT
        pg8::Gemm g{(const char*)(ws + WS_MG), (const char*)(ws + WS_MG), (const char*)(ws + WS_WOUT), 1024, 1024, 1024, 0, 16}; pg8::StaticOrder S; S.init(NT, 1024, G, bid);
        pg8::EpiOut E{(bf16_t*)(ws + WS_OUTB), (float*)(ws + WS_SO)}; pg8::gemm_phase(l3, g, S, E);
#else
        ARow al{(const bf16_t*)(ws + WS_MG), 1024}; BLplain bl{a.in[23], 1024}; EPout ep{(float*)(ws + WS_OUTF)}; gemm_o(lds, NT, 1024, 1024, al, bl, ep);
#endif
    } SEAM(9);
    if (IN(10)) for (int rep_ = 0; rep_ < (10 == PROBE_DUP ? 2 : 1); ++rep_) { if (rep_) xcd_barrier(xbar); ph_final(a); }
#undef SEAM
#undef IN
}

extern "C" void kernel_launch(void* const* d_in, const int* in_sizes, int n_in, void* d_out, int out_size, void* d_ws, size_t ws_size, hipStream_t stream) {
    static int grid = 0;
    if (grid == 0) {
        if (n_in != 25 || out_size != NT * DM || ws_size < WS_END) { fprintf(stderr, "kernel_launch: unexpected shapes n_in %d out %d ws %zu\n", n_in, out_size, ws_size); grid = -1; return; }
        int dev = 0, cus = 0, per_cu = 0;
        hipGetDevice(&dev); hipDeviceGetAttribute(&cus, hipDeviceAttributeMultiprocessorCount, dev);
        hipFuncSetAttribute((const void*)mk_fwd, hipFuncAttributeMaxDynamicSharedMemorySize, LDS_BYTES);
        hipOccupancyMaxActiveBlocksPerMultiprocessor(&per_cu, (const void*)mk_fwd, NTHR, LDS_BYTES);
        (void)hipGetLastError();
        if (per_cu < 1) per_cu = 1;
        grid = cus * 1;
        fprintf(stderr, "kernel_launch: cus %d per_cu %d grid %d ws %zu\n", cus, per_cu, grid, ws_size);
    }
    if (grid < 0) return;
    hipMemsetAsync((char*)d_ws + WS_CTL, 0, 1 * MiB, stream);
    Args a{};
    for (int i = 0; i < 25; ++i) a.in[i] = (const float*)d_in[i];
    a.out = (float*)d_out; a.ws = (unsigned char*)d_ws;
#if MK_SINGLE
    a.ph_lo = 0; a.ph_hi = NPHASE;
    void* args[] = {&a};
    hipError_t e = hipLaunchCooperativeKernel((const void*)mk_fwd, dim3(grid), dim3(NTHR), args, LDS_BYTES, stream);
    if (e != hipSuccess) fprintf(stderr, "cooperative launch failed: %s (grid %d)\n", hipGetErrorString(e), grid);
#else
    for (int p = 0; p < NPHASE; ++p) { a.ph_lo = p; a.ph_hi = p + 1; hipLaunchKernelGGL(mk_fwd, dim3(grid), dim3(NTHR), LDS_BYTES, stream, a); }
#endif
}
```
